# Optimizing an MI355X kernel written in HIP

```python
import jax
import jax.numpy as jnp
from jax import lax
import numpy as np

D_MODEL = 1024
BATCH = 8
SEQ = 8192
DEPTH = 2

CTX_LEN = 256
GRID_W = 64
ATTN_HEADS = 8
ATTN_KV_HEADS = 2
HEAD_DIM = 64
WINDOW = 128
WBLOCK = 128
ROPE_THETA = 10000.0
HG_HEADS = 4
HG_DK = 128
HG_DV = 128
HG_CHUNK = 64
N_EXPERTS = 16
EXPERT_FF = 1024
CAPACITY_FACTOR = 2
N_MOD = 6
LN_EPS = 1e-6
DEEPNORM_ALPHA = (2 * DEPTH) ** 0.25
DEEPNORM_BETA = (8 * DEPTH) ** -0.25
ATTN_Q_DIM = ATTN_HEADS * HEAD_DIM
ATTN_KV_DIM = ATTN_KV_HEADS * HEAD_DIM
HG_K_DIM = HG_HEADS * HG_DK
HG_V_DIM = HG_HEADS * HG_DV
IN_SIZES = (ATTN_Q_DIM, ATTN_KV_DIM, ATTN_KV_DIM, HG_K_DIM, HG_K_DIM, HG_K_DIM, HG_V_DIM, HG_V_DIM, D_MODEL, D_MODEL)
IN_DIM = sum(IN_SIZES)

kernel_name = 'hybrid_swa_hgrn2_ecmoe_diffusion_block'


def layer_norm(x):
    xf = x.astype(jnp.float32)
    mu = jnp.mean(xf, axis=-1, keepdims=True)
    var = jnp.mean(jnp.square(xf - mu), axis=-1, keepdims=True)
    return ((xf - mu) * lax.rsqrt(var + LN_EPS)).astype(x.dtype)


def post_norm(x, g, b):
    return layer_norm(x) * g + b


def axial_rope(x):
    n_tok = x.shape[1]
    rows = n_tok // GRID_W
    row = jnp.broadcast_to(jnp.arange(rows)[:, None], (rows, GRID_W)).reshape(-1)
    col = jnp.broadcast_to(jnp.arange(GRID_W)[None, :], (rows, GRID_W)).reshape(-1)
    n_freq = HEAD_DIM // 4
    inv_freq = ROPE_THETA ** (-jnp.arange(n_freq, dtype=jnp.float32) / n_freq)

    def rotate(xh, pos):
        ang = pos.astype(jnp.float32)[:, None] * inv_freq[None, :]
        cos = jnp.cos(ang)[None, :, None, :].astype(x.dtype)
        sin = jnp.sin(ang)[None, :, None, :].astype(x.dtype)
        x1, x2 = jnp.split(xh, 2, axis=-1)
        return jnp.concatenate([x1 * cos - x2 * sin, x2 * cos + x1 * sin], axis=-1)

    x_row, x_col = jnp.split(x, 2, axis=-1)
    return jnp.concatenate([rotate(x_row, row), rotate(x_col, col)], axis=-1)


def window_attention(q, k, v, kc, vc, sink):
    B, L, H, dh = q.shape
    G = k.shape[2]
    R = H // G
    nb = L // WBLOCK
    scale = dh ** -0.5
    qb = q.reshape(B, nb, WBLOCK, G, R, dh)

    def band(t):
        tb = t.reshape(B, nb, WBLOCK, G, dh)
        tp = jnp.pad(tb, ((0, 0), (1, 1), (0, 0), (0, 0), (0, 0)))
        return jnp.concatenate([tp[:, :-2], tp[:, 1:-1], tp[:, 2:]], axis=2)

    kw, vw = band(k), band(v)
    ipos = jnp.arange(nb)[:, None] * WBLOCK + jnp.arange(WBLOCK)[None, :]
    jpos = jnp.arange(nb)[:, None] * WBLOCK - WBLOCK + jnp.arange(3 * WBLOCK)[None, :]
    rel = jpos[:, None, :] - ipos[:, :, None]
    valid = (jnp.abs(rel) <= WINDOW) & (jpos[:, None, :] >= 0) & (jpos[:, None, :] < L)
    s_win = jnp.einsum('bntgrd,bnsgd->bngrts', qb, kw).astype(jnp.float32) * scale
    s_win = jnp.where(valid[None, :, None, None], s_win, -jnp.inf)
    s_ctx = jnp.einsum('bntgrd,bcgd->bngrtc', qb, kc).astype(jnp.float32) * scale
    s_sink = sink.astype(jnp.float32).reshape(1, 1, G, R, 1, 1)
    m = jnp.maximum(jnp.maximum(s_ctx.max(-1, keepdims=True), s_win.max(-1, keepdims=True)), s_sink)
    e_ctx = jnp.exp(s_ctx - m)
    e_win = jnp.exp(s_win - m)
    denom = jnp.exp(s_sink - m) + e_ctx.sum(-1, keepdims=True) + e_win.sum(-1, keepdims=True)
    o = jnp.einsum('bngrtc,bcgd->bngrtd', e_ctx, vc) + jnp.einsum('bngrts,bnsgd->bngrtd', e_win, vw)
    o = (o / denom).astype(v.dtype)
    return o.transpose(0, 1, 4, 2, 3, 5).reshape(B, L, H * dh)


def context_attention(q, k, v, sink):
    B, Lc, H, dh = q.shape
    G = k.shape[2]
    R = H // G
    qg = q.reshape(B, Lc, G, R, dh)
    s = jnp.einsum('btgrd,bsgd->bgrts', qg, k).astype(jnp.float32) * (dh ** -0.5)
    s_sink = jnp.broadcast_to(sink.astype(jnp.float32).reshape(1, G, R, 1, 1), s.shape[:-1] + (1,))
    p = jax.nn.softmax(jnp.concatenate([s_sink, s], axis=-1), axis=-1)
    o = jnp.einsum('bgrts,bsgd->btgrd', p[..., 1:].astype(v.dtype), v)
    return o.reshape(B, Lc, H * dh)


def hgrn_lower_bounds(logits):
    cum = jnp.cumsum(jax.nn.softmax(logits.astype(jnp.float32), axis=0), axis=0)
    return cum - cum[0:1]


def forget_gate(z, lb):
    zf = z.astype(jnp.float32)
    lbh = lb.reshape(HG_HEADS, HG_DK)
    log_f = jnp.logaddexp(jnp.log(lbh), jnp.log1p(-lbh) + jax.nn.log_sigmoid(zf))
    k = (1.0 - lbh) * jax.nn.sigmoid(-zf)
    return log_f, k


def hgrn_scan(q, k, v, log_f, s0):
    B, L, H, dk = q.shape
    dv = v.shape[-1]
    nc = L // HG_CHUNK

    def chunks(t):
        return t.reshape(B, nc, HG_CHUNK, H, t.shape[-1]).transpose(1, 0, 3, 2, 4)

    tri = jnp.tril(jnp.ones((HG_CHUNK, HG_CHUNK), dtype=bool))

    def step(S, inp):
        qc, kc, vc, gc = inp
        cum = jnp.cumsum(gc, axis=2)
        diff = cum[:, :, :, None, :] - cum[:, :, None, :, :]
        decay = jnp.exp(jnp.where(tri[:, :, None], diff, -jnp.inf))
        scores = jnp.einsum('bhtk,bhsk,bhtsk->bhts', qc.astype(jnp.float32), kc, decay)
        o = jnp.einsum('bhtk,bhkv->bhtv', qc * jnp.exp(cum), S) + jnp.einsum('bhts,bhsv->bhtv', scores, vc)
        tot = cum[:, :, -1:, :]
        S_new = jnp.exp(tot[:, :, 0, :, None]) * S + jnp.einsum('bhsk,bhsv->bhkv', kc * jnp.exp(tot - cum), vc)
        return S_new, o

    s_fin, o = lax.scan(step, s0, (chunks(q), chunks(k), chunks(v), chunks(log_f)))
    o = o.transpose(1, 0, 3, 2, 4).reshape(B, L, H, dv)
    return o, s_fin


def hgrn_bidir(q, v, z_fw, z_bw, qc, vc, zc_fw, zc_bw, lb_fw, lb_bw):
    B = q.shape[0]
    s0 = jnp.zeros((B, HG_HEADS, HG_DK, HG_DV), jnp.float32)
    flip = lambda t: jnp.flip(t, axis=1)
    log_f, k = forget_gate(zc_fw, lb_fw)
    oc_fw, s_fw = hgrn_scan(qc, k, vc, log_f, s0)
    log_f, k = forget_gate(z_fw, lb_fw)
    o_fw, _ = hgrn_scan(q, k, v, log_f, s_fw)
    log_f, k = forget_gate(flip(zc_bw), lb_bw)
    oc_bw, s_bw = hgrn_scan(flip(qc), k, flip(vc), log_f, s0)
    log_f, k = forget_gate(flip(z_bw), lb_bw)
    o_bw, _ = hgrn_scan(flip(q), k, flip(v), log_f, s_bw)
    return o_fw + flip(o_bw), oc_fw + flip(oc_bw)


def hgrn_readout(o, g, norm_g):
    B, L = o.shape[:2]
    of = o.astype(jnp.float32)
    of = of * lax.rsqrt(jnp.mean(jnp.square(of), axis=-1, keepdims=True) + LN_EPS)
    return of.reshape(B, L, HG_V_DIM).astype(g.dtype) * norm_g * jax.nn.silu(g)


def token_mixer(u, uc, w_in, sink, lb_fw, lb_bw, norm_g, w_br_a, w_br_h, w_out, need_ctx):
    B, L, _ = u.shape
    Lc = uc.shape[1]
    idx = np.cumsum(IN_SIZES)[:-1].tolist()
    qa, ka, va, qh, zf, zb, ih, gh, ga, gb = jnp.split(u @ w_in, idx, axis=-1)
    cqa, cka, cva, cqh, czf, czb, cih, cgh, cga, cgb = jnp.split(uc @ w_in, idx, axis=-1)

    def heads(t, h):
        return t.reshape(B, t.shape[1], h, -1)

    kc_a, vc_a = heads(cka, ATTN_KV_HEADS), heads(cva, ATTN_KV_HEADS)
    attn = window_attention(axial_rope(heads(qa, ATTN_HEADS)), axial_rope(heads(ka, ATTN_KV_HEADS)),
                            heads(va, ATTN_KV_HEADS), kc_a, vc_a, sink)
    o_h, oc_h = hgrn_bidir(heads(jax.nn.silu(qh), HG_HEADS), heads(ih, HG_HEADS),
                           heads(zf, HG_HEADS), heads(zb, HG_HEADS),
                           heads(jax.nn.silu(cqh), HG_HEADS), heads(cih, HG_HEADS),
                           heads(czf, HG_HEADS), heads(czb, HG_HEADS), lb_fw, lb_bw)
    hg = hgrn_readout(o_h, gh, norm_g)
    y = (jax.nn.sigmoid(ga) * (attn @ w_br_a) + jax.nn.sigmoid(gb) * (hg @ w_br_h)) @ w_out
    if not need_ctx:
        return y, None
    attn_c = context_attention(heads(cqa, ATTN_HEADS), kc_a, vc_a, sink)
    hg_c = hgrn_readout(oc_h, cgh, norm_g)
    yc = (jax.nn.sigmoid(cga) * (attn_c @ w_br_a) + jax.nn.sigmoid(cgb) * (hg_c @ w_br_h)) @ w_out
    return y, yc


def expert_choice_ffn(u, w_router, w_gate, w_up, w_down):
    B, n, D = u.shape
    cap = CAPACITY_FACTOR * n // N_EXPERTS
    aff = jax.nn.softmax((u @ w_router).astype(jnp.float32), axis=-1)
    top_w, top_idx = lax.top_k(jnp.swapaxes(aff, 1, 2), cap)
    xs = jax.vmap(lambda ub, ib: ub[ib])(u, top_idx)
    h = jax.nn.silu(jnp.einsum('becd,edf->becf', xs, w_gate)) * jnp.einsum('becd,edf->becf', xs, w_up)
    y = jnp.einsum('becf,efd->becd', h, w_down) * top_w[..., None].astype(u.dtype)
    return jax.vmap(lambda yb, ib: jnp.zeros((n, D), yb.dtype).at[ib.reshape(-1)].add(yb.reshape(-1, D)))(y, top_idx)


def setup_inputs(seed: int = 0) -> dict:
    key = jax.random.key(seed)
    ks = jax.random.split(key, 24)
    f32 = jnp.float32

    def nrm(k, shape, scale):
        return jax.random.normal(k, shape, f32) * scale

    D = D_MODEL
    return {
        'x': nrm(ks[0], (BATCH, SEQ, D), 1.0),
        'c': nrm(ks[1], (BATCH, D), 1.0),
        'ctx': nrm(ks[2], (BATCH, CTX_LEN, D), 1.0),
        'c_ctx': nrm(ks[3], (D,), 1.0),
        'w_mod': nrm(ks[4], (DEPTH, D, N_MOD * D), D ** -0.5),
        'b_mod': nrm(ks[5], (DEPTH, N_MOD * D), 0.02),
        'w_in': nrm(ks[6], (DEPTH, D, IN_DIM), D ** -0.5),
        'attn_sink': nrm(ks[7], (DEPTH, ATTN_HEADS), 1.0),
        'hgrn_lb_fw': nrm(ks[8], (DEPTH, HG_K_DIM), 0.5),
        'hgrn_lb_bw': nrm(ks[9], (DEPTH, HG_K_DIM), 0.5),
        'hgrn_norm_g': 1.0 + nrm(ks[10], (DEPTH, HG_V_DIM), 0.02),
        'w_branch_attn': nrm(ks[11], (DEPTH, ATTN_Q_DIM, D), DEEPNORM_BETA * ATTN_Q_DIM ** -0.5),
        'w_branch_hgrn': nrm(ks[12], (DEPTH, HG_V_DIM, D), DEEPNORM_BETA * HG_V_DIM ** -0.5),
        'w_out': nrm(ks[13], (DEPTH, D, D), DEEPNORM_BETA * D ** -0.5),
        'w_router': nrm(ks[14], (DEPTH, D, N_EXPERTS), D ** -0.5),
        'w_gate': nrm(ks[15], (DEPTH, N_EXPERTS, D, EXPERT_FF), D ** -0.5),
        'w_up': nrm(ks[16], (DEPTH, N_EXPERTS, D, EXPERT_FF), D ** -0.5),
        'w_down': nrm(ks[17], (DEPTH, N_EXPERTS, EXPERT_FF, D), DEEPNORM_BETA * EXPERT_FF ** -0.5),
        'ln_g': 1.0 + nrm(ks[18], (DEPTH, 2, D), 0.02),
        'ln_b': nrm(ks[19], (DEPTH, 2, D), 0.02),
    }


def reference(x, c, ctx, c_ctx, w_mod, b_mod, w_in, attn_sink, hgrn_lb_fw, hgrn_lb_bw, hgrn_norm_g,
              w_branch_attn, w_branch_hgrn, w_out, w_router, w_gate, w_up, w_down, ln_g, ln_b):
    lb_fw_all = hgrn_lower_bounds(hgrn_lb_fw)
    lb_bw_all = hgrn_lower_bounds(hgrn_lb_bw)
    xc = ctx
    for l in range(DEPTH):
        need_ctx = l < DEPTH - 1
        mod = jax.nn.silu(c) @ w_mod[l] + b_mod[l]
        modc = jax.nn.silu(c_ctx) @ w_mod[l] + b_mod[l]
        sh1, sc1, g1, sh2, sc2, g2 = jnp.split(mod[:, None, :], N_MOD, axis=-1)
        sh1c, sc1c, g1c, sh2c, sc2c, g2c = jnp.split(modc, N_MOD)
        u = layer_norm(x) * (1.0 + sc1) + sh1
        uc = layer_norm(xc) * (1.0 + sc1c) + sh1c
        y, yc = token_mixer(u, uc, w_in[l], attn_sink[l], lb_fw_all[l], lb_bw_all[l], hgrn_norm_g[l],
                            w_branch_attn[l], w_branch_hgrn[l], w_out[l], need_ctx)
        x = post_norm(DEEPNORM_ALPHA * x + g1 * y, ln_g[l, 0], ln_b[l, 0])
        u = layer_norm(x) * (1.0 + sc2) + sh2
        x = post_norm(DEEPNORM_ALPHA * x + g2 * expert_choice_ffn(u, w_router[l], w_gate[l], w_up[l], w_down[l]),
                      ln_g[l, 1], ln_b[l, 1])
        if need_ctx:
            xc = post_norm(DEEPNORM_ALPHA * xc + g1c * yc, ln_g[l, 0], ln_b[l, 0])
            uc = layer_norm(xc) * (1.0 + sc2c) + sh2c
            xc = post_norm(DEEPNORM_ALPHA * xc + g2c * expert_choice_ffn(uc, w_router[l], w_gate[l], w_up[l], w_down[l]),
                           ln_g[l, 1], ln_b[l, 1])
    return x
```

```cpp
#include <hip/hip_runtime.h>
#include <cstdint>
#include <cstdio>

#ifndef MK_MULTI
#define MK_MULTI 0
#endif
#ifndef PG8_SP2
#define PG8_SP2 1
#endif

#define LAS __attribute__((address_space(3)))
typedef unsigned short bf16_t;
typedef short bf16x8 __attribute__((ext_vector_type(8)));
typedef short s16x4 __attribute__((ext_vector_type(4)));
typedef float f32x4 __attribute__((ext_vector_type(4)));
typedef float f32x16 __attribute__((ext_vector_type(16)));
typedef unsigned u32x4 __attribute__((ext_vector_type(4)));
typedef unsigned u32x2 __attribute__((ext_vector_type(2)));

constexpr int D = 1024, NB = 8, SEQ = 8192, CTXL = 256;
constexpr int NLAT = NB * SEQ, NCTX = NB * CTXL, MROWS = NLAT + NCTX;
constexpr int IN_DIM = 5376, N1 = 2816, N2 = 2560;
constexpr int NE = 16, CAP = 1024, CAPC = 32;
constexpr int XSROWS = NB * NE * CAP + NB * NE * CAPC;
constexpr float LN_EPS = 1e-6f;
constexpr float ALPHA = 1.41421356237309515f;

constexpr int ZC_Q = 0, ZC_K = 512, ZC_V = 640, ZC_QM = 768, ZC_KM = 1280, ZC_IH = 2816;
constexpr int NCHUNK = MROWS / 64;
constexpr size_t ZO_HG = (size_t)MROWS * 768 * 2, ZA_BYTES = (size_t)MROWS * 128 * 2, ZO_IH = ZO_HG + 16 * ZA_BYTES;
constexpr int ZQP = 768;

constexpr size_t MiB = 1u << 20;
constexpr size_t WS_CTL = 0, CTL_ZERO_BYTES = 32 * 1024;
constexpr size_t WS_MOD = 1 * MiB;
constexpr size_t WS_ROPE = WS_MOD + 512 * 1024;
constexpr size_t WS_LB = WS_ROPE + 16384;
constexpr size_t WS_XC = 2 * MiB;
constexpr size_t WS_AFF = 18 * MiB;
constexpr size_t WS_INV = 23 * MiB;
constexpr size_t WS_AFFT = 28 * MiB;
constexpr size_t WS_SEL = 32 * MiB + 256 * 1024;
constexpr size_t WS_VECS = 18 * MiB;
constexpr size_t WS_W = 33 * MiB + 512 * 1024;
constexpr size_t W_IN = 0, W_BR = W_IN + (size_t)(N1 + N2) * D * 2, W_OUT = W_BR + (size_t)D * D * 2, W_GU = W_OUT + (size_t)D * D * 2,
                 W_DN = W_GU + (size_t)NE * 2048 * D * 2, W_END = W_DN + (size_t)NE * D * D * 2;
constexpr size_t WS_U = 145 * MiB;
constexpr size_t WS_Z = 277 * MiB;
constexpr size_t WS_ZG = WS_Z + 68 * MiB;
constexpr size_t WS_AH = 706 * MiB;
constexpr size_t WS_O = 838 * MiB;
constexpr size_t WS_HB = 541 * MiB;
constexpr size_t WS_END = 970 * MiB;
constexpr size_t W1_OFF = 128 * MiB;
static_assert(WS_W + W_END <= WS_U && WS_SEL + (size_t)XSROWS * 4 <= WS_W && WS_VECS + (size_t)2 * NCHUNK * 3 * 512 * 4 <= WS_SEL, "weights fit");
static_assert(WS_U + (size_t)MROWS * D * 2 <= WS_Z, "U fits");
static_assert(WS_Z + ZO_IH + 4 * ZA_BYTES <= WS_AH && WS_Z + (size_t)MROWS * 512 * 2 <= WS_ZG && WS_ZG + (size_t)(MROWS / 256) * 8 * 2 * 65536 <= WS_AH, "Z1 / Z2 fit");
static_assert(WS_AH + (size_t)MROWS * D * 2 <= WS_O, "AH fits");
static_assert(WS_O + (size_t)MROWS * D * 2 <= WS_END, "O fits");
static_assert(WS_Z + (size_t)XSROWS * D * 2 <= WS_HB && WS_HB + (size_t)XSROWS * D * 2 <= WS_O, "XS/HB fit");

constexpr int CW_BAR = 4096;

constexpr int RING_BYTES = 131072;
constexpr int MISC_OFF = RING_BYTES;
constexpr int LDS_BYTES = 147456;

__device__ __forceinline__ unsigned f2bf(float f) { unsigned u = __float_as_uint(f); return (u + 0x7fffu + ((u >> 16) & 1u)) >> 16; }
typedef float f32x2_t __attribute__((ext_vector_type(2))); typedef __bf16 bf16x2_t __attribute__((ext_vector_type(2)));
__device__ __forceinline__ unsigned pk2(float lo, float hi) { const f32x2_t v = {lo, hi}; const bf16x2_t b = __builtin_convertvector(v, bf16x2_t); return __builtin_bit_cast(unsigned, b); }
__device__ __forceinline__ float bflo(unsigned w) { return __uint_as_float(w << 16); }
__device__ __forceinline__ float bfhi(unsigned w) { return __uint_as_float(w & 0xffff0000u); }
__device__ __forceinline__ float shx(float v, int m, int lane) { return __int_as_float(__builtin_amdgcn_ds_bpermute((lane ^ m) << 2, __float_as_int(v))); }
__device__ __forceinline__ float shup(float v, int d, int lane) { return __int_as_float(__builtin_amdgcn_ds_bpermute((lane - d) << 2, __float_as_int(v))); }
__device__ __forceinline__ unsigned shup_u(unsigned v, int d, int lane) { return (unsigned)__builtin_amdgcn_ds_bpermute((lane - d) << 2, (int)v); }
__device__ __forceinline__ float shidx(float v, int src) { return __int_as_float(__builtin_amdgcn_ds_bpermute(src << 2, __float_as_int(v))); }
__device__ __forceinline__ int shidx_i(int v, int src) { return __builtin_amdgcn_ds_bpermute(src << 2, v); }
__device__ __forceinline__ float wave_sum(float v, int lane) {
#pragma unroll
    for (int o = 1; o < 64; o <<= 1) v += shx(v, o, lane);
    return v;
}

template <int CTRL> __device__ __forceinline__ float dppf(float v) { return __int_as_float(__builtin_amdgcn_update_dpp(0, __float_as_int(v), CTRL, 0xF, 0xF, true)); }
__device__ __forceinline__ float row16_sum(float v) { v += dppf<0xB1>(v); v += dppf<0x4E>(v); v += dppf<0x141>(v); v += dppf<0x140>(v); return v; }
__device__ __forceinline__ float row16_max(float v) { v = fmaxf(v, dppf<0xB1>(v)); v = fmaxf(v, dppf<0x4E>(v)); v = fmaxf(v, dppf<0x141>(v)); v = fmaxf(v, dppf<0x140>(v)); return v; }
template <int CTRL, int RM> __device__ __forceinline__ float dppz(float v) { return __int_as_float(__builtin_amdgcn_update_dpp(0, __float_as_int(v), CTRL, RM, 0xF, false)); }
__device__ __forceinline__ float wave_scan(float v) {
    v += dppz<0x111, 0xF>(v); v += dppz<0x112, 0xF>(v); v += dppz<0x114, 0xF>(v); v += dppz<0x118, 0xF>(v); v += dppz<0x142, 0xA>(v); v += dppz<0x143, 0xC>(v); return v; }
__device__ __forceinline__ float rdlane(float v, int l) { return __int_as_float(__builtin_amdgcn_readlane(__float_as_int(v), l)); }
__device__ __forceinline__ float wsum(float v) { v = row16_sum(v); return (rdlane(v, 0) + rdlane(v, 16)) + (rdlane(v, 32) + rdlane(v, 48)); }
__device__ __forceinline__ void unpack8(const u32x4 w, f32x4& a, f32x4& b) { a = (f32x4){bflo(w.x), bfhi(w.x), bflo(w.y), bfhi(w.y)}; b = (f32x4){bflo(w.z), bfhi(w.z), bflo(w.w), bfhi(w.w)}; }
__device__ __forceinline__ u32x4 pack8(const f32x4 a, const f32x4 b) { u32x4 w; w.x = pk2(a[0], a[1]); w.y = pk2(a[2], a[3]); w.z = pk2(b[0], b[1]); w.w = pk2(b[2], b[3]); return w; }
__device__ __forceinline__ float hsum4(const f32x4 v) { return (v[0] + v[1]) + (v[2] + v[3]); }
__device__ __forceinline__ float hsq4(const f32x4 v) { return (v[0] * v[0] + v[1] * v[1]) + (v[2] * v[2] + v[3] * v[3]); }
__device__ __forceinline__ float sigmoidf_(float z) { return __builtin_amdgcn_rcpf(1.0f + __expf(-z)); }
__device__ __forceinline__ float siluf_(float z) { return z * __builtin_amdgcn_rcpf(1.0f + __expf(-z)); }
__device__ __forceinline__ u32x2 pack4(const f32x4 v) { u32x2 w; w.x = pk2(v[0], v[1]); w.y = pk2(v[2], v[3]); return w; }
__device__ __forceinline__ f32x4 unpack4(const u32x2 w) { return (f32x4){bflo(w.x), bfhi(w.x), bflo(w.y), bfhi(w.y)}; }

#define XB_TMO      128
#define XB_XCNT(j)  (256  + 64 * (j))
#define XB_XSUB(j)  (1280 + 64 * (j))
#define XB_XGEN(j)  (2304 + 64 * (j))
#define XB_TOP      3328
#define XB_TOPGEN   3392
#define XCD_BAR_WORDS 3456
#define XB_SPIN_CAP (1u << 18)
__device__ __forceinline__ unsigned xb_ld(unsigned* p)              { return __hip_atomic_load(p, __ATOMIC_RELAXED, __HIP_MEMORY_SCOPE_AGENT); }
__device__ __forceinline__ unsigned xb_add(unsigned* p, unsigned v) { return __hip_atomic_fetch_add(p, v, __ATOMIC_RELAXED, __HIP_MEMORY_SCOPE_AGENT); }
__device__ __forceinline__ unsigned xb_xcc_id() { return (unsigned)__builtin_amdgcn_s_getreg((3 << 11) | 20) & 0xFu; }
#define XB_SPIN(cond, bar) do { unsigned _sp = 0; while (cond) { __builtin_amdgcn_s_sleep(1); \
    if ((++_sp & 255u) == 0u) { if (xb_ld(&(bar)[XB_TMO])) break; if (_sp > XB_SPIN_CAP) { atomicAdd(&(bar)[XB_TMO], 1u); break; } } } } while (0)
struct XcdBarrier { unsigned* bar; unsigned x; volatile LAS unsigned* st; };
__device__ __forceinline__ XcdBarrier xcd_barrier_post(unsigned* bar, volatile LAS unsigned* st) {
    XcdBarrier b; b.bar = bar; b.x = xb_xcc_id(); b.st = st;
    if (threadIdx.x == 0) (void)xb_add(&bar[XB_XCNT(b.x)], 1u);
    return b;
}
__device__ __forceinline__ void xcd_barrier_complete(unsigned* bar, unsigned x, unsigned& nloc, unsigned& nx) {
    const unsigned G = gridDim.x * gridDim.y * gridDim.z;
    unsigned sum, cnt, mine, sp = 0u;
    for (;;) {
        sum = 0u; cnt = 0u; mine = 0u;
#pragma unroll
        for (unsigned j = 0; j < 16; ++j) { const unsigned c = xb_ld(&bar[XB_XCNT(j)]); sum += c; cnt += (c > 0u) ? 1u : 0u; mine = (j == x) ? c : mine; }
        if (sum == G) break;
        __builtin_amdgcn_s_sleep(1);
        if ((++sp & 255u) == 0u) { if (xb_ld(&bar[XB_TMO])) break; if (sp > XB_SPIN_CAP) { atomicAdd(&bar[XB_TMO], 1u); break; } }
    }
    nloc = mine > 0u ? mine : 1u; nx = cnt > 0u ? cnt : 1u;
}
__device__ __forceinline__ void xcd_barrier(const XcdBarrier& b) {
    asm volatile("s_waitcnt vmcnt(0)" ::: "memory");
    __syncthreads();
    if (threadIdx.x == 0) {
        unsigned* bar = b.bar;
        __builtin_amdgcn_s_waitcnt(0);
        unsigned nloc = b.st[0], nx = b.st[1];
        if (nloc == 0u) { xcd_barrier_complete(bar, b.x, nloc, nx); b.st[0] = nloc; b.st[1] = nx; }
        const unsigned old = xb_add(&bar[XB_XSUB(b.x)], 1u);
        const unsigned gen = old / nloc;
        if (old + 1u == (gen + 1u) * nloc) {
            __builtin_amdgcn_fence(__ATOMIC_RELEASE, "agent");
            asm volatile("s_waitcnt vmcnt(0)" ::: "memory");
            const unsigned og = xb_add(&bar[XB_TOP], 1u);
            const unsigned tg = og / nx;
            if (og + 1u == (tg + 1u) * nx) xb_add(&bar[XB_TOPGEN], 1u);
            else XB_SPIN(xb_ld(&bar[XB_TOPGEN]) == tg, bar);
            xb_add(&bar[XB_XGEN(b.x)], 1u);
            __builtin_amdgcn_fence(__ATOMIC_ACQUIRE, "agent");
            asm volatile("s_waitcnt vmcnt(0)" ::: "memory");
        } else {
            XB_SPIN(xb_ld(&bar[XB_XGEN(b.x)]) == gen, bar);
            __builtin_amdgcn_fence(__ATOMIC_ACQUIRE, "agent");
            asm volatile("s_waitcnt vmcnt(0)" ::: "memory");
        }
    }
    __syncthreads();
}

namespace pg8 {
constexpr int BM = 256, BK = 64, HALF = 128, HTB = HALF * BK * 2, STAGE_BYTES = 8 * HTB, NXCD = 8, WGM = 8;
constexpr int SELBUF = STAGE_BYTES + 1024;
__host__ __device__ __forceinline__ int lds_byte(int r, int c) { const int st = (r >> 4) * 2 + (c >> 5), rr = r & 15, cc = c & 31, ob = rr * 64 + cc * 2; return st * 1024 + (ob ^ (((ob >> 9) & 1) << 5)); }
__host__ __device__ __forceinline__ int perm32(int rho) { const int n = rho >> 4, i = rho & 15; return 8 * (i >> 2) + 4 * n + (i & 3); }
__host__ __device__ __forceinline__ void stage_rc(int b, int& R, int& C) { const int st = b / 1024, sb = b % 1024, swz = sb ^ (((sb >> 9) & 1) << 5); R = (st >> 1) * 16 + swz / 64; C = (st & 1) * 32 + (swz % 64) / 2; }
struct Unit { int pm, pn, aux; };
__device__ __forceinline__ void tile_of(int wgid0, int nM, int nN, int& pm, int& pn) {
    const int nwg = nM * nN; int wgid = wgid0;
    { const int q = nwg / NXCD, r = nwg % NXCD, xcd = wgid % NXCD, off = wgid / NXCD; wgid = (xcd < r ? xcd * (q + 1) : r * (q + 1) + (xcd - r) * q) + off; }
    const int nig = WGM * nN, gid = wgid / nig, fm = gid * WGM, gsz = (nM - fm) < WGM ? (nM - fm) : WGM;
    pm = fm + ((wgid % nig) % gsz); pn = (wgid % nig) / gsz;
}
template <bool GATHER = false, class Epi, class Sched>
__device__ __forceinline__ void gemm_phase(LAS unsigned char* lds, const int tid, const int K, const int lda, const int ldb, const Sched& S, const Epi& E) {
    const int wid = __builtin_amdgcn_readfirstlane(tid >> 6), lane = tid & 63, wr = wid >> 2, wc = wid & 3, fr = lane & 15, fq = lane >> 4;
    const int nt = K / BK;
    unsigned voffA[2]; int Rr[2], Cc[2];
    unsigned sbv[2];
#pragma unroll
    for (int i = 0; i < 2; ++i) { int R, C; stage_rc(tid * 16 + i * 8192, R, C); Rr[i] = R; Cc[i] = C; voffA[i] = (unsigned)(R * lda + C) * 2u; sbv[i] = 0u; }
    auto bvoff = [&](bool perm, int i) -> unsigned { int ln_; asm volatile("v_mbcnt_lo_u32_b32 %0, -1, 0\n\tv_mbcnt_hi_u32_b32 %0, -1, %0" : "=v"(ln_)); int R, C; stage_rc((wid * 64 + ln_) * 16 + i * 8192, R, C);
        const int Rp = perm ? ((R & ~31) + perm32(R & 31)) : R; return (unsigned)(Rp * ldb + C) * 2u; };
    unsigned goff[2][2], ngoff[2][2], so[2][2];
#pragma unroll
    for (int h = 0; h < 2; ++h)
#pragma unroll
        for (int i = 0; i < 2; ++i) { goff[h][i] = 0u; ngoff[h][i] = 0u; so[h][i] = 0u; }
    const size_t kstep = (size_t)(BK * 2);
    const size_t hstepA = (size_t)HALF * lda * 2, hstepB = (size_t)HALF * ldb * 2;
    const unsigned ldsw = (unsigned)wid * 1024u;
    const int aoff = lds_byte(wr * 64 + fr, fq * 8), boff = lds_byte(wc * 32 + fr, fq * 8);
#define PG8_SA(b, h) (((b) * 2 + (h)) * HTB)
#define PG8_SB(b, h) ((4 + (b) * 2 + (h)) * HTB)
#define PG8_STAGE(bufoff, gbase, voff) do { _Pragma("unroll") for (int _i = 0; _i < 2; ++_i) \
        __builtin_amdgcn_global_load_lds((const unsigned*)((const char*)(gbase) + (voff)[_i]), (LAS unsigned*)(lds + (bufoff) + ldsw + _i * 8192), 16, 0, 0); } while (0)
#define PG8_STAGE_A(bufoff, gbase, h, VO) do { if constexpr (GATHER) { PG8_STAGE(bufoff, gbase, VO[h]); } else { PG8_STAGE(bufoff, (gbase) + (h) * hstepA, voffA); } } while (0)
#define PG8_LDA(dst, b, h) do { _Pragma("unroll") for (int m = 0; m < 4; ++m) _Pragma("unroll") for (int k = 0; k < 2; ++k) dst[m][k] = *(const LAS bf16x8*)(lds + PG8_SA(b, h) + aoff + m * 2048 + k * 1024); } while (0)
#define PG8_LDB(dst, b, h) do { _Pragma("unroll") for (int n = 0; n < 2; ++n) _Pragma("unroll") for (int k = 0; k < 2; ++k) dst[n][k] = *(const LAS bf16x8*)(lds + PG8_SB(b, h) + boff + n * 2048 + k * 1024); } while (0)
#define PG8_MMA(ai, bj, At, Bt) do { __builtin_amdgcn_s_setprio(1); _Pragma("unroll") for (int m = 0; m < 4; ++m) _Pragma("unroll") for (int n = 0; n < 2; ++n) _Pragma("unroll") for (int k = 0; k < 2; ++k) \
        acc[ai][bj][m][n] = __builtin_amdgcn_mfma_f32_16x16x32_bf16(Bt[n][k], At[m][k], acc[ai][bj][m][n], 0, 0, 0); __builtin_amdgcn_s_setprio(0); } while (0)
#define PG8_WAIT_V(n) asm volatile("s_waitcnt vmcnt(" #n ")" ::: "memory")
#define PG8_WAIT_VN(N) asm volatile("s_waitcnt vmcnt(%0)" :: "n"(N) : "memory")
#define PG8_WAIT_L(n) asm volatile("s_waitcnt lgkmcnt(" #n ")" ::: "memory")
#define PG8_BAR __builtin_amdgcn_s_barrier()
#define PG8_SCHED __builtin_amdgcn_sched_barrier(0)
    Unit cur, nxt; int ui = 0;
    if (!S.next(0, cur)) return;
    f32x4 acc[2][2][4][2];
#pragma unroll
    for (int a = 0; a < 2; ++a)
#pragma unroll
        for (int b = 0; b < 2; ++b)
#pragma unroll
            for (int m = 0; m < 4; ++m)
#pragma unroll
                for (int n = 0; n < 2; ++n) acc[a][b][m][n] = (f32x4){0.f, 0.f, 0.f, 0.f};
    bf16x8 At[4][2], B0[2][2], B1[2][2];
    const char* cA = S.aptr(cur); const char* cB = S.bptr(cur);
    bool pcur = E.perm(cur);
    unsigned vbc[2];
#pragma unroll
    for (int i = 0; i < 2; ++i) vbc[i] = bvoff(pcur, i);
    if constexpr (GATHER) {
#pragma unroll
        for (int h = 0; h < 2; ++h)
#pragma unroll
            for (int i = 0; i < 2; ++i) goff[h][i] = S.arow(cur, h * HALF + Rr[i]) + (unsigned)Cc[i] * 2u;
    }
#if PG8_SP2
    PG8_STAGE(PG8_SB(0, 0), cB, vbc); PG8_STAGE(PG8_SB(0, 1), cB + hstepB, vbc); PG8_STAGE_A(PG8_SA(0, 0), cA, 0, goff); PG8_STAGE_A(PG8_SA(0, 1), cA, 1, goff);
    if (wr == 1) PG8_BAR;
    PG8_WAIT_V(2); PG8_BAR;
    PG8_STAGE(PG8_SB(1, 0), cB + kstep, vbc); PG8_STAGE_A(PG8_SA(1, 0), cA + kstep, 0, goff); PG8_STAGE(PG8_SB(1, 1), cB + hstepB + kstep, vbc);
    PG8_WAIT_V(6); PG8_BAR;
#else
    PG8_STAGE(PG8_SB(0, 0), cB, vbc); PG8_STAGE_A(PG8_SA(0, 0), cA, 0, goff); PG8_STAGE(PG8_SB(0, 1), cB + hstepB, vbc); PG8_STAGE_A(PG8_SA(0, 1), cA, 1, goff);
    if (wr == 1) PG8_BAR;
    PG8_WAIT_V(4); PG8_BAR;
    PG8_STAGE(PG8_SB(1, 0), cB + kstep, vbc); PG8_STAGE_A(PG8_SA(1, 0), cA + kstep, 0, goff); PG8_STAGE(PG8_SB(1, 1), cB + hstepB + kstep, vbc);
    PG8_WAIT_V(6); PG8_BAR;
#endif
    for (;;) {
        const bool has_next = S.next(ui + 1, nxt);
        const char* nA = has_next ? S.aptr(nxt) : cA; const char* nB = has_next ? S.bptr(nxt) : cB;
        if constexpr (GATHER) {
            if (has_next && wid == 0) { int ln_; asm volatile("v_mbcnt_lo_u32_b32 %0, -1, 0\n\tv_mbcnt_hi_u32_b32 %0, -1, %0" : "=v"(ln_));
                __builtin_amdgcn_global_load_lds((const unsigned*)(S.selrow(nxt) + ln_ * 4), (LAS unsigned*)(lds + SELBUF + ((ui + 1) & 1) * 1024), 16, 0, 0); }
        }
        const bool pnext = has_next ? E.perm(nxt) : pcur;
        for (int t = 0; t < nt; t += 2) {
            const bool last = (t == nt - 2);
#pragma unroll
            for (int i = 0; i < 2; ++i) sbv[i] = vbc[i];
            if (last && pnext != pcur) {
#pragma unroll
                for (int i = 0; i < 2; ++i) sbv[i] = bvoff(pnext, i); }
            if constexpr (GATHER) {
#pragma unroll
                for (int h = 0; h < 2; ++h)
#pragma unroll
                    for (int i = 0; i < 2; ++i) so[h][i] = goff[h][i];
                if (last) {
                    const LAS int* sb = (const LAS int*)(lds + SELBUF + ((ui + 1) & 1) * 1024);
                    int ln_; asm volatile("v_mbcnt_lo_u32_b32 %0, -1, 0\n\tv_mbcnt_hi_u32_b32 %0, -1, %0" : "=v"(ln_));
#pragma unroll
                    for (int i = 0; i < 2; ++i) { int R_, C_; stage_rc((wid * 64 + ln_) * 16 + i * 8192, R_, C_);
#pragma unroll
                        for (int h = 0; h < 2; ++h) { ngoff[h][i] = has_next ? (unsigned)sb[h * HALF + R_] * (unsigned)(2048) + (unsigned)C_ * 2u : goff[h][i]; so[h][i] = ngoff[h][i]; } }
                }
            }
            const char* a1 = cA + (size_t)(t + 1) * kstep;
            const char* a2 = last ? nA : cA + (size_t)(t + 2) * kstep; const char* b2 = last ? nB : cB + (size_t)(t + 2) * kstep;
            const char* a3 = a2 + kstep; const char* b3 = b2 + kstep;
            if constexpr (Epi::HAS_MID) { if (t == nt / 2) E.mid(acc, cur, wr, wc); }
#if PG8_SP2
            const bool rlx = (t == 0) && (ui > 0);
#define PG8_WAIT_R() do { if (rlx) PG8_WAIT_VN(8 + Epi::MIN_VM); else PG8_WAIT_VN(8); } while (0)
            PG8_LDB(B0, 0, 0); PG8_LDB(B1, 0, 1); PG8_SCHED; PG8_LDA(At, 0, 0); if (!rlx) { PG8_STAGE_A(PG8_SA(1, 1), a1, 1, goff); }
            PG8_WAIT_R(); PG8_WAIT_L(0); PG8_BAR; PG8_MMA(0, 0, At, B0); PG8_MMA(0, 1, At, B1); PG8_BAR; PG8_SCHED;
            PG8_LDA(At, 0, 1); PG8_STAGE(PG8_SB(0, 0), b2, sbv); PG8_STAGE(PG8_SB(0, 1), b2 + hstepB, sbv); PG8_STAGE_A(PG8_SA(0, 0), a2, 0, so);
            PG8_WAIT_R(); PG8_WAIT_L(0); PG8_BAR; PG8_MMA(1, 0, At, B0); PG8_MMA(1, 1, At, B1); PG8_BAR; PG8_SCHED;
            PG8_LDB(B0, 1, 0); PG8_LDB(B1, 1, 1); PG8_SCHED; PG8_LDA(At, 1, 0); PG8_STAGE_A(PG8_SA(0, 1), a2, 1, so);
            PG8_WAIT_R(); PG8_WAIT_L(0); PG8_BAR; PG8_MMA(0, 0, At, B0); PG8_MMA(0, 1, At, B1); PG8_BAR; PG8_SCHED;
            PG8_LDA(At, 1, 1); PG8_STAGE(PG8_SB(1, 0), b3, sbv); PG8_STAGE(PG8_SB(1, 1), b3 + hstepB, sbv); PG8_STAGE_A(PG8_SA(1, 0), a3, 0, so);
            if (rlx) asm volatile("s_waitcnt vmcnt(8) ; exact in the first trip too" ::: "memory"); else PG8_WAIT_VN(8);
            PG8_WAIT_L(0); PG8_BAR; PG8_MMA(1, 0, At, B0); PG8_MMA(1, 1, At, B1); PG8_BAR; PG8_SCHED;
#undef PG8_WAIT_R
#else
            PG8_LDB(B0, 0, 0); PG8_SCHED; PG8_LDA(At, 0, 0); PG8_STAGE_A(PG8_SA(1, 1), a1, 1, goff);
            PG8_WAIT_L(8); PG8_BAR; PG8_WAIT_L(0); PG8_MMA(0, 0, At, B0); PG8_BAR; PG8_SCHED;
            PG8_LDB(B1, 0, 1); PG8_STAGE(PG8_SB(0, 0), b2, sbv);
            PG8_BAR; PG8_WAIT_L(0); PG8_MMA(0, 1, At, B1); PG8_BAR;
            PG8_LDA(At, 0, 1); PG8_STAGE_A(PG8_SA(0, 0), a2, 0, so);
            PG8_BAR; PG8_WAIT_L(0); PG8_MMA(1, 0, At, B0); PG8_BAR; PG8_SCHED;
            PG8_STAGE(PG8_SB(0, 1), b2 + hstepB, sbv);
            PG8_WAIT_V(6); PG8_BAR; PG8_MMA(1, 1, At, B1); PG8_BAR;
            PG8_LDB(B0, 1, 0); PG8_SCHED; PG8_LDA(At, 1, 0); PG8_STAGE_A(PG8_SA(0, 1), a2, 1, so);
            PG8_WAIT_L(8); PG8_BAR; PG8_WAIT_L(0); PG8_MMA(0, 0, At, B0); PG8_BAR; PG8_SCHED;
            PG8_LDB(B1, 1, 1); PG8_STAGE(PG8_SB(1, 0), b3, sbv);
            PG8_BAR; PG8_WAIT_L(0); PG8_MMA(0, 1, At, B1); PG8_BAR;
            PG8_LDA(At, 1, 1); PG8_STAGE_A(PG8_SA(1, 0), a3, 0, so);
            PG8_BAR; PG8_WAIT_L(0); PG8_MMA(1, 0, At, B0); PG8_BAR; PG8_SCHED;
            PG8_STAGE(PG8_SB(1, 1), b3 + hstepB, sbv);
            PG8_WAIT_V(6); PG8_BAR; PG8_MMA(1, 1, At, B1); PG8_BAR;
#endif
        }
#if PG8_SP2
        if (has_next) { PG8_STAGE_A(PG8_SA(1, 1), nA + kstep, 1, ngoff); }
        asm volatile("" ::: "memory"); PG8_SCHED;
#endif
        if (wr == 0) PG8_BAR;
        const bool keep = E(acc, cur, wr, wc, fr, fq);
        if (!has_next) break;
        if (!keep) {
#pragma unroll
            for (int a = 0; a < 2; ++a)
#pragma unroll
                for (int b = 0; b < 2; ++b)
#pragma unroll
                    for (int m = 0; m < 4; ++m)
#pragma unroll
                        for (int n = 0; n < 2; ++n) acc[a][b][m][n] = (f32x4){0.f, 0.f, 0.f, 0.f};
        }
        cur = nxt; cA = nA; cB = nB; ++ui; pcur = pnext;
        if (wr == 1) PG8_BAR;
#pragma unroll
        for (int i = 0; i < 2; ++i) vbc[i] = sbv[i];
        if constexpr (GATHER) {
#pragma unroll
            for (int h = 0; h < 2; ++h)
#pragma unroll
                for (int i = 0; i < 2; ++i) goff[h][i] = ngoff[h][i];
        }
    }
    PG8_WAIT_V(0);
    PG8_BAR;
#undef PG8_SA
#undef PG8_SB
#undef PG8_STAGE
#undef PG8_STAGE_A
#undef PG8_LDA
#undef PG8_LDB
#undef PG8_MMA
#undef PG8_WAIT_V
#undef PG8_WAIT_L
#undef PG8_BAR
#undef PG8_SCHED
}
}
using pg8::Unit;

struct Args {
    const float *x, *c, *ctx, *c_ctx, *w_mod, *b_mod, *w_in, *attn_sink, *lb_fw, *lb_bw, *norm_g, *w_bra, *w_brh, *w_out, *w_router, *w_gate, *w_up, *w_down, *ln_g, *ln_b;
    float* out; unsigned char* ws; int ph_lo, ph_hi;
};
struct Frame {
    LAS unsigned char* lds;
    int tid, lane, wave, G, vcu, bx;
    unsigned char* ws;
};
__device__ __forceinline__ Frame phase_frame(const Frame& F0) {
    Frame F = F0; int ln; asm volatile("v_mbcnt_lo_u32_b32 %0, -1, 0\n\tv_mbcnt_hi_u32_b32 %0, -1, %0" : "=v"(ln));
    int wv = F0.wave, gg = F0.G, bb = (int)blockIdx.x; asm volatile("" : "+s"(wv), "+s"(gg), "+s"(bb)); F.wave = wv; F.G = gg; F.bx = bb; F.lane = ln; F.tid = wv * 64 + ln;
    unsigned long long w = (unsigned long long)F0.ws; asm volatile("" : "+s"(w)); F.ws = (unsigned char*)(__attribute__((address_space(1))) unsigned char*)w; return F;
}
__device__ __forceinline__ int mod_group(int row) { return row < NLAT ? (row >> 13) : NB; }

template <int NS>
struct DenseSched {
    const char* A; const char* B; int nM, nN, G, c; size_t a_sub, b_sub;
    __device__ __forceinline__ bool next(int i, Unit& u) const {
        const int ti = (i / NS) * G + c; if (ti >= nM * nN) return false;
        pg8::tile_of(ti, nM, nN, u.pm, u.pn); u.aux = i % NS; return true;
    }
    __device__ __forceinline__ const char* aptr(const Unit& u) const { return A + (size_t)u.pm * 256 * D * 2 + (size_t)u.aux * a_sub; }
    __device__ __forceinline__ const char* bptr(const Unit& u) const { return B + (size_t)u.pn * 256 * D * 2 + (size_t)u.aux * b_sub; }
};

template <int CTRL> __device__ __forceinline__ f32x4 dpp4(const f32x4 v) { return (f32x4){dppf<CTRL>(v[0]), dppf<CTRL>(v[1]), dppf<CTRL>(v[2]), dppf<CTRL>(v[3])}; }
__device__ __forceinline__ f32x4 row16_scan4(f32x4 v) { v += dpp4<0x111>(v); v += dpp4<0x112>(v); v += dpp4<0x114>(v); v += dpp4<0x118>(v); return v; }
__device__ __forceinline__ f32x4 row16_sum4(f32x4 v) { return (f32x4){row16_sum(v[0]), row16_sum(v[1]), row16_sum(v[2]), row16_sum(v[3])}; }
struct EpiIn1 {
    static constexpr bool HAS_MID = false; static constexpr int MIN_VM = 16;
    bf16_t* Z; const float* rope; const float* lb; float* vecs; bf16_t* QS;
    __device__ __forceinline__ bool perm(const Unit& u) const { return u.pn >= 3; }
    template <bool FWD>
    __device__ __forceinline__ void decay_half(f32x4 (&zz)[4][2], const f32x4 (&qraw)[4][2]  , const int dir, const int kc, const Unit& u, int ai, int wr, int wc, int fr, int fq) const {
        u32x2 omf[4][2];
        f32x4 r0[2], s01[2], r2[2], tot[2];
        {
            const f32x4 lbv[2] = {*(const f32x4*)(lb + dir * 512 + kc), *(const f32x4*)(lb + dir * 512 + kc + 4)};
#pragma unroll
            for (int m = 0; m < 4; ++m)
#pragma unroll
                for (int n = 0; n < 2; ++n) {
                    f32x4 z = zz[m][n], o;
#pragma unroll
                    for (int i = 0; i < 4; ++i) {
                        const float e = __expf(-fabsf(z[i])), r = __builtin_amdgcn_rcpf(1.0f + e); const bool pos = z[i] >= 0.f;
                        const float oml = 1.0f - lbv[n][i];
                        z[i] = __builtin_amdgcn_logf(lbv[n][i] + oml * ((pos ? 1.0f : e) * r));
                        o[i] = oml * ((pos ? e : 1.0f) * r);
                    }
                    omf[m][n] = pack4(o);
                    z = row16_scan4(z); zz[m][n] = z;
                    const f32x4 rs = dpp4<0x15F>(z);
                    if (m == 0) r0[n] = rs; else if (m == 1) s01[n] = r0[n] + rs; else if (m == 2) r2[n] = rs; else tot[n] = (s01[n] + r2[n]) + rs;
                }
        }
        int frl = fr, kcl = kc; asm volatile("" : "+v"(frl), "+v"(kcl));
        const int head = kc >> 7;
        const size_t rowoff = (size_t)(u.pm * 256 + ai * 128 + wr * 64 + frl);
        bf16_t* zp = (bf16_t*)((unsigned char*)Z + ZO_HG + (size_t)((dir * 4 + head) * 2) * ZA_BYTES) + rowoff * 128 + (kcl & 127);
#pragma unroll
        for (int m = 0; m < 4; ++m) {
            u32x2 a0p[2], kmp[2], qsp[2];
#pragma unroll
            for (int n = 0; n < 2; ++n) {
                const f32x4 cfl = zz[m][n];
                const f32x4 cf = m == 0 ? cfl : cfl + (m == 1 ? r0[n] : m == 2 ? s01[n] : s01[n] + r2[n]);
                const f32x4 d = dir ? (s01[n] - cf) + (cfl - dpp4<0x111>(cfl)) : cf - s01[n];
                const f32x4 om = unpack4(omf[m][n]);
                f32x4 a0, km, qs;
#pragma unroll
                for (int i = 0; i < 4; ++i) {
                    const float x = fminf(fmaxf(d[i], -115.415603f), 115.415603f);
                    const float E1 = __builtin_amdgcn_exp2f(x);
                    if constexpr (FWD) { qs[i] = siluf_(qraw[m][n][i]); a0[i] = qs[i] * E1; } else { a0[i] = E1; }
                    km[i] = om[i] * __builtin_amdgcn_exp2f(-x);
                }
                a0p[n] = pack4(a0); kmp[n] = pack4(km); if constexpr (FWD) qsp[n] = pack4(qs);
                __builtin_amdgcn_sched_barrier(0);
            }
            *(u32x4*)(zp + (size_t)(16 * m) * 128) = (u32x4){a0p[0].x, a0p[0].y, a0p[1].x, a0p[1].y}; *(u32x4*)(zp + ZA_BYTES / 2 + (size_t)(16 * m) * 128) = (u32x4){kmp[0].x, kmp[0].y, kmp[1].x, kmp[1].y};
            if constexpr (FWD) *(u32x4*)(QS + (rowoff + 16 * m) * D + 512 + kcl) = (u32x4){qsp[0].x, qsp[0].y, qsp[1].x, qsp[1].y};
        }
        if (frl == 0) {
            float* vp = vecs + ((size_t)(dir * NCHUNK + (u.pm * 4 + ai * 2 + wr)) * 3) * 512 + kcl;
#pragma unroll
            for (int n = 0; n < 2; ++n) {
                f32x4 te, dc, ee;
#pragma unroll
                for (int i = 0; i < 4; ++i) { const float e2 = dir ? tot[n][i] - s01[n][i] : s01[n][i]; te[i] = __builtin_amdgcn_exp2f(tot[n][i] - e2); dc[i] = __builtin_amdgcn_exp2f(tot[n][i]); ee[i] = __builtin_amdgcn_exp2f(e2); }
                *(f32x4*)(vp + 4 * n) = te; *(f32x4*)(vp + 512 + 4 * n) = dc; *(f32x4*)(vp + 1024 + 4 * n) = ee;
            }
        }
    }
    __device__ __forceinline__ bool operator()(f32x4 (&acc)[2][2][4][2], const Unit& u, int wr, int wc, int fr, int fq) const {
        { int ln_; asm volatile("v_mbcnt_lo_u32_b32 %0, -1, 0\n\tv_mbcnt_hi_u32_b32 %0, -1, %0" : "=v"(ln_)); fr = ln_ & 15; fq = ln_ >> 4; }
        const bool latent = u.pm < 256;
        if (u.pn >= 3 && u.pn < 7) {
            const int hj = u.pn - 3, kc = 128 * hj + 32 * wc + 8 * fq;
#pragma unroll
            for (int ai = 0; ai < 2; ++ai) decay_half<true>(acc[ai][1], acc[ai][0], 0, kc, u, ai, wr, wc, fr, fq);
            return false;
        }
        if (u.pn >= 7 && u.pn < 9) {
#pragma unroll
            for (int ai = 0; ai < 2; ++ai)
#pragma unroll
                for (int bj = 0; bj < 2; ++bj) decay_half<false>(acc[ai][bj], acc[ai][bj], 1, 256 * (u.pn - 7) + 128 * bj + 32 * wc + 8 * fq, u, ai, wr, wc, fr, fq);
            return false;
        }
        if (u.pn >= 9) {
#pragma unroll
            for (int bj = 0; bj < 2; ++bj) {
                bf16_t* zp = (bf16_t*)((unsigned char*)Z + ZO_IH + (size_t)(2 * (u.pn - 9) + bj) * ZA_BYTES) + (size_t)(u.pm * 256 + wr * 64 + fr) * 128 + 32 * wc + 8 * fq;
#pragma unroll
                for (int ai = 0; ai < 2; ++ai)
#pragma unroll
                    for (int m = 0; m < 4; ++m) *(u32x4*)(zp + (size_t)(ai * 128 + m * 16) * 128) = pack8(acc[ai][bj][m][0], acc[ai][bj][m][1]);
            }
            return false;
        }
        f32x4 rcs[2][4], rsn[2][4];
        if (latent && u.pn < 3) {
#pragma unroll
            for (int ai = 0; ai < 2; ++ai)
#pragma unroll
                for (int m = 0; m < 4; ++m) {
                    const int t = (u.pm * 256 + ai * 128 + wr * 64 + m * 16 + fr) & (SEQ - 1); const int pos = (wc & 1) ? (t & 63) : (t >> 6);
                    rcs[ai][m] = *(const f32x4*)(rope + pos * 16 + 4 * fq); rsn[ai][m] = *(const f32x4*)(rope + 2048 + pos * 16 + 4 * fq);
                }
            __builtin_amdgcn_sched_barrier(0);
        }
#pragma unroll
        for (int bj = 0; bj < 2; ++bj) {
            const int hidx = 2 * u.pn + bj;
            const int col0 = 128 * hidx + 32 * wc + 4 * fq;
            bf16_t* zp = Z + (size_t)(u.pm * 256 + wr * 64 + fr) * ZQP + col0;
            if (hidx < 5) {
                const float qs = hidx < 4 ? 0.125f * 1.44269504089f : 1.0f;
#pragma unroll
                for (int ai = 0; ai < 2; ++ai)
#pragma unroll
                    for (int m = 0; m < 4; ++m) {
                        f32x4 v0 = acc[ai][bj][m][0], v1 = acc[ai][bj][m][1];
                        if (latent) {
                            const f32x4 cs = rcs[ai][m], sn = rsn[ai][m];
                            const f32x4 o0 = v0 * cs - v1 * sn, o1 = v1 * cs + v0 * sn; v0 = o0; v1 = o1;
                        }
                        bf16_t* p = zp + (size_t)(ai * 128 + m * 16) * ZQP;
                        *(u32x2*)p = pack4(v0 * qs); *(u32x2*)(p + 16) = pack4(v1 * qs);
                    }
            } else {
#pragma unroll
                for (int ai = 0; ai < 2; ++ai)
#pragma unroll
                    for (int m = 0; m < 4; ++m) {
                        bf16_t* p = zp + (size_t)(ai * 128 + m * 16) * ZQP;
                        *(u32x2*)p = pack4(acc[ai][bj][m][0]); *(u32x2*)(p + 16) = pack4(acc[ai][bj][m][1]);
                    }
            }
        }
        return false;
    }
};
struct EpiIn2 {
    bf16_t* GH; unsigned char* ZG;
    static constexpr bool HAS_MID = false; static constexpr int MIN_VM = 16;
    __device__ __forceinline__ bool perm(const Unit&) const { return true; }
    __device__ __forceinline__ bool operator()(f32x4 (&acc)[2][2][4][2], const Unit& u, int wr, int wc, int fr, int fq) const {
        { int ln_; asm volatile("v_mbcnt_lo_u32_b32 %0, -1, 0\n\tv_mbcnt_hi_u32_b32 %0, -1, %0" : "=v"(ln_)); fr = ln_ & 15; fq = ln_ >> 4; }
        const bool gh = u.pn < 2;
        unsigned char* base = ZG + ((size_t)(u.pm * 8 + (u.pn - 2)) * 2) * 65536 + ((size_t)((wr * 4 + wc) * 8) * 64 + (fq * 16 + fr)) * 16;
#pragma unroll
        for (int ai = 0; ai < 2; ++ai)
#pragma unroll
            for (int m = 0; m < 4; ++m) {
                f32x4 e[2][2];
#pragma unroll
                for (int bj = 0; bj < 2; ++bj)
#pragma unroll
                    for (int n = 0; n < 2; ++n)
#pragma unroll
                        for (int i = 0; i < 4; ++i) e[bj][n][i] = __expf(-acc[ai][bj][m][n][i]);
                if (gh) {
                    const int row = u.pm * 256 + ai * 128 + wr * 64 + m * 16 + fr;
#pragma unroll
                    for (int bj = 0; bj < 2; ++bj) {
                        f32x4 v0, v1;
#pragma unroll
                        for (int i = 0; i < 4; ++i) { v0[i] = acc[ai][bj][m][0][i] * __builtin_amdgcn_rcpf(1.0f + e[bj][0][i]); v1[i] = acc[ai][bj][m][1][i] * __builtin_amdgcn_rcpf(1.0f + e[bj][1][i]); }
                        *(u32x4*)(GH + (size_t)row * 512 + u.pn * 256 + bj * 128 + wc * 32 + 8 * fq) = pack8(v0, v1);
                    }
                } else {
                    f32x4 r0, r1, g0, g1;
#pragma unroll
                    for (int i = 0; i < 4; ++i) {
                        g0[i] = __builtin_amdgcn_rcpf(1.0f + e[1][0][i]); r0[i] = (1.0f + e[1][0][i]) * __builtin_amdgcn_rcpf(1.0f + e[0][0][i]);
                        g1[i] = __builtin_amdgcn_rcpf(1.0f + e[1][1][i]); r1[i] = (1.0f + e[1][1][i]) * __builtin_amdgcn_rcpf(1.0f + e[0][1][i]);
                    }
                    *(u32x4*)(base + (size_t)((ai * 4 + m) * 64) * 16) = pack8(r0, r1);
                    *(u32x4*)(base + 65536 + (size_t)((ai * 4 + m) * 64) * 16) = pack8(g0, g1);
                }
                __builtin_amdgcn_sched_barrier(0);
            }
        return false;
    }
};
struct EpiPlain {
    bf16_t* O;
    static constexpr bool HAS_MID = false; static constexpr int MIN_VM = 16;
    __device__ __forceinline__ bool perm(const Unit&) const { return true; }
    __device__ __forceinline__ bool operator()(f32x4 (&acc)[2][2][4][2], const Unit& u, int wr, int wc, int fr, int fq) const {
        { int ln_; asm volatile("v_mbcnt_lo_u32_b32 %0, -1, 0\n\tv_mbcnt_hi_u32_b32 %0, -1, %0" : "=v"(ln_)); fr = ln_ & 15; fq = ln_ >> 4; }
#pragma unroll
        for (int ai = 0; ai < 2; ++ai)
#pragma unroll
            for (int m = 0; m < 4; ++m) {
                const int row = u.pm * 256 + ai * 128 + wr * 64 + m * 16 + fr;
#pragma unroll
                for (int bj = 0; bj < 2; ++bj) {
                    *(u32x4*)(O + (size_t)row * D + u.pn * 256 + bj * 128 + wc * 32 + 8 * fq) = pack8(acc[ai][bj][m][0], acc[ai][bj][m][1]);
                }
            }
        return false;
    }
};
struct EpiBranch {
    static constexpr int MIN_VM = 32;
    static constexpr bool HAS_MID = true;
    const unsigned char* ZG; bf16_t* MB;
    __device__ __forceinline__ bool perm(const Unit&) const { return true; }
    __device__ __forceinline__ void mid(f32x4 (&acc)[2][2][4][2], const Unit& u, int wr, int wc) const {
        int ln_; asm volatile("v_mbcnt_lo_u32_b32 %0, -1, 0\n\tv_mbcnt_hi_u32_b32 %0, -1, %0" : "=v"(ln_));
        u32x4 w[2][8];
#pragma unroll
        for (int bj = 0; bj < 2; ++bj) {
            const unsigned char* base = ZG + ((size_t)(u.pm * 8 + (2 * u.pn + bj)) * 2) * 65536 + ((size_t)((wr * 4 + wc) * 8) * 64 + ln_) * 16;
#pragma unroll
            for (int k = 0; k < 8; ++k) w[bj][k] = *(const u32x4*)(base + (size_t)(k * 64) * 16);
        }
        __builtin_amdgcn_sched_barrier(0);
#pragma unroll
        for (int bj = 0; bj < 2; ++bj)
#pragma unroll
            for (int ai = 0; ai < 2; ++ai)
#pragma unroll
                for (int m = 0; m < 4; ++m) {
                    f32x4 g0, g1; unpack8(w[bj][ai * 4 + m], g0, g1);
                    acc[ai][bj][m][0] *= g0; acc[ai][bj][m][1] *= g1;
                }
        __builtin_amdgcn_sched_barrier(0);
    }
    __device__ __forceinline__ bool operator()(f32x4 (&acc)[2][2][4][2], const Unit& u, int wr, int wc, int fr, int fq) const {
        { int ln_; asm volatile("v_mbcnt_lo_u32_b32 %0, -1, 0\n\tv_mbcnt_hi_u32_b32 %0, -1, %0" : "=v"(ln_)); fr = ln_ & 15; fq = ln_ >> 4; }
        u32x4 w[2][8];
#pragma unroll
        for (int bj = 0; bj < 2; ++bj) {
            const unsigned char* base = ZG + ((size_t)(u.pm * 8 + (2 * u.pn + bj)) * 2 + 1) * 65536 + ((size_t)((wr * 4 + wc) * 8) * 64 + (fq * 16 + fr)) * 16;
#pragma unroll
            for (int k = 0; k < 8; ++k) w[bj][k] = *(const u32x4*)(base + (size_t)(k * 64) * 16);
        }
        __builtin_amdgcn_sched_barrier(0);
#pragma unroll
        for (int bj = 0; bj < 2; ++bj)
#pragma unroll
            for (int ai = 0; ai < 2; ++ai)
#pragma unroll
                for (int m = 0; m < 4; ++m) {
                    f32x4 g0, g1; unpack8(w[bj][ai * 4 + m], g0, g1);
                    const int row = u.pm * 256 + ai * 128 + wr * 64 + m * 16 + fr;
                    *(u32x4*)(MB + (size_t)row * D + u.pn * 256 + bj * 128 + wc * 32 + 8 * fq) = pack8(acc[ai][bj][m][0] * g0, acc[ai][bj][m][1] * g1);
                }
        return false;
    }
};
struct EpiSwiglu {
    bf16_t* H;
    static constexpr bool HAS_MID = false; static constexpr int MIN_VM = 8;
    __device__ __forceinline__ bool perm(const Unit&) const { return true; }
    __device__ __forceinline__ bool operator()(f32x4 (&acc)[2][2][4][2], const Unit& u, int wr, int wc, int fr, int fq) const {
        { int ln_; asm volatile("v_mbcnt_lo_u32_b32 %0, -1, 0\n\tv_mbcnt_hi_u32_b32 %0, -1, %0" : "=v"(ln_)); fr = ln_ & 15; fq = ln_ >> 4; }
#pragma unroll
        for (int ai = 0; ai < 2; ++ai)
#pragma unroll
            for (int m = 0; m < 4; ++m) {
                const int row = u.pm * 256 + ai * 128 + wr * 64 + m * 16 + fr;
                f32x4 h[2];
#pragma unroll
                for (int n = 0; n < 2; ++n) {
                    const f32x4 g = acc[ai][0][m][n], up = acc[ai][1][m][n];
#pragma unroll
                    for (int i = 0; i < 4; ++i) h[n][i] = siluf_(g[i]) * up[i];
                }
                *(u32x4*)(H + (size_t)row * D + u.pn * 128 + wc * 32 + 8 * fq) = pack8(h[0], h[1]);
            }
        return false;
    }
};
struct MoeSched1 {
    const char* XS; const char* W; const int* SEL; int total, G, c;
    __device__ __forceinline__ bool next(int i, Unit& u) const {
        const int L = i * G + c; if (L >= total) return false;
        if (L < 4096) { const int b = L & 7, rt = (L >> 3) & 3, j = (L >> 5) & 7, e = L >> 8; u.pm = (b * NE + e) * 4 + rt; u.pn = j; u.aux = e; }
        else { const int q = L - 4096; u.pn = q & 7; u.aux = q >> 3; u.pm = 512 + u.aux; }
        return true;
    }
    __device__ __forceinline__ const char* aptr(const Unit&) const { return XS; }
    __device__ __forceinline__ unsigned arow(const Unit& u, int r) const { return (unsigned)SEL[u.pm * 256 + r] * (unsigned)(D * 2); }
    __device__ __forceinline__ const int* selrow(const Unit& u) const { return SEL + u.pm * 256; }
    __device__ __forceinline__ const char* bptr(const Unit& u) const { return W + ((size_t)u.aux * 2048 + (size_t)u.pn * 256) * D * 2; }
};
struct MoeSched2 {
    const char* HB; const char* W; int total, G, c;
    __device__ __forceinline__ bool next(int i, Unit& u) const {
        const int L = i * G + c; if (L >= total) return false;
        if (L < 2048) { const int b = L & 7, rt = (L >> 3) & 3, j = (L >> 5) & 3, e = L >> 7; u.pm = (b * NE + e) * 4 + rt; u.pn = j; u.aux = e; }
        else { const int q = L - 2048; u.pn = q & 3; u.aux = q >> 2; u.pm = 512 + u.aux; }
        return true;
    }
    __device__ __forceinline__ const char* aptr(const Unit& u) const { return HB + (size_t)u.pm * 256 * D * 2; }
    __device__ __forceinline__ const char* bptr(const Unit& u) const { return W + ((size_t)u.aux * 1024 + (size_t)u.pn * 256) * D * 2; }
};

__device__ __forceinline__ void transpose_item(const float* W, int srcN, int k0, int n0, bf16_t* WT, int dpitch, int drow0, int dcol0, LAS float* scr, int lane) {
    float wv[32];
#pragma unroll
    for (int i = 0; i < 32; ++i) { const int kk = 2 * i + (lane >> 5); wv[i] = __builtin_nontemporal_load(W + (size_t)(k0 + kk) * srcN + n0 + (lane & 31)); }
    __builtin_amdgcn_sched_barrier(0);
#pragma unroll
    for (int i = 0; i < 32; ++i) { const int kk = 2 * i + (lane >> 5); scr[kk * 33 + (lane & 31)] = wv[i]; }
    asm volatile("s_waitcnt lgkmcnt(0)" ::: "memory");
    const int c = lane & 7;
#pragma unroll
    for (int j = 0; j < 4; ++j) { const int n = (lane >> 3) + 8 * j; const LAS float* s = scr + (8 * c) * 33 + n;
        u32x4 o; o.x = pk2(s[0 * 33], s[1 * 33]); o.y = pk2(s[2 * 33], s[3 * 33]); o.z = pk2(s[4 * 33], s[5 * 33]); o.w = pk2(s[6 * 33], s[7 * 33]);
        *(u32x4*)(WT + (size_t)(drow0 + n) * dpitch + dcol0 + k0 + 8 * c) = o; }
    asm volatile("s_waitcnt lgkmcnt(0)" ::: "memory");
}
constexpr int CV_IN = 16 * (IN_DIM / 32), CV_BR = 8 * 32, CV_OUT = 16 * 32, CV_E = 16 * 32;
constexpr int CV_DENSE = CV_IN + 2 * CV_BR + CV_OUT, CV_GU_END = CV_DENSE + NE * 2 * CV_E, CV_ITEMS = CV_GU_END + NE * CV_E;
__device__ __forceinline__ bf16_t* weights_of(const Frame& F, const Args& a, int l) { return l == 0 ? (bf16_t*)(F.ws + WS_W) : (bf16_t*)((unsigned char*)a.out + W1_OFF); }
__device__ __forceinline__ void convert_weights(const Frame& F, const Args& a, int l, int it_lo, int it_hi, int worker, int nworkers) {
    LAS float* scr = (LAS float*)(F.lds + F.wave * 8448);
    bf16_t* Wb = weights_of(F, a, l);
    bf16_t* WIN = Wb + W_IN / 2; bf16_t* WBR = Wb + W_BR / 2; bf16_t* WOUT = Wb + W_OUT / 2; bf16_t* WGU = Wb + W_GU / 2; bf16_t* WDN = Wb + W_DN / 2;
    constexpr int I_IN = CV_IN, I_BR = CV_BR, I_OUT = CV_OUT, I_E = CV_E;
    const int gw = worker * 8 + F.wave, NGW = nworkers * 8;
    for (int it = it_lo + gw; it < it_hi; it += NGW) {
        int r = it;
        if (r < I_IN) { const int nblk = IN_DIM / 32, kb = r / nblk, nb = r % nblk; const int src = 32 * nb; int d0;
            if (src < 768) d0 = src;
            else if (src < 1280) { const int j = (src - 768) >> 7, c = (src - 768) & 127; d0 = 768 + 256 * j + c; }
            else if (src < 1792) { const int j = (src - 1280) >> 7, c = (src - 1280) & 127; d0 = 768 + 256 * j + 128 + c; }
            else if (src < 2304) d0 = 1792 + (src - 1792);
            else if (src < 2816) d0 = 2304 + (src - 2304);
            else if (src < 3328) d0 = N1 + (src - 2816);
            else if (src < 4352) { const int c = src - 3328; d0 = N1 + 512 + 256 * (c >> 7) + (c & 127); }
            else { const int c = src - 4352; d0 = N1 + 512 + 256 * (c >> 7) + 128 + (c & 127); }
            transpose_item(a.w_in + (size_t)l * D * IN_DIM, IN_DIM, 64 * kb, src, WIN, D, d0, 0, scr, F.lane);
            continue; } r -= I_IN;
        if (r < I_BR) { const int kb = r / 32, nb = r % 32; transpose_item(a.w_bra + (size_t)l * 512 * D, D, 64 * kb, 32 * nb, WBR, D, 32 * nb, 0, scr, F.lane); continue; } r -= I_BR;
        if (r < I_BR) { const int kb = r / 32, nb = r % 32; transpose_item(a.w_brh + (size_t)l * 512 * D, D, 64 * kb, 32 * nb, WBR, D, 32 * nb, 512, scr, F.lane); continue; } r -= I_BR;
        if (r < I_OUT) { const int kb = r / 32, nb = r % 32; transpose_item(a.w_out + (size_t)l * D * D, D, 64 * kb, 32 * nb, WOUT, D, 32 * nb, 0, scr, F.lane); continue; } r -= I_OUT;
        if (r < NE * 2 * I_E) {
            const int e = r / (2 * I_E), q = r % (2 * I_E), which = q / I_E, s = q % I_E, kb = s / 32, nb = s % 32;
            const size_t eoff = ((size_t)l * NE + e) * D * D;
            if (which == 0) transpose_item(a.w_gate + eoff, D, 64 * kb, 32 * nb, WGU + (size_t)e * 2048 * D, D, (nb >> 2) * 256 + (nb & 3) * 32, 0, scr, F.lane);
            else            transpose_item(a.w_up + eoff, D, 64 * kb, 32 * nb, WGU + (size_t)e * 2048 * D, D, (nb >> 2) * 256 + 128 + (nb & 3) * 32, 0, scr, F.lane);
            continue; } r -= NE * 2 * I_E;
        { const int e = r / I_E, s = r % I_E, kb = s / 32, nb = s % 32;
          transpose_item(a.w_down + ((size_t)l * NE + e) * D * D, D, 64 * kb, 32 * nb, WDN + (size_t)e * D * D, D, 32 * nb, 0, scr, F.lane); }
    }
}
__device__ __forceinline__ void convert_in_tail(const Frame& F, const Args& a, int total, int l, int it_lo, int it_hi) {
    const int rem = total % F.G, c = F.bx;
    if (rem == 0) convert_weights(F, a, l, it_lo, it_hi, c, F.G);
    else if (c >= rem) convert_weights(F, a, l, it_lo, it_hi, c - rem, F.G - rem);
}
constexpr int CVS_P0 = CV_DENSE;
constexpr int CVS_A = CVS_P0 + 9000, CVS_B = CVS_A + 6500;
constexpr int CVS_C = CV_DENSE + 4000, CVS_D = CVS_C + 5000;
static_assert(CVS_B < CV_ITEMS && CVS_D < CV_GU_END, "conversion slices");
__device__ __forceinline__ void mod_items(const Frame& F, const Args& a) {
    LAS float* sct = (LAS float*)(F.lds + 69632);
    LAS float* red = (LAS float*)(F.lds);
    if (blockIdx.x < 192) {
        for (int i = F.tid; i < 9 * 1024; i += 512) { const int g = i >> 10, k = i & 1023; const float cv = g < NB ? a.c[g * D + k] : a.c_ctx[k]; sct[k * 12 + g] = siluf_(cv); }
    }
    __syncthreads();
    if (blockIdx.x < 192) {
        const int it = blockIdx.x, l = it / 96, n = (it % 96) * 64 + F.lane;
        const float* W = a.w_mod + (size_t)l * D * 6144 + n;
        float acc[9];
#pragma unroll
        for (int g = 0; g < 9; ++g) acc[g] = 0.f;
        for (int k0 = 128 * F.wave; k0 < 128 * F.wave + 128; k0 += 16) {
            float w[16];
#pragma unroll
            for (int j = 0; j < 16; ++j) w[j] = W[(size_t)(k0 + j) * 6144];
#pragma unroll
            for (int j = 0; j < 16; ++j) {
                const f32x4 s0 = *(const LAS f32x4*)(sct + (k0 + j) * 12), s1 = *(const LAS f32x4*)(sct + (k0 + j) * 12 + 4); const float s8 = sct[(k0 + j) * 12 + 8];
                acc[0] += s0[0] * w[j]; acc[1] += s0[1] * w[j]; acc[2] += s0[2] * w[j]; acc[3] += s0[3] * w[j];
                acc[4] += s1[0] * w[j]; acc[5] += s1[1] * w[j]; acc[6] += s1[2] * w[j]; acc[7] += s1[3] * w[j]; acc[8] += s8 * w[j];
            }
        }
#pragma unroll
        for (int g = 0; g < 9; ++g) red[(F.wave * 9 + g) * 64 + F.lane] = acc[g];
    }
    __syncthreads();
    if (blockIdx.x < 192) {
        const int it = blockIdx.x, l = it / 96;
        float* MOD = (float*)(F.ws + WS_MOD);
        for (int i = F.tid; i < 9 * 64; i += 512) { const int g = i >> 6, ln = i & 63; const int n = (it % 96) * 64 + ln;
            float v = a.b_mod[l * 6144 + n];
#pragma unroll
            for (int w = 0; w < 8; ++w) v += red[(w * 9 + g) * 64 + ln];
            MOD[(size_t)(l * 9 + g) * 6144 + n] = v; }
    }
    __syncthreads();
}
__device__ __forceinline__ void small_tables(const Frame& F, const Args& a) {
    if (blockIdx.x == gridDim.x - 1) {
        float* rope = (float*)(F.ws + WS_ROPE);
        for (int i = F.tid; i < 2048; i += 512) { const int pos = i >> 4, d = i & 15; const float inv = powf(10000.0f, -(float)d / 16.0f); const float ang = (float)pos * inv; rope[i] = cosf(ang); rope[2048 + i] = sinf(ang); }
        float* LB = (float*)(F.ws + WS_LB);
        for (int i = F.tid; i < 1024; i += 512) { const int dir = i >> 9, k = i & 511; const float* src = dir ? a.lb_bw : a.lb_fw;
            const float a0 = src[k], a1 = src[512 + k]; const float mx = fmaxf(a0, a1); const float e0 = expf(a0 - mx), e1 = expf(a1 - mx);
            LB[0 * 1024 + i] = 0.0f; LB[1 * 1024 + i] = e1 / (e0 + e1); }
    }
}
__device__ __forceinline__ void ln_mod_rows(const Frame& F, const Args& a) {
    const float* MOD = (const float*)(F.ws + WS_MOD);
    bf16_t* U = (bf16_t*)(F.ws + WS_U);
    const int gw = F.vcu * 8 + F.wave, NGW = F.G * 8, lane = F.lane;
    f32x4 xr[4][4];
    auto ld = [&](int grp) {
        const int row0 = grp * 4;
        const float* xin = row0 < NLAT ? a.x + (size_t)row0 * D : a.ctx + (size_t)(row0 - NLAT) * D;
#pragma unroll
        for (int s2 = 0; s2 < 2; ++s2)
#pragma unroll
            for (int r = 0; r < 4; ++r) { const int c0 = 512 * s2 + 8 * lane; xr[r][2 * s2] = *(const f32x4*)(xin + (size_t)r * D + c0); xr[r][2 * s2 + 1] = *(const f32x4*)(xin + (size_t)r * D + c0 + 4); }
    };
    if (gw < MROWS / 4) ld(gw);
    for (int grp = gw; grp < MROWS / 4; grp += NGW) {
        const int row0 = grp * 4;
        const float* md = MOD + (size_t)(0 * 9 + mod_group(row0)) * 6144;
        f32x4 v[4][4];
#pragma unroll
        for (int r = 0; r < 4; ++r)
#pragma unroll
            for (int q = 0; q < 4; ++q) v[r][q] = xr[r][q];
        if (grp + NGW < MROWS / 4) ld(grp + NGW);
        float rstd[4];
#pragma unroll
        for (int r = 0; r < 4; ++r) {
            const float mean = wsum((hsum4(v[r][0]) + hsum4(v[r][1])) + (hsum4(v[r][2]) + hsum4(v[r][3]))) * (1.f / D);
#pragma unroll
            for (int q = 0; q < 4; ++q) v[r][q] = v[r][q] - mean;
            rstd[r] = 1.0f / sqrtf(wsum((hsq4(v[r][0]) + hsq4(v[r][1])) + (hsq4(v[r][2]) + hsq4(v[r][3]))) * (1.f / D) + LN_EPS);
        }
#pragma unroll
        for (int s2 = 0; s2 < 2; ++s2) {
            const int c0 = 512 * s2 + 8 * lane;
            const f32x4 sca = *(const f32x4*)(md + 1024 + c0) + 1.0f, scb = *(const f32x4*)(md + 1024 + c0 + 4) + 1.0f, sha = *(const f32x4*)(md + c0), shb = *(const f32x4*)(md + c0 + 4);
#pragma unroll
            for (int r = 0; r < 4; ++r) *(u32x4*)(U + (size_t)(row0 + r) * D + c0) = pack8(v[r][2 * s2] * rstd[r] * sca + sha, v[r][2 * s2 + 1] * rstd[r] * scb + shb);
        }
    }
}

constexpr int AT_PITCH = 144;
__device__ __forceinline__ int crow(int r, int hi) { return (r & 3) + 8 * (r >> 2) + 4 * hi; }
typedef short v4i16_t __attribute__((ext_vector_type(4)));
__device__ __forceinline__ s16x4 tr_read(const LAS unsigned char* p) { return __builtin_bit_cast(s16x4, __builtin_amdgcn_ds_read_tr16_b64_v4i16((LAS v4i16_t*)p)); }

__device__ __forceinline__ void attn_unit(const Frame& F, const bf16_t* Z1, bf16_t* AH, const float* sink, int qrow0, int g, int crow0, int wrow0, int nb) {
    const int tid = F.tid, lane = F.lane, wid = F.wave, r32 = lane & 31, hi = lane >> 5;
    const int hh = wid >> 1, th = wid & 1, head = 4 * g + hh;
    LAS unsigned char* Kt = F.lds; LAS unsigned char* Vt = F.lds + 2 * 64 * AT_PITCH;
    bf16x8 qf[2][4];
#pragma unroll
    for (int qb = 0; qb < 2; ++qb)
#pragma unroll
        for (int s = 0; s < 4; ++s) qf[qb][s] = *(const bf16x8*)(Z1 + (size_t)(qrow0 + 64 * th + 32 * qb + r32) * ZQP + ZC_Q + 64 * head + 16 * s + 8 * hi);
    f32x16 ot[2][2];
#pragma unroll
    for (int a = 0; a < 2; ++a)
#pragma unroll
        for (int b = 0; b < 2; ++b) ot[a][b] = (f32x16){};
    const float sk = sink[head] * 1.44269504089f;
    float mrun[2] = {sk, sk}, lsum[2] = {hi == 0 ? 1.0f : 0.0f, hi == 0 ? 1.0f : 0.0f};
    const int srow = tid >> 3, sch = tid & 7;
    u32x4 kreg, vreg;
    auto tile_row0 = [&](int ti) -> int { if (ti < 4) return crow0 + 64 * ti; if (nb < 0) return -1; const int ts = 128 * nb - 128 + 64 * (ti - 4); return (ts < 0 || ts >= SEQ) ? -1 : wrow0 + ts; };
    auto load_tile = [&](int row0) { const bf16_t* p = Z1 + (size_t)(row0 + srow) * ZQP + 64 * g + 8 * sch; kreg = *(const u32x4*)(p + ZC_K); vreg = *(const u32x4*)(p + ZC_V); };
    int ti = 0; int row0 = tile_row0(0); load_tile(row0);
    int buf = 0;
    while (ti < 10) {
        *(LAS u32x4*)(Kt + buf * 64 * AT_PITCH + srow * AT_PITCH + sch * 16) = kreg;
        *(LAS u32x4*)(Vt + buf * 64 * AT_PITCH + srow * AT_PITCH + sch * 16) = vreg;
        __syncthreads();
        int tn = ti + 1, rown = -1;
        while (tn < 10) { rown = tile_row0(tn); if (rown >= 0) break; ++tn; }
        if (tn < 10) load_tile(rown);
        const bool win = ti >= 4;
        const int w = ti - 4;
        const bool skip = win && ((th == 0 && w == 5) || (th == 1 && w == 0));
        if (!skip) {
            const LAS unsigned char* Kb = Kt + buf * 64 * AT_PITCH; const LAS unsigned char* Vb = Vt + buf * 64 * AT_PITCH;
#pragma unroll
            for (int kb = 0; kb < 2; ++kb) {
                bf16x8 kf[4];
#pragma unroll
                for (int s = 0; s < 4; ++s) kf[s] = *(const LAS bf16x8*)(Kb + (32 * kb + r32) * AT_PITCH + (16 * s + 8 * hi) * 2);
                f32x16 sc[2];
#pragma unroll
                for (int qb = 0; qb < 2; ++qb) { sc[qb] = (f32x16){};
#pragma unroll
                    for (int s = 0; s < 4; ++s) sc[qb] = __builtin_amdgcn_mfma_f32_32x32x16_bf16(kf[s], qf[qb][s], sc[qb], 0, 0, 0); }
                bf16x8 pb[2][2];
#pragma unroll
                for (int qb = 0; qb < 2; ++qb) {
                    if (win && (w == th || w == th + 4)) {
                        const int irel = 64 * th + 32 * qb + r32;
                        const int jrel0 = -128 + 64 * w + 32 * kb;
#pragma unroll
                        for (int r = 0; r < 16; ++r) { const int dj = jrel0 + crow(r, hi) - irel; if (dj > 128 || dj < -128) sc[qb][r] = -INFINITY; }
                    }
                    float mx = sc[qb][0];
#pragma unroll
                    for (int r = 1; r < 16; ++r) mx = fmaxf(mx, sc[qb][r]);
                    { const auto sw = __builtin_amdgcn_permlane32_swap(__float_as_uint(mx), __float_as_uint(mx), false, false); mx = fmaxf(__uint_as_float(sw[0]), __uint_as_float(sw[1])); }
                    const float mnew = fmaxf(mrun[qb], mx);
                    const float fsc = __builtin_amdgcn_exp2f(mrun[qb] - mnew);
                    mrun[qb] = mnew;
                    float p[16];
                    f32x2_t ps2 = {0.f, 0.f};
                    const f32x2_t mn2 = {mnew, mnew};
#pragma unroll
                    for (int r = 0; r < 16; r += 2) { const f32x2_t d = (f32x2_t){sc[qb][r], sc[qb][r + 1]} - mn2; p[r] = __builtin_amdgcn_exp2f(d[0]); p[r + 1] = __builtin_amdgcn_exp2f(d[1]); ps2 += (f32x2_t){p[r], p[r + 1]}; }
                    const float ps = ps2[0] + ps2[1];
                    lsum[qb] = lsum[qb] * fsc + ps;
                    if (__any(fsc != 1.0f)) {
#pragma unroll
                        for (int dbl = 0; dbl < 2; ++dbl)
#pragma unroll
                            for (int r = 0; r < 16; ++r) ot[qb][dbl][r] *= fsc;
                    }
#pragma unroll
                    for (int s2 = 0; s2 < 2; ++s2) { u32x4 wv; wv.x = pk2(p[8 * s2 + 0], p[8 * s2 + 1]); wv.y = pk2(p[8 * s2 + 2], p[8 * s2 + 3]); wv.z = pk2(p[8 * s2 + 4], p[8 * s2 + 5]); wv.w = pk2(p[8 * s2 + 6], p[8 * s2 + 7]);
                        pb[qb][s2] = __builtin_bit_cast(bf16x8, wv); }
                }
#pragma unroll
                for (int dbl = 0; dbl < 2; ++dbl)
#pragma unroll
                    for (int s2 = 0; s2 < 2; ++s2) {
                        const int kv0 = 32 * kb + 16 * s2 + 4 * hi + ((lane & 15) >> 2);
                        const int dcol = 32 * dbl + 16 * ((lane >> 4) & 1) + 4 * (lane & 3);
                        const s16x4 lo = tr_read(Vb + kv0 * AT_PITCH + dcol * 2);
                        const s16x4 hi4 = tr_read(Vb + (kv0 + 8) * AT_PITCH + dcol * 2);
                        const bf16x8 va = (bf16x8){lo[0], lo[1], lo[2], lo[3], hi4[0], hi4[1], hi4[2], hi4[3]};
#pragma unroll
                        for (int qb = 0; qb < 2; ++qb) ot[qb][dbl] = __builtin_amdgcn_mfma_f32_32x32x16_bf16(va, pb[qb][s2], ot[qb][dbl], 0, 0, 0);
                    }
            }
        }
        ti = tn; buf ^= 1;
    }
    __syncthreads();
#pragma unroll
    for (int qb = 0; qb < 2; ++qb) {
        float lt; { const auto sw = __builtin_amdgcn_permlane32_swap(__float_as_uint(lsum[qb]), __float_as_uint(lsum[qb]), false, false); lt = __uint_as_float(sw[0]) + __uint_as_float(sw[1]); }
        const float inv = 1.0f / lt;
        bf16_t* orow = AH + (size_t)(qrow0 + 64 * th + 32 * qb + r32) * D + 64 * head;
#pragma unroll
        for (int dbl = 0; dbl < 2; ++dbl)
#pragma unroll
            for (int gq = 0; gq < 4; ++gq) {
                const f32x4 v = (f32x4){ot[qb][dbl][4 * gq + 0], ot[qb][dbl][4 * gq + 1], ot[qb][dbl][4 * gq + 2], ot[qb][dbl][4 * gq + 3]} * inv;
                *(u32x2*)(orow + 32 * dbl + 8 * gq + 4 * hi) = pack4(v);
            }
    }
}
__device__ __forceinline__ void attn_phase(const Frame& F, const Args& a, int l) {
    const bf16_t* Z1 = (const bf16_t*)(F.ws + WS_Z); bf16_t* AH = (bf16_t*)(F.ws + WS_AH);
    const float* sink = a.attn_sink + l * 8;
    const int total = 1024 + (l == 0 ? 32 : 0);
    for (int u = F.vcu; u < total; u += F.G) {
        if (u < 1024) { const int g = u & 1, nb = (u >> 1) & 63, b = u >> 7; attn_unit(F, Z1, AH, sink, b * SEQ + 128 * nb, g, NLAT + b * CTXL, b * SEQ, nb); }
        else { const int q = u - 1024, g = q & 1, half = (q >> 1) & 1, b = q >> 2; attn_unit(F, Z1, AH, sink, NLAT + b * CTXL + 128 * half, g, NLAT + b * CTXL, 0, -1); }
    }
}

constexpr int HG_P128 = 272, HG_PV = 80;
constexpr int HG_QK = 0, HG_QKSZ = 2 * 64 * HG_P128;
constexpr int HG_VT = 2 * HG_QKSZ, HG_VTSZ = 64 * HG_PV;
constexpr int HG_ST = HG_VT + 2 * HG_VTSZ, HG_STSZ = 32 * HG_P128, HG_END = HG_ST + 2 * HG_STSZ;
static_assert(HG_END <= RING_BYTES, "hgrn LDS");
__device__ __forceinline__ int hg_row(int b, int dir, int c, int t) {
    const int p = 64 * (c < 4 ? c : c - 4) + t;
    if (c < 4) return NLAT + b * CTXL + (dir ? (CTXL - 1 - p) : p);
    return b * SEQ + (dir ? (SEQ - 1 - p) : p);
}
template <int V> struct IntC { static constexpr int value = V; };
__device__ __forceinline__ void hgrn_item(const Frame& F, const bf16_t* Z1, const float* VECS, const bf16_t* QS  , bf16_t* OUT  , int b, int h, int dir, int vq) {
    const int tid = F.tid, lane = F.lane, wid = F.wave;
    LAS unsigned char* L = F.lds;
    const int sr = tid >> 3, sc8 = tid & 7;
    const int tv = tid >> 2, vp = tid & 3;
    const int fr = lane & 15, fq = lane >> 4;
    const int tb = wid < 4 ? (wid >> 1) : 3 - ((wid - 4) >> 1), vb = wid & 1;
    const int NC = 132;
    const size_t zq = (ZO_HG + (size_t)((dir * 4 + h) * 2) * ZA_BYTES) / 2, zk = zq + ZA_BYTES / 2;
    for (int i = tid; i < 2 * HG_STSZ / 4; i += 512) ((LAS unsigned*)(L + HG_ST))[i] = 0u;
    f32x4 Sacc[2]; Sacc[0] = (f32x4){0.f, 0.f, 0.f, 0.f}; Sacc[1] = Sacc[0];
    struct GSet { u32x4 q[2], k[2], v, qx[2]; };
    GSet g0, g1; f32x4 mte, mdc;
    g0.v = (u32x4){0u, 0u, 0u, 0u}; g1.v = g0.v; mte = (f32x4){0.f, 0.f, 0.f, 0.f}; mdc = mte;
    auto hg_load = [&](int c, GSet& g) {
        const int row_ = hg_row(b, dir, c, sr); const bf16_t* p_ = Z1 + (size_t)row_ * 128 + 16 * sc8;
        g.q[0] = *(const u32x4*)(p_ + zq); g.q[1] = *(const u32x4*)(p_ + zq + 8); g.k[0] = *(const u32x4*)(p_ + zk); g.k[1] = *(const u32x4*)(p_ + zk + 8);
        if (dir) { const bf16_t* qp_ = QS + (size_t)row_ * D + 512 + h * 128 + 16 * sc8; g.qx[0] = *(const u32x4*)qp_; g.qx[1] = *(const u32x4*)(qp_ + 8); }
        if (tid < 256) { const int rv_ = hg_row(b, dir, c, tv); g.v = *(const u32x4*)(Z1 + (ZO_IH + (size_t)h * ZA_BYTES) / 2 + (size_t)rv_ * 128 + vq * 32 + 8 * vp); }
    };
    f32x4 pte = (f32x4){0.f, 0.f, 0.f, 0.f}, pdc = pte, pee = pte;
    auto hv_load = [&](int c) { const float* vp_ = VECS + ((size_t)(dir * NCHUNK + (hg_row(b, dir, c, 0) >> 6)) * 3) * 512 + h * 128 + 16 * wid + 4 * fq;
        pte = *(const f32x4*)vp_; pdc = *(const f32x4*)(vp_ + 512); pee = *(const f32x4*)(vp_ + 1024); };
    hv_load(0);
    hg_load(0, g0); hg_load(1, g1);
    __syncthreads();
    auto step = [&](int it, GSet& g, auto parc) {
        constexpr int PAR = decltype(parc)::value;
        const f32x4 eenext = pee, tenext = pte, dcnext = pdc;
        if (it + 1 < NC) hv_load(it + 1);
        if (it < NC) {
            constexpr int pp = PAR;
            LAS unsigned char* QMt = L + HG_QK + pp * HG_QKSZ; LAS unsigned char* KMt = QMt + 64 * HG_P128;
            if (dir) {
#pragma unroll
                for (int j = 0; j < 2; ++j) { f32x4 e0, e1, q0, q1; unpack8(g.q[j], e0, e1); unpack8(g.qx[j], q0, q1); g.q[j] = pack8(e0 * q0, e1 * q1); }
            }
            *(LAS u32x4*)(QMt + sr * HG_P128 + 32 * sc8) = g.q[0]; *(LAS u32x4*)(QMt + sr * HG_P128 + 32 * sc8 + 16) = g.q[1];
            *(LAS u32x4*)(KMt + sr * HG_P128 + 32 * sc8) = g.k[0]; *(LAS u32x4*)(KMt + sr * HG_P128 + 32 * sc8 + 16) = g.k[1];
            if (tid < 256) *(LAS u32x4*)(L + HG_VT + pp * HG_VTSZ + tv * HG_PV + 16 * vp) = g.v;
        }
        const f32x4 cte = mte, cdc = mdc;
        __builtin_amdgcn_sched_barrier(0);
        if (it + 2 < NC) hg_load(it + 2, g);
        __builtin_amdgcn_sched_barrier(0);
        if (it >= 1) {
            const int c = it - 1; constexpr int pm = 1 - PAR;
            const LAS unsigned char* QMt = L + HG_QK + pm * HG_QKSZ; const LAS unsigned char* KMt = QMt + 64 * HG_P128;
            const LAS unsigned char* Vt = L + HG_VT + pm * HG_VTSZ;
            const LAS unsigned char* STr = L + HG_ST + pm * HG_STSZ;
            bf16x8 qbs[4], sas[4], ka[4][2];
#pragma unroll
            for (int s = 0; s < 4; ++s) {
                qbs[s] = *(const LAS bf16x8*)(QMt + (16 * tb + fr) * HG_P128 + (32 * s + 8 * fq) * 2);
                sas[s] = *(const LAS bf16x8*)(STr + (16 * vb + fr) * HG_P128 + (32 * s + 8 * fq) * 2);
                ka[s][0] = *(const LAS bf16x8*)(KMt + fr * HG_P128 + (32 * s + 8 * fq) * 2);
            }
            if (tb >= 1) {
#pragma unroll
                for (int s = 0; s < 4; ++s) ka[s][1] = *(const LAS bf16x8*)(KMt + (16 + fr) * HG_P128 + (32 * s + 8 * fq) * 2);
            }
            __builtin_amdgcn_sched_barrier(0);
            f32x4 sc4[4], ov = (f32x4){0.f, 0.f, 0.f, 0.f}, sv[2];
#pragma unroll
            for (int sb = 0; sb < 4; ++sb) sc4[sb] = (f32x4){0.f, 0.f, 0.f, 0.f};
            sv[0] = (f32x4){0.f, 0.f, 0.f, 0.f}; sv[1] = sv[0];
#pragma unroll
            for (int s = 0; s < 4; ++s) {
                sc4[0] = __builtin_amdgcn_mfma_f32_16x16x32_bf16(ka[s][0], qbs[s], sc4[0], 0, 0, 0);
                ov = __builtin_amdgcn_mfma_f32_16x16x32_bf16(sas[s], qbs[s], ov, 0, 0, 0);
            }
            if (tb >= 1) {
#pragma unroll
                for (int s = 0; s < 4; ++s) sc4[1] = __builtin_amdgcn_mfma_f32_16x16x32_bf16(ka[s][1], qbs[s], sc4[1], 0, 0, 0);
            }
            if (tb >= 2) {
#pragma unroll
                for (int s = 0; s < 4; ++s) ka[s][0] = *(const LAS bf16x8*)(KMt + (32 + fr) * HG_P128 + (32 * s + 8 * fq) * 2);
                if (tb >= 3) {
#pragma unroll
                    for (int s = 0; s < 4; ++s) ka[s][1] = *(const LAS bf16x8*)(KMt + (48 + fr) * HG_P128 + (32 * s + 8 * fq) * 2);
                }
#pragma unroll
                for (int s = 0; s < 4; ++s) sc4[2] = __builtin_amdgcn_mfma_f32_16x16x32_bf16(ka[s][0], qbs[s], sc4[2], 0, 0, 0);
                if (tb >= 3) {
#pragma unroll
                    for (int s = 0; s < 4; ++s) sc4[3] = __builtin_amdgcn_mfma_f32_16x16x32_bf16(ka[s][1], qbs[s], sc4[3], 0, 0, 0);
                }
            }
            bf16x8 va[2], kfr[2], vf[2][2];
#pragma unroll
            for (int p2 = 0; p2 < 2; ++p2) {
                const int vrow = 32 * p2 + 4 * fq + ((lane & 15) >> 2), vcolb = (16 * vb + 4 * (lane & 3)) * 2;
                const s16x4 lo = tr_read(Vt + vrow * HG_PV + vcolb), hi4 = tr_read(Vt + (vrow + 16) * HG_PV + vcolb);
                va[p2] = (bf16x8){lo[0], lo[1], lo[2], lo[3], hi4[0], hi4[1], hi4[2], hi4[3]};
                const int krow = 32 * p2 + 8 * fq + ((lane & 15) >> 2), kcolb = (16 * wid + 4 * (lane & 3)) * 2;
                const s16x4 klo = tr_read(KMt + krow * HG_P128 + kcolb), khi = tr_read(KMt + (krow + 4) * HG_P128 + kcolb);
                kfr[p2] = (bf16x8){klo[0], klo[1], klo[2], klo[3], khi[0], khi[1], khi[2], khi[3]};
#pragma unroll
                for (int v2 = 0; v2 < 2; ++v2) {
                    const int v2colb = (16 * v2 + 4 * (lane & 3)) * 2;
                    const s16x4 l2 = tr_read(Vt + krow * HG_PV + v2colb), h2 = tr_read(Vt + (krow + 4) * HG_PV + v2colb);
                    vf[v2][p2] = (bf16x8){l2[0], l2[1], l2[2], l2[3], h2[0], h2[1], h2[2], h2[3]};
                }
            }
#pragma unroll
            for (int s = 0; s < 2; ++s) { sv[0] = __builtin_amdgcn_mfma_f32_16x16x32_bf16(kfr[s], vf[0][s], sv[0], 0, 0, 0); sv[1] = __builtin_amdgcn_mfma_f32_16x16x32_bf16(kfr[s], vf[1][s], sv[1], 0, 0, 0); }
#pragma unroll
            for (int sb = 0; sb < 4; ++sb) if (tb == sb) {
#pragma unroll
                for (int r = 0; r < 4; ++r) if (4 * fq + r > fr) sc4[sb][r] = 0.f;
            }
            {
                const u32x2 blo = pack4(sc4[0]), bhi = pack4(sc4[1]);
                const bf16x8 ab = __builtin_bit_cast(bf16x8, (u32x4){blo.x, blo.y, bhi.x, bhi.y});
                ov = __builtin_amdgcn_mfma_f32_16x16x32_bf16(va[0], ab, ov, 0, 0, 0);
            }
            if (tb >= 2) {
                const u32x2 blo = pack4(sc4[2]), bhi = pack4(sc4[3]);
                const bf16x8 ab = __builtin_bit_cast(bf16x8, (u32x4){blo.x, blo.y, bhi.x, bhi.y});
                ov = __builtin_amdgcn_mfma_f32_16x16x32_bf16(va[1], ab, ov, 0, 0, 0);
            }
            { const int row = hg_row(b, dir, c, 16 * tb + fr);
              *(u32x2*)(OUT + (size_t)row * 512 + h * 128 + vq * 32 + 16 * vb + 4 * fq) = pack4(ov); }
            Sacc[0] = Sacc[0] * cdc + sv[0] * cte; Sacc[1] = Sacc[1] * cdc + sv[1] * cte;
            if (it < NC) {
#pragma unroll
                for (int v2 = 0; v2 < 2; ++v2) *(LAS u32x2*)(L + HG_ST + PAR * HG_STSZ + (16 * v2 + fr) * HG_P128 + (16 * wid + 4 * fq) * 2) = pack4(Sacc[v2] * eenext);
            }
        }
        mte = tenext; mdc = dcnext;
        asm volatile("s_waitcnt lgkmcnt(0)" ::: "memory"); __builtin_amdgcn_s_barrier(); asm volatile("" ::: "memory");
    };
    for (int it = 0; it <= NC; it += 2) { step(it, g0, IntC<0>{}); if (it + 1 <= NC) step(it + 1, g1, IntC<1>{}); }
}
__device__ __forceinline__ void hgrn_phase(const Frame& F) {
    const bf16_t* Z1 = (const bf16_t*)(F.ws + WS_Z);
    bf16_t* OFW = (bf16_t*)(F.ws + WS_O); bf16_t* OBW = OFW + (size_t)MROWS * 512;
    for (int it = F.vcu; it < 256; it += F.G) {
        const int vq = it & 3, dir = (it >> 2) & 1, h = (it >> 3) & 3, b = it >> 5;
        hgrn_item(F, Z1, (const float*)(F.ws + WS_VECS), (const bf16_t*)(F.ws + WS_AH), dir ? OBW : OFW, b, h, dir, vq);
        __syncthreads();
    }
}
__device__ __forceinline__ void readout_phase(const Frame& F, const Args& a, int l, int M) {
    const bf16_t* OFW = (const bf16_t*)(F.ws + WS_O); const bf16_t* OBW = OFW + (size_t)MROWS * 512;
    const bf16_t* Z2 = (const bf16_t*)(F.ws + WS_Z); bf16_t* AH = (bf16_t*)(F.ws + WS_AH);
    const float* ng = a.norm_g + l * 512;
    const int gw = F.vcu * 8 + F.wave, NGW = F.G * 8, lane = F.lane;
    const f32x4 g0 = *(const f32x4*)(ng + 8 * lane), g1 = *(const f32x4*)(ng + 8 * lane + 4);
    u32x4 ra[4], rb[4], rs4[4];
    auto ld = [&](int grp) {
#pragma unroll
        for (int r = 0; r < 4; ++r) { const size_t off = (size_t)(grp * 4 + r) * 512 + 8 * lane; ra[r] = *(const u32x4*)(OFW + off); rb[r] = *(const u32x4*)(OBW + off); rs4[r] = *(const u32x4*)(Z2 + off); }
    };
    if (gw < M / 4) ld(gw);
    for (int grp = gw; grp < M / 4; grp += NGW) {
        f32x4 oa[4], ob[4], sa[4], sb[4];
#pragma unroll
        for (int r = 0; r < 4; ++r) { f32x4 x0, x1, y0, y1; unpack8(ra[r], x0, x1); unpack8(rb[r], y0, y1); oa[r] = x0 + y0; ob[r] = x1 + y1; unpack8(rs4[r], sa[r], sb[r]); }
        if (grp + NGW < M / 4) ld(grp + NGW);
#pragma unroll
        for (int r = 0; r < 4; ++r) {
            const float ss = row16_sum(hsq4(oa[r]) + hsq4(ob[r]));
            const float rs = 1.0f / sqrtf(ss * (1.0f / 128.0f) + LN_EPS);
            *(u32x4*)(AH + (size_t)(grp * 4 + r) * D + 512 + 8 * lane) = pack8(oa[r] * rs * g0 * sa[r], ob[r] * rs * g1 * sb[r]);
        }
    }
}

__device__ __forceinline__ void row_pass1(const Frame& F, const Args& a, int l, int M) {
    LAS float* wrT = (LAS float*)F.lds;
    constexpr int WRP = D + 4;
    const float* wr = a.w_router + (size_t)l * D * NE;
    for (int i = F.tid; i < D * NE; i += 512) { const int d = i >> 4, e = i & 15; wrT[e * WRP + d] = wr[i]; }
    __syncthreads();
    const float* MOD = (const float*)(F.ws + WS_MOD);
    const bf16_t* Y = (const bf16_t*)(F.ws + WS_AH);
    bf16_t* U2 = (bf16_t*)(F.ws + WS_U);
    float* XC = (float*)(F.ws + WS_XC);
    float* AFF = (float*)(F.ws + WS_AFF); float* AFFT = (float*)(F.ws + WS_AFFT);
    const float* lng = a.ln_g + (size_t)(l * 2 + 0) * D; const float* lnb = a.ln_b + (size_t)(l * 2 + 0) * D;
    const int gw = F.vcu * 8 + F.wave, NGW = F.G * 8, lane = F.lane;
    u32x4 xr[4][4];
    const bool xbf = l == 1;
    bf16_t* X1 = (bf16_t*)(F.ws + WS_O);
    auto rp1_load = [&](int grp) {
        const int row0 = grp * 4; const bool lat = row0 < NLAT;
        if (lat && xbf) {
            const bf16_t* xin = (const bf16_t*)a.out + (size_t)row0 * D;
#pragma unroll
            for (int s2 = 0; s2 < 2; ++s2)
#pragma unroll
                for (int r = 0; r < 4; ++r) xr[r][2 * s2] = *(const u32x4*)(xin + (size_t)r * D + 512 * s2 + 8 * lane);
        } else {
            const float* xin = lat ? a.x + (size_t)row0 * D : (l == 0 ? a.ctx + (size_t)(row0 - NLAT) * D : XC + (size_t)(row0 - NLAT) * D);
#pragma unroll
            for (int s2 = 0; s2 < 2; ++s2)
#pragma unroll
                for (int r = 0; r < 4; ++r) {
                    const int c0 = 512 * s2 + 8 * lane;
                    xr[r][2 * s2] = *(const u32x4*)(xin + (size_t)r * D + c0); xr[r][2 * s2 + 1] = *(const u32x4*)(xin + (size_t)r * D + c0 + 4);
                }
        }
    };
    if (gw < M / 4) rp1_load(gw);
    for (int grp = gw; grp < M / 4; grp += NGW) {
        const int row0 = grp * 4; const bool lat = row0 < NLAT;
        float* xo = XC + (size_t)(lat ? 0 : row0 - NLAT) * D;
        const float* md = MOD + (size_t)(l * 9 + mod_group(row0)) * 6144;
        f32x4 v[4][4];
#pragma unroll
        for (int s2 = 0; s2 < 2; ++s2) {
            const int c0 = 512 * s2 + 8 * lane;
            const f32x4 ga = *(const f32x4*)(md + 2048 + c0), gb = *(const f32x4*)(md + 2048 + c0 + 4);
#pragma unroll
            for (int r = 0; r < 4; ++r) {
                f32x4 ya, yb; unpack8(*(const u32x4*)(Y + (size_t)(row0 + r) * D + c0), ya, yb);
                f32x4 xa, xb; if (lat && xbf) unpack8(xr[r][2 * s2], xa, xb); else { xa = __builtin_bit_cast(f32x4, xr[r][2 * s2]); xb = __builtin_bit_cast(f32x4, xr[r][2 * s2 + 1]); }
                v[r][2 * s2] = xa * ALPHA + ga * ya; v[r][2 * s2 + 1] = xb * ALPHA + gb * yb;
            }
        }
        if (grp + NGW < M / 4) rp1_load(grp + NGW);
        float rstd[4];
#pragma unroll
        for (int r = 0; r < 4; ++r) {
            const float mean = wsum((hsum4(v[r][0]) + hsum4(v[r][1])) + (hsum4(v[r][2]) + hsum4(v[r][3]))) * (1.f / D);
#pragma unroll
            for (int q = 0; q < 4; ++q) v[r][q] = v[r][q] - mean;
            rstd[r] = 1.0f / sqrtf(wsum((hsq4(v[r][0]) + hsq4(v[r][1])) + (hsq4(v[r][2]) + hsq4(v[r][3]))) * (1.f / D) + LN_EPS);
        }
#pragma unroll
        for (int q = 0; q < 4; ++q) {
            const int c0 = 512 * (q >> 1) + 8 * lane + 4 * (q & 1);
            const f32x4 g = *(const f32x4*)(lng + c0), bb = *(const f32x4*)(lnb + c0);
#pragma unroll
            for (int r = 0; r < 4; ++r) { v[r][q] = v[r][q] * rstd[r] * g + bb; if (!lat) *(f32x4*)(xo + (size_t)r * D + c0) = v[r][q]; }
        }
        if (lat) {
#pragma unroll
            for (int s2 = 0; s2 < 2; ++s2)
#pragma unroll
                for (int r = 0; r < 4; ++r) *(u32x4*)(X1 + (size_t)(row0 + r) * D + 512 * s2 + 8 * lane) = pack8(v[r][2 * s2], v[r][2 * s2 + 1]);
        }
#pragma unroll
        for (int r = 0; r < 4; ++r) {
            const float mean = wsum((hsum4(v[r][0]) + hsum4(v[r][1])) + (hsum4(v[r][2]) + hsum4(v[r][3]))) * (1.f / D);
#pragma unroll
            for (int q = 0; q < 4; ++q) v[r][q] = v[r][q] - mean;
            rstd[r] = 1.0f / sqrtf(wsum((hsq4(v[r][0]) + hsq4(v[r][1])) + (hsq4(v[r][2]) + hsq4(v[r][3]))) * (1.f / D) + LN_EPS);
        }
#pragma unroll
        for (int s2 = 0; s2 < 2; ++s2) {
            const int c0 = 512 * s2 + 8 * lane;
            const f32x4 sca = *(const f32x4*)(md + 4096 + c0) + 1.0f, scb = *(const f32x4*)(md + 4096 + c0 + 4) + 1.0f, sha = *(const f32x4*)(md + 3072 + c0), shb = *(const f32x4*)(md + 3072 + c0 + 4);
#pragma unroll
            for (int r = 0; r < 4; ++r) {
                v[r][2 * s2] = v[r][2 * s2] * rstd[r] * sca + sha; v[r][2 * s2 + 1] = v[r][2 * s2 + 1] * rstd[r] * scb + shb;
                *(u32x4*)(U2 + (size_t)(row0 + r) * D + c0) = pack8(v[r][2 * s2], v[r][2 * s2 + 1]);
            }
        }
        float p[64];
#pragma unroll
        for (int e = 0; e < 16; ++e) {
            f32x4 pa[4];
#pragma unroll
            for (int r = 0; r < 4; ++r) pa[r] = (f32x4){0.f, 0.f, 0.f, 0.f};
#pragma unroll
            for (int q = 0; q < 4; ++q) {
                const f32x4 w4 = *(const LAS f32x4*)(wrT + e * WRP + 512 * (q >> 1) + 8 * lane + 4 * (q & 1));
#pragma unroll
                for (int r = 0; r < 4; ++r) pa[r] = __builtin_elementwise_fma(v[r][q], w4, pa[r]);
            }
#pragma unroll
            for (int r = 0; r < 4; ++r) p[r * 16 + e] = hsum4(pa[r]);
            asm volatile("" ::: "memory");
        }
#pragma unroll
        for (int i = 0; i < 32; ++i) { const auto sw = __builtin_amdgcn_permlane32_swap(__float_as_uint(p[i]), __float_as_uint(p[i + 32]), false, false); p[i] = __uint_as_float(sw[0]) + __uint_as_float(sw[1]); }
#define BFLY_(N, MK) { const bool hi_ = (lane & MK) != 0; _Pragma("unroll") for (int i = 0; i < N / 2; ++i) { const float send = hi_ ? p[i] : p[i + N / 2]; const float keep = hi_ ? p[i + N / 2] : p[i]; p[i] = keep + shx(send, MK, lane); } }
        BFLY_(32, 16) BFLY_(16, 8) BFLY_(8, 4) BFLY_(4, 2) BFLY_(2, 1)
#undef BFLY_
        const float lg = p[0];
        const float mx = row16_max(lg);
        const float ex = expf(lg - mx);
        const float mine = ex / row16_sum(ex);
        const int r = lane >> 4, e = lane & 15, row = row0 + r;
        AFF[(size_t)row0 * 16 + lane] = mine;
        if (lat) AFFT[((size_t)(row >> 13) * 16 + e) * SEQ + (row & (SEQ - 1))] = mine;
        else { const int rc = row - NLAT; AFFT[(size_t)NB * 16 * SEQ + ((size_t)(rc >> 8) * 16 + e) * CTXL + (rc & (CTXL - 1))] = mine; }
    }
}
__device__ __forceinline__ void topk_phase(const Frame& F, int l) {
    LAS unsigned* vals = (LAS unsigned*)F.lds;
    LAS unsigned* hist = (LAS unsigned*)(F.lds + 32768);
    LAS unsigned* wtot = (LAS unsigned*)(F.lds + 32768 + 1024);
    LAS unsigned* ctl = (LAS unsigned*)(F.lds + 32768 + 1024 + 64);
    const float* AFFT = (const float*)(F.ws + WS_AFFT);
    int* SEL = (int*)(F.ws + WS_SEL); int* INV = (int*)(F.ws + WS_INV);
    const int total = 128 + (l == 0 ? 128 : 0);
    for (int u = F.vcu; u < total; u += F.G) {
        const bool lat = u < 128; const int q = lat ? u : u - 128, b = q >> 4, e = q & 15;
        const int n = lat ? SEQ : CTXL, cap = lat ? CAP : CAPC;
        const float* src = lat ? AFFT + (size_t)q * SEQ : AFFT + (size_t)NB * 16 * SEQ + (size_t)q * CTXL;
        for (int i = F.tid; i < n; i += 512) vals[i] = __float_as_uint(src[i]);
        if (F.tid == 0) { ctl[0] = 0u; ctl[1] = (unsigned)cap; }
        __syncthreads();
        unsigned mask = 0u;
        for (int pass = 0; pass < 4; ++pass) {
            const int shift = 24 - 8 * pass;
            if (F.tid < 256) hist[F.tid] = 0u;
            __syncthreads();
            const unsigned prefix = ctl[0];
            for (int i = F.tid; i < n; i += 512) { const unsigned v = vals[i]; if ((v & mask) == prefix) __hip_atomic_fetch_add(&hist[(v >> shift) & 255u], 1u, __ATOMIC_RELAXED, __HIP_MEMORY_SCOPE_WORKGROUP); }
            __syncthreads();
            if (F.wave == 0) {
                const unsigned kk = ctl[1];
                const u32x4 h4 = *(const LAS u32x4*)(hist + 4 * F.lane);
                const unsigned sl = (h4.x + h4.y) + (h4.z + h4.w);
                unsigned inc = sl;
#pragma unroll
                for (int o = 1; o < 64; o <<= 1) { const unsigned x = shup_u(inc, o, F.lane); if (F.lane >= o) inc += x; }
                const unsigned tot = (unsigned)__builtin_amdgcn_readlane((int)inc, 63);
                const bool reach = tot - (inc - sl) >= kk;
                const unsigned long long bm = __ballot(reach);
                const int ls = bm ? 63 - __builtin_clzll(bm) : 0;
                unsigned cum = tot - (unsigned)__builtin_amdgcn_readlane((int)inc, ls);
                const unsigned c3 = (unsigned)__builtin_amdgcn_readlane((int)h4.w, ls), c2 = (unsigned)__builtin_amdgcn_readlane((int)h4.z, ls), c1 = (unsigned)__builtin_amdgcn_readlane((int)h4.y, ls);
                int bin = 4 * ls + 3;
                if (cum + c3 < kk) { cum += c3; bin = 4 * ls + 2; if (cum + c2 < kk) { cum += c2; bin = 4 * ls + 1; if (cum + c1 < kk) { cum += c1; bin = 4 * ls; } } }
                if (F.lane == 0) { ctl[0] = prefix | ((unsigned)bin << shift); ctl[1] = kk - cum; }
            }
            mask |= 255u << shift;
            __syncthreads();
        }
        const unsigned T = ctl[0], keq = ctl[1];
        const int per = n >= 512 ? n / 512 : 1; const int base = F.tid * per; const bool active = base < n;
        unsigned ngt = 0u, neq = 0u;
        if (active) for (int i = 0; i < per; ++i) { const unsigned v = vals[base + i]; ngt += v > T; neq += v == T; }
        unsigned pk = ngt | (neq << 16), inc = pk;
#pragma unroll
        for (int o = 1; o < 64; o <<= 1) { const unsigned x = shup_u(inc, o, F.lane); if (F.lane >= o) inc += x; }
        if (F.lane == 63) wtot[F.wave] = inc;
        __syncthreads();
        unsigned wpre = 0u;
        for (int w = 0; w < F.wave; ++w) wpre += wtot[w];
        const unsigned excl = wpre + inc - pk;
        unsigned cgt = excl & 0xffffu, ceq = excl >> 16;
        if (active) for (int i = 0; i < per; ++i) {
            const int t = base + i; const unsigned v = vals[t];
            bool take = false; unsigned slot = 0u;
            if (v > T) { take = true; slot = cgt + (ceq < keq ? ceq : keq); ++cgt; }
            else if (v == T) { if (ceq < keq) { take = true; slot = cgt + ceq; } ++ceq; }
            const int row = lat ? b * SEQ + t : NLAT + b * CTXL + t;
            INV[(size_t)row * 16 + e] = take ? (int)slot : -1;
            if (take) { const int xr = lat ? (b * NE + e) * CAP + (int)slot : NB * NE * CAP + (e * NB + b) * CAPC + (int)slot; SEL[xr] = row; }
        }
        __syncthreads();
    }
}
__device__ __forceinline__ void gather_phase(const Frame& F, int l) {
    const int* SEL = (const int*)(F.ws + WS_SEL);
    const bf16_t* U2 = (const bf16_t*)(F.ws + WS_U); bf16_t* XS = (bf16_t*)(F.ws + WS_Z);
    const int total = NB * NE * CAP + (l == 0 ? NB * NE * CAPC : 0);
    const int gw = F.vcu * 8 + F.wave, NGW = F.G * 8;
    for (int r = gw; r < total; r += NGW) {
        const int src = SEL[r];
        const u32x4 a0 = *(const u32x4*)(U2 + (size_t)src * D + 8 * F.lane), a1 = *(const u32x4*)(U2 + (size_t)src * D + 512 + 8 * F.lane);
        *(u32x4*)(XS + (size_t)r * D + 8 * F.lane) = a0; *(u32x4*)(XS + (size_t)r * D + 512 + 8 * F.lane) = a1;
    }
}
__device__ __forceinline__ void row_pass2(const Frame& F, const Args& a, int l, int M) {
    const float* MOD = (const float*)(F.ws + WS_MOD);
    const bf16_t* YE = (const bf16_t*)(F.ws + WS_Z);
    bf16_t* U = (bf16_t*)(F.ws + WS_U);
    float* XC = (float*)(F.ws + WS_XC);
    const float* AFF = (const float*)(F.ws + WS_AFF); const int* INV = (const int*)(F.ws + WS_INV);
    const float* lng = a.ln_g + (size_t)(l * 2 + 1) * D; const float* lnb = a.ln_b + (size_t)(l * 2 + 1) * D;
    const int gw = F.vcu * 8 + F.wave, NGW = F.G * 8, lane = F.lane;
    u32x4 xr[4][4]; int inv_n = -1; float af_n = 0.f;
    const bf16_t* X1 = (const bf16_t*)(F.ws + WS_O);
    auto rp2_load = [&](int grp) {
        const int row0 = grp * 4; const bool lat = row0 < NLAT;
        inv_n = INV[(size_t)row0 * 16 + lane]; af_n = AFF[(size_t)row0 * 16 + lane];
        if (lat) {
#pragma unroll
            for (int s2 = 0; s2 < 2; ++s2)
#pragma unroll
                for (int r = 0; r < 4; ++r) xr[r][2 * s2] = *(const u32x4*)(X1 + (size_t)(row0 + r) * D + 512 * s2 + 8 * lane);
        } else {
            const float* xin = XC + (size_t)(row0 - NLAT) * D;
#pragma unroll
            for (int q = 0; q < 4; ++q)
#pragma unroll
                for (int r = 0; r < 4; ++r) xr[r][q] = *(const u32x4*)(xin + (size_t)r * D + 512 * (q >> 1) + 8 * lane + 4 * (q & 1));
        }
    };
    if (gw < M / 4) rp2_load(gw);
    for (int grp = gw; grp < M / 4; grp += NGW) {
        const int row0 = grp * 4; const bool lat = row0 < NLAT;
        float* xio = lat ? a.out + (size_t)row0 * D : XC + (size_t)(row0 - NLAT) * D;
        const bool obf = lat && l == 0;
        const int g9 = mod_group(row0);
        const float* md = MOD + (size_t)(l * 9 + g9) * 6144;
        const int inv = inv_n; const float af = af_n;
        const unsigned long long selm = __ballot(inv >= 0);
        unsigned sel_lo = (unsigned)selm, sel_hi = (unsigned)(selm >> 32); asm volatile("" : "+s"(sel_lo), "+s"(sel_hi));
        const int b = lat ? (row0 >> 13) : ((row0 - NLAT) >> 8);
        f32x4 v[4][4];
        unsigned mk[4];
#pragma unroll
        for (int r = 0; r < 4; ++r) {
#pragma unroll
            for (int q = 0; q < 4; ++q) v[r][q] = (f32x4){0.f, 0.f, 0.f, 0.f};
            mk[r] = ((r < 2 ? sel_lo : sel_hi) >> (16 * (r & 1))) & 0xffffu;
        }
        while ((mk[0] | mk[1]) | (mk[2] | mk[3])) {
            u32x4 y0[4], y1[4]; float w[4];
#pragma unroll
            for (int r = 0; r < 4; ++r) {
                w[r] = 0.f;
                if (mk[r]) {
                    const int e = __builtin_ctz(mk[r]); mk[r] &= mk[r] - 1u;
                    const int slot = __builtin_amdgcn_readlane(inv, 16 * r + e); w[r] = rdlane(af, 16 * r + e);
                    const size_t yr = lat ? (size_t)(b * NE + e) * CAP + slot : (size_t)NB * NE * CAP + (size_t)(e * NB + b) * CAPC + slot;
                    y0[r] = *(const u32x4*)(YE + yr * D + 8 * lane); y1[r] = *(const u32x4*)(YE + yr * D + 512 + 8 * lane);
                } else { y0[r] = (u32x4){0u, 0u, 0u, 0u}; y1[r] = y0[r]; }
            }
#pragma unroll
            for (int r = 0; r < 4; ++r) {
                f32x4 ya, yb; unpack8(y0[r], ya, yb); v[r][0] += ya * w[r]; v[r][1] += yb * w[r]; unpack8(y1[r], ya, yb); v[r][2] += ya * w[r]; v[r][3] += yb * w[r];
            }
        }
#pragma unroll
        for (int q = 0; q < 4; ++q) {
            const int c0 = 512 * (q >> 1) + 8 * lane + 4 * (q & 1);
            const f32x4 g2 = *(const f32x4*)(md + 5120 + c0);
#pragma unroll
            for (int r = 0; r < 4; ++r) {
                f32x4 xv;
                if (lat) { f32x4 xa, xb; unpack8(xr[r][q & 2], xa, xb); xv = (q & 1) ? xb : xa; } else xv = __builtin_bit_cast(f32x4, xr[r][q]);
                v[r][q] = xv * ALPHA + g2 * v[r][q];
            }
        }
        if (grp + NGW < M / 4) rp2_load(grp + NGW);
        float rstd[4];
#pragma unroll
        for (int r = 0; r < 4; ++r) {
            const float mean = wsum((hsum4(v[r][0]) + hsum4(v[r][1])) + (hsum4(v[r][2]) + hsum4(v[r][3]))) * (1.f / D);
#pragma unroll
            for (int q = 0; q < 4; ++q) v[r][q] = v[r][q] - mean;
            rstd[r] = 1.0f / sqrtf(wsum((hsq4(v[r][0]) + hsq4(v[r][1])) + (hsq4(v[r][2]) + hsq4(v[r][3]))) * (1.f / D) + LN_EPS);
        }
#pragma unroll
        for (int q = 0; q < 4; ++q) {
            const int c0 = 512 * (q >> 1) + 8 * lane + 4 * (q & 1);
            const f32x4 g = *(const f32x4*)(lng + c0), bb = *(const f32x4*)(lnb + c0);
#pragma unroll
            for (int r = 0; r < 4; ++r) { v[r][q] = v[r][q] * rstd[r] * g + bb; if (!obf) *(f32x4*)(xio + (size_t)r * D + c0) = v[r][q]; }
        }
        if (obf) {
            bf16_t* X2 = (bf16_t*)a.out;
#pragma unroll
            for (int s2 = 0; s2 < 2; ++s2)
#pragma unroll
                for (int r = 0; r < 4; ++r) *(u32x4*)(X2 + (size_t)(row0 + r) * D + 512 * s2 + 8 * lane) = pack8(v[r][2 * s2], v[r][2 * s2 + 1]);
        }
        if (l == 0) {
            const float* md1 = MOD + (size_t)(1 * 9 + g9) * 6144;
#pragma unroll
            for (int r = 0; r < 4; ++r) {
                const float mean = wsum((hsum4(v[r][0]) + hsum4(v[r][1])) + (hsum4(v[r][2]) + hsum4(v[r][3]))) * (1.f / D);
#pragma unroll
                for (int q = 0; q < 4; ++q) v[r][q] = v[r][q] - mean;
                rstd[r] = 1.0f / sqrtf(wsum((hsq4(v[r][0]) + hsq4(v[r][1])) + (hsq4(v[r][2]) + hsq4(v[r][3]))) * (1.f / D) + LN_EPS);
            }
#pragma unroll
            for (int s2 = 0; s2 < 2; ++s2) {
                const int c0 = 512 * s2 + 8 * lane;
                const f32x4 sca = *(const f32x4*)(md1 + 1024 + c0) + 1.0f, scb = *(const f32x4*)(md1 + 1024 + c0 + 4) + 1.0f, sha = *(const f32x4*)(md1 + c0), shb = *(const f32x4*)(md1 + c0 + 4);
#pragma unroll
                for (int r = 0; r < 4; ++r) *(u32x4*)(U + (size_t)(row0 + r) * D + c0) = pack8(v[r][2 * s2] * rstd[r] * sca + sha, v[r][2 * s2 + 1] * rstd[r] * scb + shb);
            }
        }
    }
}

constexpr int NPH_LAYER = 13, NPHASES = 2 + 2 * NPH_LAYER;
__global__ void __launch_bounds__(512, 2) fwd_kernel(Args args) {
    extern __shared__ __attribute__((aligned(16))) unsigned char lds_raw[];
    Frame F0;
    F0.lds = (LAS unsigned char*)lds_raw;
    F0.tid = threadIdx.x; F0.lane = F0.tid & 63; F0.wave = __builtin_amdgcn_readfirstlane(F0.tid >> 6);
    F0.G = gridDim.x; { const int bx = blockIdx.x; F0.vcu = (F0.G % 8 == 0) ? (bx % 8) * (F0.G / 8) + bx / 8 : bx; }
    F0.ws = args.ws;
    volatile LAS unsigned* MISC = (volatile LAS unsigned*)(F0.lds + MISC_OFF);
    if (F0.tid < 64) MISC[F0.tid] = 0u;
    __syncthreads();
    unsigned* ctl = (unsigned*)(F0.ws + WS_CTL);
    XcdBarrier bar; bar.bar = ctl + CW_BAR; bar.x = 0; bar.st = nullptr;
    const int lo = args.ph_lo, hi = args.ph_hi;
    if (hi - lo > 1) bar = xcd_barrier_post(ctl + CW_BAR, MISC + 8);
#ifndef PH_MASK
#define PH_MASK 0xffff
#endif
#define PHON(j) (((PH_MASK) >> (j)) & 1)
#ifndef PH_REP
#define PH_REP 0
#endif
#define REPS(j) for (int rep_ = 0; rep_ <= (((PH_REP) >> (j)) & 1); ++rep_)
#define IN(k) (lo <= (k) && (k) < hi)
#define SEAM(k) do { if (IN(k) && IN((k) + 1)) xcd_barrier(bar); } while (0)
    if (PHON(13) && IN(0)) { const Frame F = phase_frame(F0); mod_items(F, args); small_tables(F, args); convert_weights(F, args, 0, 0, CVS_P0, F.bx, F.G); }
    SEAM(0);
    if (PHON(14) && IN(1)) { const Frame F = phase_frame(F0); ln_mod_rows(F, args); }
    SEAM(1);
    for (int l = 0; l < 2; ++l) {
        const int pb = 2 + NPH_LAYER * l;
        const int M = l == 0 ? MROWS : NLAT;
        REPS(0) if (PHON(0) && IN(pb + 0)) { const Frame F = phase_frame(F0); bf16_t* Wb = weights_of(F, args, l);
            DenseSched<1> S{(const char*)(F.ws + WS_U), (const char*)(Wb + W_IN / 2), MROWS / 256, N1 / 256, F.G, F.bx, 0, 0};
            EpiIn1 E{(bf16_t*)(F.ws + WS_Z), (const float*)(F.ws + WS_ROPE), (const float*)(F.ws + WS_LB) + l * 1024, (float*)(F.ws + WS_VECS), (bf16_t*)(F.ws + WS_AH)};
            pg8::gemm_phase(F.lds, F.tid, D, D, D, S, E);
            { const Frame F2 = phase_frame(F0);
              if (l == 0) convert_in_tail(F2, args, (MROWS / 256) * (N1 / 256), 0, CVS_P0, CVS_A); else convert_in_tail(F2, args, (MROWS / 256) * (N1 / 256), 1, CV_GU_END, CV_ITEMS); }
        }
        SEAM(pb + 0);
        REPS(2) if (PHON(2) && IN(pb + 1)) { const Frame F = phase_frame(F0); bf16_t* Wb = weights_of(F, args, l); hgrn_phase(F); }
        if (IN(pb + 1) && IN(pb + 2)) __syncthreads();
        REPS(1) if (PHON(1) && IN(pb + 2)) { const Frame F = phase_frame(F0); bf16_t* Wb = weights_of(F, args, l); attn_phase(F, args, l); }
        SEAM(pb + 2);
        REPS(3) if (PHON(3) && IN(pb + 3)) { const Frame F = phase_frame(F0); bf16_t* Wb = weights_of(F, args, l);
            DenseSched<1> S{(const char*)(F.ws + WS_U), (const char*)(Wb + W_IN / 2 + (size_t)N1 * D), M / 256, N2 / 256, F.G, F.bx, 0, 0};
            EpiIn2 E{(bf16_t*)(F.ws + WS_Z), F.ws + WS_ZG};
            pg8::gemm_phase(F.lds, F.tid, D, D, D, S, E);
            { const Frame F2 = phase_frame(F0);
              if (l == 0) convert_in_tail(F2, args, (M / 256) * (N2 / 256), 0, CVS_A, CVS_B); }
        }
        SEAM(pb + 3);
        REPS(4) if (PHON(4) && IN(pb + 4)) { const Frame F = phase_frame(F0); bf16_t* Wb = weights_of(F, args, l); readout_phase(F, args, l, M); }
        SEAM(pb + 4);
        REPS(5) if (PHON(5) && IN(pb + 5)) { const Frame F = phase_frame(F0); bf16_t* Wb = weights_of(F, args, l);
            DenseSched<1> S{(const char*)(F.ws + WS_AH), (const char*)(Wb + W_BR / 2), M / 256, D / 256, F.G, F.bx, 0, 0};
            EpiBranch E{F.ws + WS_ZG, (bf16_t*)(F.ws + WS_O)};
            pg8::gemm_phase(F.lds, F.tid, D, D, D, S, E);
            { const Frame F2 = phase_frame(F0);
              if (l == 0) convert_in_tail(F2, args, (M / 256) * (D / 256), 0, CVS_B, CV_ITEMS); }
        }
        SEAM(pb + 5);
        REPS(6) if (PHON(6) && IN(pb + 6)) { const Frame F = phase_frame(F0); bf16_t* Wb = weights_of(F, args, l);
            DenseSched<1> S{(const char*)(F.ws + WS_O), (const char*)(Wb + W_OUT / 2), M / 256, D / 256, F.G, F.bx, 0, 0};
            EpiPlain E{(bf16_t*)(F.ws + WS_AH)};
            pg8::gemm_phase(F.lds, F.tid, D, D, D, S, E);
            { const Frame F2 = phase_frame(F0);
              if (l == 0) convert_in_tail(F2, args, (M / 256) * (D / 256), 1, 0, CVS_C); }
        }
        SEAM(pb + 6);
        REPS(7) if (PHON(7) && IN(pb + 7)) { const Frame F = phase_frame(F0); bf16_t* Wb = weights_of(F, args, l); row_pass1(F, args, l, M); }
        SEAM(pb + 7);
        REPS(8) if (PHON(8) && IN(pb + 8)) { const Frame F = phase_frame(F0); bf16_t* Wb = weights_of(F, args, l); topk_phase(F, l); }
        SEAM(pb + 8);
        REPS(10) if (PHON(10) && IN(pb + 10)) { const Frame F = phase_frame(F0); bf16_t* Wb = weights_of(F, args, l);
            MoeSched1 S{(const char*)(F.ws + WS_U), (const char*)(Wb + W_GU / 2), (const int*)(F.ws + WS_SEL), 4096 + (l == 0 ? 128 : 0), F.G, F.bx};
            EpiSwiglu E{(bf16_t*)(F.ws + WS_HB)};
            pg8::gemm_phase<true>(F.lds, F.tid, D, D, D, S, E);
            { const Frame F2 = phase_frame(F0);
              if (l == 0) convert_in_tail(F2, args, 4096 + 128, 1, CVS_C, CVS_D); }
        }
        SEAM(pb + 10);
        REPS(11) if (PHON(11) && IN(pb + 11)) { const Frame F = phase_frame(F0); bf16_t* Wb = weights_of(F, args, l);
            MoeSched2 S{(const char*)(F.ws + WS_HB), (const char*)(Wb + W_DN / 2), 2048 + (l == 0 ? 64 : 0), F.G, F.bx};
            EpiPlain E{(bf16_t*)(F.ws + WS_Z)};
            pg8::gemm_phase(F.lds, F.tid, D, D, D, S, E);
            { const Frame F2 = phase_frame(F0);
              if (l == 0) convert_in_tail(F2, args, 2048 + 64, 1, CVS_D, CV_GU_END); }
        }
        SEAM(pb + 11);
        REPS(12) if (PHON(12) && IN(pb + 12)) { const Frame F = phase_frame(F0); bf16_t* Wb = weights_of(F, args, l); row_pass2(F, args, l, M); }
        if (l == 0) SEAM(pb + 12);
    }
#undef IN
#undef SEAM
}

extern "C" void kernel_launch(void* const* d_in, const int* in_sizes, int n_in, void* d_out, int out_size, void* d_ws, size_t ws_size, hipStream_t stream) {
    static int grid = 0;
    if (grid == 0) {
        if (n_in != 20 || out_size != NLAT * D || ws_size < WS_END) { fprintf(stderr, "kernel_launch: unexpected shapes (n_in %d out %d ws %zu)\n", n_in, out_size, ws_size); grid = -1; return; }
        int dev = 0, cus = 0, per_cu = 0;
        if (hipGetDevice(&dev) != hipSuccess || hipDeviceGetAttribute(&cus, hipDeviceAttributeMultiprocessorCount, dev) != hipSuccess) { grid = -1; return; }
        if (hipFuncSetAttribute((const void*)fwd_kernel, hipFuncAttributeMaxDynamicSharedMemorySize, LDS_BYTES) != hipSuccess) { fprintf(stderr, "kernel_launch: hipFuncSetAttribute failed\n"); grid = -1; return; }
        if (hipOccupancyMaxActiveBlocksPerMultiprocessor(&per_cu, (const void*)fwd_kernel, 512, LDS_BYTES) != hipSuccess || per_cu < 1) fprintf(stderr, "kernel_launch: occupancy query reports %d\n", per_cu);
        (void)hipGetLastError();
        grid = cus;
    }
    if (grid < 0) return;
    (void)hipMemsetAsync((char*)d_ws + WS_CTL, 0, CTL_ZERO_BYTES, stream);
    Args a{};
    a.x = (const float*)d_in[0]; a.c = (const float*)d_in[1]; a.ctx = (const float*)d_in[2]; a.c_ctx = (const float*)d_in[3]; a.w_mod = (const float*)d_in[4]; a.b_mod = (const float*)d_in[5];
    a.w_in = (const float*)d_in[6]; a.attn_sink = (const float*)d_in[7]; a.lb_fw = (const float*)d_in[8]; a.lb_bw = (const float*)d_in[9]; a.norm_g = (const float*)d_in[10];
    a.w_bra = (const float*)d_in[11]; a.w_brh = (const float*)d_in[12]; a.w_out = (const float*)d_in[13]; a.w_router = (const float*)d_in[14]; a.w_gate = (const float*)d_in[15];
    a.w_up = (const float*)d_in[16]; a.w_down = (const float*)d_in[17]; a.ln_g = (const float*)d_in[18]; a.ln_b = (const float*)d_in[19];
    a.out = (float*)d_out; a.ws = (unsigned char*)d_ws;
#if MK_MULTI
    for (int p = 0; p < NPHASES; ++p) { a.ph_lo = p; a.ph_hi = p + 1; hipLaunchKernelGGL(fwd_kernel, dim3(grid), dim3(512), LDS_BYTES, stream, a); }
#else
    a.ph_lo = 0; a.ph_hi = NPHASES;
    hipLaunchKernelGGL(fwd_kernel, dim3(grid), dim3(512), LDS_BYTES, stream, a);
#endif
}
```

```cpp
#include <hip/hip_runtime.h>
#include <cstdint>
#include <cstdio>

#ifndef MK_MULTI
#define MK_MULTI 0
#endif
#ifndef PG8_SP2
#define PG8_SP2 1
#endif

#define LAS __attribute__((address_space(3)))
typedef unsigned short bf16_t;
typedef short bf16x8 __attribute__((ext_vector_type(8)));
typedef short s16x4 __attribute__((ext_vector_type(4)));
typedef float f32x4 __attribute__((ext_vector_type(4)));
typedef float f32x16 __attribute__((ext_vector_type(16)));
typedef unsigned u32x4 __attribute__((ext_vector_type(4)));
typedef unsigned u32x2 __attribute__((ext_vector_type(2)));

constexpr int D = 1024, NB = 8, SEQ = 8192, CTXL = 256;
constexpr int NLAT = NB * SEQ, NCTX = NB * CTXL, MROWS = NLAT + NCTX;
constexpr int IN_DIM = 5376, N1 = 2816, N2 = 2560;
constexpr int NE = 16, CAP = 1024, CAPC = 32;
constexpr int XSROWS = NB * NE * CAP + NB * NE * CAPC;
constexpr float LN_EPS = 1e-6f;
constexpr float ALPHA = 1.41421356237309515f;

constexpr int ZC_Q = 0, ZC_K = 512, ZC_V = 640, ZC_QM = 768, ZC_KM = 1280, ZC_IH = 2816;
constexpr int NCHUNK = MROWS / 64;
constexpr size_t ZO_HG = (size_t)MROWS * 768 * 2, ZA_BYTES = (size_t)MROWS * 128 * 2, ZO_IH = ZO_HG + 16 * ZA_BYTES;
constexpr int ZQP = 768;

constexpr size_t MiB = 1u << 20;
constexpr size_t WS_CTL = 0, CTL_ZERO_BYTES = 32 * 1024;
constexpr size_t WS_MOD = 1 * MiB;
constexpr size_t WS_ROPE = WS_MOD + 512 * 1024;
constexpr size_t WS_LB = WS_ROPE + 16384;
constexpr size_t WS_XC = 2 * MiB;
constexpr size_t WS_AFF = 18 * MiB;
constexpr size_t WS_INV = 23 * MiB;
constexpr size_t WS_AFFT = 28 * MiB;
constexpr size_t WS_SEL = 32 * MiB + 256 * 1024;
constexpr size_t WS_VECS = 18 * MiB;
constexpr size_t WS_W = 33 * MiB + 512 * 1024;
constexpr size_t W_IN = 0, W_BR = W_IN + (size_t)(N1 + N2) * D * 2, W_OUT = W_BR + (size_t)D * D * 2, W_GU = W_OUT + (size_t)D * D * 2,
                 W_DN = W_GU + (size_t)NE * 2048 * D * 2, W_END = W_DN + (size_t)NE * D * D * 2;
constexpr size_t WS_U = 145 * MiB;
constexpr size_t WS_Z = 277 * MiB;
constexpr size_t WS_ZG = WS_Z + 68 * MiB;
constexpr size_t WS_AH = 706 * MiB;
constexpr size_t WS_O = 838 * MiB;
constexpr size_t WS_HB = 541 * MiB;
constexpr size_t WS_END = 970 * MiB;
constexpr size_t W1_OFF = 128 * MiB;
static_assert(WS_W + W_END <= WS_U && WS_SEL + (size_t)XSROWS * 4 <= WS_W && WS_VECS + (size_t)2 * NCHUNK * 3 * 512 * 4 <= WS_SEL, "weights fit");
static_assert(WS_U + (size_t)MROWS * D * 2 <= WS_Z, "U fits");
static_assert(WS_Z + ZO_IH + 4 * ZA_BYTES <= WS_AH && WS_Z + (size_t)MROWS * 512 * 2 <= WS_ZG && WS_ZG + (size_t)(MROWS / 256) * 8 * 2 * 65536 <= WS_AH, "Z1 / Z2 fit");
static_assert(WS_AH + (size_t)MROWS * D * 2 <= WS_O, "AH fits");
static_assert(WS_O + (size_t)MROWS * D * 2 <= WS_END, "O fits");
static_assert(WS_Z + (size_t)XSROWS * D * 2 <= WS_HB && WS_HB + (size_t)XSROWS * D * 2 <= WS_O, "XS/HB fit");

constexpr int CW_BAR = 4096;

constexpr int RING_BYTES = 131072;
constexpr int MISC_OFF = RING_BYTES;
constexpr int LDS_BYTES = 147456;

__device__ __forceinline__ unsigned f2bf(float f) { unsigned u = __float_as_uint(f); return (u + 0x7fffu + ((u >> 16) & 1u)) >> 16; }
typedef float f32x2_t __attribute__((ext_vector_type(2))); typedef __bf16 bf16x2_t __attribute__((ext_vector_type(2)));
__device__ __forceinline__ unsigned pk2(float lo, float hi) { const f32x2_t v = {lo, hi}; const bf16x2_t b = __builtin_convertvector(v, bf16x2_t); return __builtin_bit_cast(unsigned, b); }
__device__ __forceinline__ float bflo(unsigned w) { return __uint_as_float(w << 16); }
__device__ __forceinline__ float bfhi(unsigned w) { return __uint_as_float(w & 0xffff0000u); }
__device__ __forceinline__ float shx(float v, int m, int lane) { return __int_as_float(__builtin_amdgcn_ds_bpermute((lane ^ m) << 2, __float_as_int(v))); }
__device__ __forceinline__ float shup(float v, int d, int lane) { return __int_as_float(__builtin_amdgcn_ds_bpermute((lane - d) << 2, __float_as_int(v))); }
__device__ __forceinline__ unsigned shup_u(unsigned v, int d, int lane) { return (unsigned)__builtin_amdgcn_ds_bpermute((lane - d) << 2, (int)v); }
__device__ __forceinline__ float shidx(float v, int src) { return __int_as_float(__builtin_amdgcn_ds_bpermute(src << 2, __float_as_int(v))); }
__device__ __forceinline__ int shidx_i(int v, int src) { return __builtin_amdgcn_ds_bpermute(src << 2, v); }
__device__ __forceinline__ float wave_sum(float v, int lane) {
#pragma unroll
    for (int o = 1; o < 64; o <<= 1) v += shx(v, o, lane);
    return v;
}

template <int CTRL> __device__ __forceinline__ float dppf(float v) { return __int_as_float(__builtin_amdgcn_update_dpp(0, __float_as_int(v), CTRL, 0xF, 0xF, true)); }
__device__ __forceinline__ float row16_sum(float v) { v += dppf<0xB1>(v); v += dppf<0x4E>(v); v += dppf<0x141>(v); v += dppf<0x140>(v); return v; }
__device__ __forceinline__ float row16_max(float v) { v = fmaxf(v, dppf<0xB1>(v)); v = fmaxf(v, dppf<0x4E>(v)); v = fmaxf(v, dppf<0x141>(v)); v = fmaxf(v, dppf<0x140>(v)); return v; }
template <int CTRL, int RM> __device__ __forceinline__ float dppz(float v) { return __int_as_float(__builtin_amdgcn_update_dpp(0, __float_as_int(v), CTRL, RM, 0xF, false)); }
__device__ __forceinline__ float wave_scan(float v) {
    v += dppz<0x111, 0xF>(v); v += dppz<0x112, 0xF>(v); v += dppz<0x114, 0xF>(v); v += dppz<0x118, 0xF>(v); v += dppz<0x142, 0xA>(v); v += dppz<0x143, 0xC>(v); return v; }
__device__ __forceinline__ float rdlane(float v, int l) { return __int_as_float(__builtin_amdgcn_readlane(__float_as_int(v), l)); }
__device__ __forceinline__ float wsum(float v) { v = row16_sum(v); return (rdlane(v, 0) + rdlane(v, 16)) + (rdlane(v, 32) + rdlane(v, 48)); }
__device__ __forceinline__ void unpack8(const u32x4 w, f32x4& a, f32x4& b) { a = (f32x4){bflo(w.x), bfhi(w.x), bflo(w.y), bfhi(w.y)}; b = (f32x4){bflo(w.z), bfhi(w.z), bflo(w.w), bfhi(w.w)}; }
__device__ __forceinline__ u32x4 pack8(const f32x4 a, const f32x4 b) { u32x4 w; w.x = pk2(a[0], a[1]); w.y = pk2(a[2], a[3]); w.z = pk2(b[0], b[1]); w.w = pk2(b[2], b[3]); return w; }
__device__ __forceinline__ float hsum4(const f32x4 v) { return (v[0] + v[1]) + (v[2] + v[3]); }
__device__ __forceinline__ float hsq4(const f32x4 v) { return (v[0] * v[0] + v[1] * v[1]) + (v[2] * v[2] + v[3] * v[3]); }
__device__ __forceinline__ float sigmoidf_(float z) { return __builtin_amdgcn_rcpf(1.0f + __expf(-z)); }
__device__ __forceinline__ float siluf_(float z) { return z * __builtin_amdgcn_rcpf(1.0f + __expf(-z)); }
__device__ __forceinline__ u32x2 pack4(const f32x4 v) { u32x2 w; w.x = pk2(v[0], v[1]); w.y = pk2(v[2], v[3]); return w; }
__device__ __forceinline__ f32x4 unpack4(const u32x2 w) { return (f32x4){bflo(w.x), bfhi(w.x), bflo(w.y), bfhi(w.y)}; }

#define XB_TMO      128
#define XB_XCNT(j)  (256  + 64 * (j))
#define XB_XSUB(j)  (1280 + 64 * (j))
#define XB_XGEN(j)  (2304 + 64 * (j))
#define XB_TOP      3328
#define XB_TOPGEN   3392
#define XCD_BAR_WORDS 3456
#define XB_SPIN_CAP (1u << 18)
__device__ __forceinline__ unsigned xb_ld(unsigned* p)              { return __hip_atomic_load(p, __ATOMIC_RELAXED, __HIP_MEMORY_SCOPE_AGENT); }
__device__ __forceinline__ unsigned xb_add(unsigned* p, unsigned v) { return __hip_atomic_fetch_add(p, v, __ATOMIC_RELAXED, __HIP_MEMORY_SCOPE_AGENT); }
__device__ __forceinline__ unsigned xb_xcc_id() { return (unsigned)__builtin_amdgcn_s_getreg((3 << 11) | 20) & 0xFu; }
#define XB_SPIN(cond, bar) do { unsigned _sp = 0; while (cond) { __builtin_amdgcn_s_sleep(1); \
    if ((++_sp & 255u) == 0u) { if (xb_ld(&(bar)[XB_TMO])) break; if (_sp > XB_SPIN_CAP) { atomicAdd(&(bar)[XB_TMO], 1u); break; } } } } while (0)
struct XcdBarrier { unsigned* bar; unsigned x; volatile LAS unsigned* st; };
__device__ __forceinline__ XcdBarrier xcd_barrier_post(unsigned* bar, volatile LAS unsigned* st) {
    XcdBarrier b; b.bar = bar; b.x = xb_xcc_id(); b.st = st;
    if (threadIdx.x == 0) (void)xb_add(&bar[XB_XCNT(b.x)], 1u);
    return b;
}
__device__ __forceinline__ void xcd_barrier_complete(unsigned* bar, unsigned x, unsigned& nloc, unsigned& nx) {
    const unsigned G = gridDim.x * gridDim.y * gridDim.z;
    unsigned sum, cnt, mine, sp = 0u;
    for (;;) {
        sum = 0u; cnt = 0u; mine = 0u;
#pragma unroll
        for (unsigned j = 0; j < 16; ++j) { const unsigned c = xb_ld(&bar[XB_XCNT(j)]); sum += c; cnt += (c > 0u) ? 1u : 0u; mine = (j == x) ? c : mine; }
        if (sum == G) break;
        __builtin_amdgcn_s_sleep(1);
        if ((++sp & 255u) == 0u) { if (xb_ld(&bar[XB_TMO])) break; if (sp > XB_SPIN_CAP) { atomicAdd(&bar[XB_TMO], 1u); break; } }
    }
    nloc = mine > 0u ? mine : 1u; nx = cnt > 0u ? cnt : 1u;
}
__device__ __forceinline__ void xcd_barrier(const XcdBarrier& b) {
    asm volatile("s_waitcnt vmcnt(0)" ::: "memory");
    __syncthreads();
    if (threadIdx.x == 0) {
        unsigned* bar = b.bar;
        __builtin_amdgcn_s_waitcnt(0);
        unsigned nloc = b.st[0], nx = b.st[1];
        if (nloc == 0u) { xcd_barrier_complete(bar, b.x, nloc, nx); b.st[0] = nloc; b.st[1] = nx; }
        const unsigned old = xb_add(&bar[XB_XSUB(b.x)], 1u);
        const unsigned gen = old / nloc;
        if (old + 1u == (gen + 1u) * nloc) {
            __builtin_amdgcn_fence(__ATOMIC_RELEASE, "agent");
            asm volatile("s_waitcnt vmcnt(0)" ::: "memory");
            const unsigned og = xb_add(&bar[XB_TOP], 1u);
            const unsigned tg = og / nx;
            if (og + 1u == (tg + 1u) * nx) xb_add(&bar[XB_TOPGEN], 1u);
            else XB_SPIN(xb_ld(&bar[XB_TOPGEN]) == tg, bar);
            xb_add(&bar[XB_XGEN(b.x)], 1u);
            __builtin_amdgcn_fence(__ATOMIC_ACQUIRE, "agent");
            asm volatile("s_waitcnt vmcnt(0)" ::: "memory");
        } else {
            XB_SPIN(xb_ld(&bar[XB_XGEN(b.x)]) == gen, bar);
            __builtin_amdgcn_fence(__ATOMIC_ACQUIRE, "agent");
            asm volatile("s_waitcnt vmcnt(0)" ::: "memory");
        }
    }
    __syncthreads();
}

namespace pg8 {
constexpr int BM = 256, BK = 64, HALF = 128, HTB = HALF * BK * 2, STAGE_BYTES = 8 * HTB, NXCD = 8, WGM = 8;
constexpr int SELBUF = STAGE_BYTES + 1024;
__host__ __device__ __forceinline__ int lds_byte(int r, int c) { const int st = (r >> 4) * 2 + (c >> 5), rr = r & 15, cc = c & 31, ob = rr * 64 + cc * 2; return st * 1024 + (ob ^ (((ob >> 9) & 1) << 5)); }
__host__ __device__ __forceinline__ int perm32(int rho) { const int n = rho >> 4, i = rho & 15; return 8 * (i >> 2) + 4 * n + (i & 3); }
__host__ __device__ __forceinline__ void stage_rc(int b, int& R, int& C) { const int st = b / 1024, sb = b % 1024, swz = sb ^ (((sb >> 9) & 1) << 5); R = (st >> 1) * 16 + swz / 64; C = (st & 1) * 32 + (swz % 64) / 2; }
struct Unit { int pm, pn, aux; };
__device__ __forceinline__ void tile_of(int wgid0, int nM, int nN, int& pm, int& pn) {
    const int nwg = nM * nN; int wgid = wgid0;
    { const int q = nwg / NXCD, r = nwg % NXCD, xcd = wgid % NXCD, off = wgid / NXCD; wgid = (xcd < r ? xcd * (q + 1) : r * (q + 1) + (xcd - r) * q) + off; }
    const int nig = WGM * nN, gid = wgid / nig, fm = gid * WGM, gsz = (nM - fm) < WGM ? (nM - fm) : WGM;
    pm = fm + ((wgid % nig) % gsz); pn = (wgid % nig) / gsz;
}
template <bool GATHER = false, class Epi, class Sched>
__device__ __forceinline__ void gemm_phase(LAS unsigned char* lds, const int tid, const int K, const int lda, const int ldb, const Sched& S, const Epi& E) {
    const int wid = __builtin_amdgcn_readfirstlane(tid >> 6), lane = tid & 63, wr = wid >> 2, wc = wid & 3, fr = lane & 15, fq = lane >> 4;
    const int nt = K / BK;
    unsigned voffA[2]; int Rr[2], Cc[2];
    unsigned sbv[2];
#pragma unroll
    for (int i = 0; i < 2; ++i) { int R, C; stage_rc(tid * 16 + i * 8192, R, C); Rr[i] = R; Cc[i] = C; voffA[i] = (unsigned)(R * lda + C) * 2u; sbv[i] = 0u; }
    auto bvoff = [&](bool perm, int i) -> unsigned { int ln_; asm volatile("v_mbcnt_lo_u32_b32 %0, -1, 0\n\tv_mbcnt_hi_u32_b32 %0, -1, %0" : "=v"(ln_)); int R, C; stage_rc((wid * 64 + ln_) * 16 + i * 8192, R, C);
        const int Rp = perm ? ((R & ~31) + perm32(R & 31)) : R; return (unsigned)(Rp * ldb + C) * 2u; };
    unsigned goff[2][2], ngoff[2][2], so[2][2];
#pragma unroll
    for (int h = 0; h < 2; ++h)
#pragma unroll
        for (int i = 0; i < 2; ++i) { goff[h][i] = 0u; ngoff[h][i] = 0u; so[h][i] = 0u; }
    const size_t kstep = (size_t)(BK * 2);
    const size_t hstepA = (size_t)HALF * lda * 2, hstepB = (size_t)HALF * ldb * 2;
    const unsigned ldsw = (unsigned)wid * 1024u;
    const int aoff = lds_byte(wr * 64 + fr, fq * 8), boff = lds_byte(wc * 32 + fr, fq * 8);
#define PG8_SA(b, h) (((b) * 2 + (h)) * HTB)
#define PG8_SB(b, h) ((4 + (b) * 2 + (h)) * HTB)
#define PG8_STAGE(bufoff, gbase, voff) do { _Pragma("unroll") for (int _i = 0; _i < 2; ++_i) \
        __builtin_amdgcn_global_load_lds((const unsigned*)((const char*)(gbase) + (voff)[_i]), (LAS unsigned*)(lds + (bufoff) + ldsw + _i * 8192), 16, 0, 0); } while (0)
#define PG8_STAGE_A(bufoff, gbase, h, VO) do { if constexpr (GATHER) { PG8_STAGE(bufoff, gbase, VO[h]); } else { PG8_STAGE(bufoff, (gbase) + (h) * hstepA, voffA); } } while (0)
#define PG8_LDA(dst, b, h) do { _Pragma("unroll") for (int m = 0; m < 4; ++m) _Pragma("unroll") for (int k = 0; k < 2; ++k) dst[m][k] = *(const LAS bf16x8*)(lds + PG8_SA(b, h) + aoff + m * 2048 + k * 1024); } while (0)
#define PG8_LDB(dst, b, h) do { _Pragma("unroll") for (int n = 0; n < 2; ++n) _Pragma("unroll") for (int k = 0; k < 2; ++k) dst[n][k] = *(const LAS bf16x8*)(lds + PG8_SB(b, h) + boff + n * 2048 + k * 1024); } while (0)
#define PG8_MMA(ai, bj, At, Bt) do { __builtin_amdgcn_s_setprio(1); _Pragma("unroll") for (int m = 0; m < 4; ++m) _Pragma("unroll") for (int n = 0; n < 2; ++n) _Pragma("unroll") for (int k = 0; k < 2; ++k) \
        acc[ai][bj][m][n] = __builtin_amdgcn_mfma_f32_16x16x32_bf16(Bt[n][k], At[m][k], acc[ai][bj][m][n], 0, 0, 0); __builtin_amdgcn_s_setprio(0); } while (0)
#define PG8_WAIT_V(n) asm volatile("s_waitcnt vmcnt(" #n ")" ::: "memory")
#define PG8_WAIT_VN(N) asm volatile("s_waitcnt vmcnt(%0)" :: "n"(N) : "memory")
#define PG8_WAIT_L(n) asm volatile("s_waitcnt lgkmcnt(" #n ")" ::: "memory")
#define PG8_BAR __builtin_amdgcn_s_barrier()
#define PG8_SCHED __builtin_amdgcn_sched_barrier(0)
    Unit cur, nxt; int ui = 0;
    if (!S.next(0, cur)) return;
    f32x4 acc[2][2][4][2];
#pragma unroll
    for (int a = 0; a < 2; ++a)
#pragma unroll
        for (int b = 0; b < 2; ++b)
#pragma unroll
            for (int m = 0; m < 4; ++m)
#pragma unroll
                for (int n = 0; n < 2; ++n) acc[a][b][m][n] = (f32x4){0.f, 0.f, 0.f, 0.f};
    bf16x8 At[4][2], B0[2][2], B1[2][2];
    const char* cA = S.aptr(cur); const char* cB = S.bptr(cur);
    bool pcur = E.perm(cur);
    unsigned vbc[2];
#pragma unroll
    for (int i = 0; i < 2; ++i) vbc[i] = bvoff(pcur, i);
    if constexpr (GATHER) {
#pragma unroll
        for (int h = 0; h < 2; ++h)
#pragma unroll
            for (int i = 0; i < 2; ++i) goff[h][i] = S.arow(cur, h * HALF + Rr[i]) + (unsigned)Cc[i] * 2u;
    }
#if PG8_SP2
    PG8_STAGE(PG8_SB(0, 0), cB, vbc); PG8_STAGE(PG8_SB(0, 1), cB + hstepB, vbc); PG8_STAGE_A(PG8_SA(0, 0), cA, 0, goff); PG8_STAGE_A(PG8_SA(0, 1), cA, 1, goff);
    if (wr == 1) PG8_BAR;
    PG8_WAIT_V(2); PG8_BAR;
    PG8_STAGE(PG8_SB(1, 0), cB + kstep, vbc); PG8_STAGE_A(PG8_SA(1, 0), cA + kstep, 0, goff); PG8_STAGE(PG8_SB(1, 1), cB + hstepB + kstep, vbc);
    PG8_WAIT_V(6); PG8_BAR;
#else
    PG8_STAGE(PG8_SB(0, 0), cB, vbc); PG8_STAGE_A(PG8_SA(0, 0), cA, 0, goff); PG8_STAGE(PG8_SB(0, 1), cB + hstepB, vbc); PG8_STAGE_A(PG8_SA(0, 1), cA, 1, goff);
    if (wr == 1) PG8_BAR;
    PG8_WAIT_V(4); PG8_BAR;
    PG8_STAGE(PG8_SB(1, 0), cB + kstep, vbc); PG8_STAGE_A(PG8_SA(1, 0), cA + kstep, 0, goff); PG8_STAGE(PG8_SB(1, 1), cB + hstepB + kstep, vbc);
    PG8_WAIT_V(6); PG8_BAR;
#endif
    for (;;) {
        const bool has_next = S.next(ui + 1, nxt);
        const char* nA = has_next ? S.aptr(nxt) : cA; const char* nB = has_next ? S.bptr(nxt) : cB;
        if constexpr (GATHER) {
            if (has_next && wid == 0) { int ln_; asm volatile("v_mbcnt_lo_u32_b32 %0, -1, 0\n\tv_mbcnt_hi_u32_b32 %0, -1, %0" : "=v"(ln_));
                __builtin_amdgcn_global_load_lds((const unsigned*)(S.selrow(nxt) + ln_ * 4), (LAS unsigned*)(lds + SELBUF + ((ui + 1) & 1) * 1024), 16, 0, 0); }
        }
        const bool pnext = has_next ? E.perm(nxt) : pcur;
        for (int t = 0; t < nt; t += 2) {
            const bool last = (t == nt - 2);
#pragma unroll
            for (int i = 0; i < 2; ++i) sbv[i] = vbc[i];
            if (last && pnext != pcur) {
#pragma unroll
                for (int i = 0; i < 2; ++i) sbv[i] = bvoff(pnext, i); }
            if constexpr (GATHER) {
#pragma unroll
                for (int h = 0; h < 2; ++h)
#pragma unroll
                    for (int i = 0; i < 2; ++i) so[h][i] = goff[h][i];
                if (last) {
                    const LAS int* sb = (const LAS int*)(lds + SELBUF + ((ui + 1) & 1) * 1024);
                    int ln_; asm volatile("v_mbcnt_lo_u32_b32 %0, -1, 0\n\tv_mbcnt_hi_u32_b32 %0, -1, %0" : "=v"(ln_));
#pragma unroll
                    for (int i = 0; i < 2; ++i) { int R_, C_; stage_rc((wid * 64 + ln_) * 16 + i * 8192, R_, C_);
#pragma unroll
                        for (int h = 0; h < 2; ++h) { ngoff[h][i] = has_next ? (unsigned)sb[h * HALF + R_] * (unsigned)(2048) + (unsigned)C_ * 2u : goff[h][i]; so[h][i] = ngoff[h][i]; } }
                }
            }
            const char* a1 = cA + (size_t)(t + 1) * kstep;
            const char* a2 = last ? nA : cA + (size_t)(t + 2) * kstep; const char* b2 = last ? nB : cB + (size_t)(t + 2) * kstep;
            const char* a3 = a2 + kstep; const char* b3 = b2 + kstep;
            if constexpr (Epi::HAS_MID) { if (t == nt / 2) E.mid(acc, cur, wr, wc); }
#if PG8_SP2
            const bool rlx = (t == 0) && (ui > 0);
#define PG8_WAIT_R() do { if (rlx) PG8_WAIT_VN(8 + Epi::MIN_VM); else PG8_WAIT_VN(8); } while (0)
            PG8_LDB(B0, 0, 0); PG8_LDB(B1, 0, 1); PG8_SCHED; PG8_LDA(At, 0, 0); if (!rlx) { PG8_STAGE_A(PG8_SA(1, 1), a1, 1, goff); }
            PG8_WAIT_R(); PG8_WAIT_L(0); PG8_BAR; PG8_MMA(0, 0, At, B0); PG8_MMA(0, 1, At, B1); PG8_BAR; PG8_SCHED;
            PG8_LDA(At, 0, 1); PG8_STAGE(PG8_SB(0, 0), b2, sbv); PG8_STAGE(PG8_SB(0, 1), b2 + hstepB, sbv); PG8_STAGE_A(PG8_SA(0, 0), a2, 0, so);
            PG8_WAIT_R(); PG8_WAIT_L(0); PG8_BAR; PG8_MMA(1, 0, At, B0); PG8_MMA(1, 1, At, B1); PG8_BAR; PG8_SCHED;
            PG8_LDB(B0, 1, 0); PG8_LDB(B1, 1, 1); PG8_SCHED; PG8_LDA(At, 1, 0); PG8_STAGE_A(PG8_SA(0, 1), a2, 1, so);
            PG8_WAIT_R(); PG8_WAIT_L(0); PG8_BAR; PG8_MMA(0, 0, At, B0); PG8_MMA(0, 1, At, B1); PG8_BAR; PG8_SCHED;
            PG8_LDA(At, 1, 1); PG8_STAGE(PG8_SB(1, 0), b3, sbv); PG8_STAGE(PG8_SB(1, 1), b3 + hstepB, sbv); PG8_STAGE_A(PG8_SA(1, 0), a3, 0, so);
            if (rlx) asm volatile("s_waitcnt vmcnt(8) ; exact in the first trip too" ::: "memory"); else PG8_WAIT_VN(8);
            PG8_WAIT_L(0); PG8_BAR; PG8_MMA(1, 0, At, B0); PG8_MMA(1, 1, At, B1); PG8_BAR; PG8_SCHED;
#undef PG8_WAIT_R
#else
            PG8_LDB(B0, 0, 0); PG8_SCHED; PG8_LDA(At, 0, 0); PG8_STAGE_A(PG8_SA(1, 1), a1, 1, goff);
            PG8_WAIT_L(8); PG8_BAR; PG8_WAIT_L(0); PG8_MMA(0, 0, At, B0); PG8_BAR; PG8_SCHED;
            PG8_LDB(B1, 0, 1); PG8_STAGE(PG8_SB(0, 0), b2, sbv);
            PG8_BAR; PG8_WAIT_L(0); PG8_MMA(0, 1, At, B1); PG8_BAR;
            PG8_LDA(At, 0, 1); PG8_STAGE_A(PG8_SA(0, 0), a2, 0, so);
            PG8_BAR; PG8_WAIT_L(0); PG8_MMA(1, 0, At, B0); PG8_BAR; PG8_SCHED;
            PG8_STAGE(PG8_SB(0, 1), b2 + hstepB, sbv);
            PG8_WAIT_V(6); PG8_BAR; PG8_MMA(1, 1, At, B1); PG8_BAR;
            PG8_LDB(B0, 1, 0); PG8_SCHED; PG8_LDA(At, 1, 0); PG8_STAGE_A(PG8_SA(0, 1), a2, 1, so);
            PG8_WAIT_L(8); PG8_BAR; PG8_WAIT_L(0); PG8_MMA(0, 0, At, B0); PG8_BAR; PG8_SCHED;
            PG8_LDB(B1, 1, 1); PG8_STAGE(PG8_SB(1, 0), b3, sbv);
            PG8_BAR; PG8_WAIT_L(0); PG8_MMA(0, 1, At, B1); PG8_BAR;
            PG8_LDA(At, 1, 1); PG8_STAGE_A(PG8_SA(1, 0), a3, 0, so);
            PG8_BAR; PG8_WAIT_L(0); PG8_MMA(1, 0, At, B0); PG8_BAR; PG8_SCHED;
            PG8_STAGE(PG8_SB(1, 1), b3 + hstepB, sbv);
            PG8_WAIT_V(6); PG8_BAR; PG8_MMA(1, 1, At, B1); PG8_BAR;
#endif
        }
#if PG8_SP2
        if (has_next) { PG8_STAGE_A(PG8_SA(1, 1), nA + kstep, 1, ngoff); }
        asm volatile("" ::: "memory"); PG8_SCHED;
#endif
        if (wr == 0) PG8_BAR;
        const bool keep = E(acc, cur, wr, wc, fr, fq);
        if (!has_next) break;
        if (!keep) {
#pragma unroll
            for (int a = 0; a < 2; ++a)
#pragma unroll
                for (int b = 0; b < 2; ++b)
#pragma unroll
                    for (int m = 0; m < 4; ++m)
#pragma unroll
                        for (int n = 0; n < 2; ++n) acc[a][b][m][n] = (f32x4){0.f, 0.f, 0.f, 0.f};
        }
        cur = nxt; cA = nA; cB = nB; ++ui; pcur = pnext;
        if (wr == 1) PG8_BAR;
#pragma unroll
        for (int i = 0; i < 2; ++i) vbc[i] = sbv[i];
        if constexpr (GATHER) {
#pragma unroll
            for (int h = 0; h < 2; ++h)
#pragma unroll
                for (int i = 0; i < 2; ++i) goff[h][i] = ngoff[h][i];
        }
    }
    PG8_WAIT_V(0);
    PG8_BAR;
#undef PG8_SA
#undef PG8_SB
#undef PG8_STAGE
#undef PG8_STAGE_A
#undef PG8_LDA
#undef PG8_LDB
#undef PG8_MMA
#undef PG8_WAIT_V
#undef PG8_WAIT_L
#undef PG8_BAR
#undef PG8_SCHED
}
}
using pg8::Unit;

struct Args {
    const float *x, *c, *ctx, *c_ctx, *w_mod, *b_mod, *w_in, *attn_sink, *lb_fw, *lb_bw, *norm_g, *w_bra, *w_brh, *w_out, *w_router, *w_gate, *w_up, *w_down, *ln_g, *ln_b;
    float* out; unsigned char* ws; int ph_lo, ph_hi;
};
struct Frame {
    LAS unsigned char* lds;
    int tid, lane, wave, G, vcu, bx;
    unsigned char* ws;
};
__device__ __forceinline__ Frame phase_frame(const Frame& F0) {
    Frame F = F0; int ln; asm volatile("v_mbcnt_lo_u32_b32 %0, -1, 0\n\tv_mbcnt_hi_u32_b32 %0, -1, %0" : "=v"(ln));
    int wv = F0.wave, gg = F0.G, bb = (int)blockIdx.x; asm volatile("" : "+s"(wv), "+s"(gg), "+s"(bb)); F.wave = wv; F.G = gg; F.bx = bb; F.lane = ln; F.tid = wv * 64 + ln;
    unsigned long long w = (unsigned long long)F0.ws; asm volatile("" : "+s"(w)); F.ws = (unsigned char*)(__attribute__((address_space(1))) unsigned char*)w; return F;
}
__device__ __forceinline__ int mod_group(int row) { return row < NLAT ? (row >> 13) : NB; }

template <int NS>
struct DenseSched {
    const char* A; const char* B; int nM, nN, G, c; size_t a_sub, b_sub;
    __device__ __forceinline__ bool next(int i, Unit& u) const {
        const int ti = (i / NS) * G + c; if (ti >= nM * nN) return false;
        pg8::tile_of(ti, nM, nN, u.pm, u.pn); u.aux = i % NS; return true;
    }
    __device__ __forceinline__ const char* aptr(const Unit& u) const { return A + (size_t)u.pm * 256 * D * 2 + (size_t)u.aux * a_sub; }
    __device__ __forceinline__ const char* bptr(const Unit& u) const { return B + (size_t)u.pn * 256 * D * 2 + (size_t)u.aux * b_sub; }
};

template <int CTRL> __device__ __forceinline__ f32x4 dpp4(const f32x4 v) { return (f32x4){dppf<CTRL>(v[0]), dppf<CTRL>(v[1]), dppf<CTRL>(v[2]), dppf<CTRL>(v[3])}; }
__device__ __forceinline__ f32x4 row16_scan4(f32x4 v) { v += dpp4<0x111>(v); v += dpp4<0x112>(v); v += dpp4<0x114>(v); v += dpp4<0x118>(v); return v; }
__device__ __forceinline__ f32x4 row16_sum4(f32x4 v) { return (f32x4){row16_sum(v[0]), row16_sum(v[1]), row16_sum(v[2]), row16_sum(v[3])}; }
struct EpiIn1 {
    static constexpr bool HAS_MID = false; static constexpr int MIN_VM = 16;
    bf16_t* Z; const float* rope; const float* lb; float* vecs; bf16_t* QS;
    __device__ __forceinline__ bool perm(const Unit& u) const { return u.pn >= 3; }
    template <bool FWD>
    __device__ __forceinline__ void decay_half(f32x4 (&zz)[4][2], const f32x4 (&qraw)[4][2]  , const int dir, const int kc, const Unit& u, int ai, int wr, int wc, int fr, int fq) const {
        u32x2 omf[4][2];
        f32x4 r0[2], s01[2], r2[2], tot[2];
        {
            const f32x4 lbv[2] = {*(const f32x4*)(lb + dir * 512 + kc), *(const f32x4*)(lb + dir * 512 + kc + 4)};
#pragma unroll
            for (int m = 0; m < 4; ++m)
#pragma unroll
                for (int n = 0; n < 2; ++n) {
                    f32x4 z = zz[m][n], o;
#pragma unroll
                    for (int i = 0; i < 4; ++i) {
                        const float e = __expf(-fabsf(z[i])), r = __builtin_amdgcn_rcpf(1.0f + e); const bool pos = z[i] >= 0.f;
                        const float oml = 1.0f - lbv[n][i];
                        z[i] = __builtin_amdgcn_logf(lbv[n][i] + oml * ((pos ? 1.0f : e) * r));
                        o[i] = oml * ((pos ? e : 1.0f) * r);
                    }
                    omf[m][n] = pack4(o);
                    z = row16_scan4(z); zz[m][n] = z;
                    const f32x4 rs = dpp4<0x15F>(z);
                    if (m == 0) r0[n] = rs; else if (m == 1) s01[n] = r0[n] + rs; else if (m == 2) r2[n] = rs; else tot[n] = (s01[n] + r2[n]) + rs;
                }
        }
        int frl = fr, kcl = kc; asm volatile("" : "+v"(frl), "+v"(kcl));
        const int head = kc >> 7;
        const size_t rowoff = (size_t)(u.pm * 256 + ai * 128 + wr * 64 + frl);
        bf16_t* zp = (bf16_t*)((unsigned char*)Z + ZO_HG + (size_t)((dir * 4 + head) * 2) * ZA_BYTES) + rowoff * 128 + (kcl & 127);
#pragma unroll
        for (int m = 0; m < 4; ++m) {
            u32x2 a0p[2], kmp[2], qsp[2];
#pragma unroll
            for (int n = 0; n < 2; ++n) {
                const f32x4 cfl = zz[m][n];
                const f32x4 cf = m == 0 ? cfl : cfl + (m == 1 ? r0[n] : m == 2 ? s01[n] : s01[n] + r2[n]);
                const f32x4 d = dir ? (s01[n] - cf) + (cfl - dpp4<0x111>(cfl)) : cf - s01[n];
                const f32x4 om = unpack4(omf[m][n]);
                f32x4 a0, km, qs;
#pragma unroll
                for (int i = 0; i < 4; ++i) {
                    const float x = fminf(fmaxf(d[i], -115.415603f), 115.415603f);
                    const float E1 = __builtin_amdgcn_exp2f(x);
                    if constexpr (FWD) { qs[i] = siluf_(qraw[m][n][i]); a0[i] = qs[i] * E1; } else { a0[i] = E1; }
                    km[i] = om[i] * __builtin_amdgcn_exp2f(-x);
                }
                a0p[n] = pack4(a0); kmp[n] = pack4(km); if constexpr (FWD) qsp[n] = pack4(qs);
                __builtin_amdgcn_sched_barrier(0);
            }
            *(u32x4*)(zp + (size_t)(16 * m) * 128) = (u32x4){a0p[0].x, a0p[0].y, a0p[1].x, a0p[1].y}; *(u32x4*)(zp + ZA_BYTES / 2 + (size_t)(16 * m) * 128) = (u32x4){kmp[0].x, kmp[0].y, kmp[1].x, kmp[1].y};
            if constexpr (FWD) *(u32x4*)(QS + (rowoff + 16 * m) * D + 512 + kcl) = (u32x4){qsp[0].x, qsp[0].y, qsp[1].x, qsp[1].y};
        }
        if (frl == 0) {
            float* vp = vecs + ((size_t)(dir * NCHUNK + (u.pm * 4 + ai * 2 + wr)) * 3) * 512 + kcl;
#pragma unroll
            for (int n = 0; n < 2; ++n) {
                f32x4 te, dc, ee;
#pragma unroll
                for (int i = 0; i < 4; ++i) { const float e2 = dir ? tot[n][i] - s01[n][i] : s01[n][i]; te[i] = __builtin_amdgcn_exp2f(tot[n][i] - e2); dc[i] = __builtin_amdgcn_exp2f(tot[n][i]); ee[i] = __builtin_amdgcn_exp2f(e2); }
                *(f32x4*)(vp + 4 * n) = te; *(f32x4*)(vp + 512 + 4 * n) = dc; *(f32x4*)(vp + 1024 + 4 * n) = ee;
            }
        }
    }
    __device__ __forceinline__ bool operator()(f32x4 (&acc)[2][2][4][2], const Unit& u, int wr, int wc, int fr, int fq) const {
        { int ln_; asm volatile("v_mbcnt_lo_u32_b32 %0, -1, 0\n\tv_mbcnt_hi_u32_b32 %0, -1, %0" : "=v"(ln_)); fr = ln_ & 15; fq = ln_ >> 4; }
        const bool latent = u.pm < 256;
        if (u.pn >= 3 && u.pn < 7) {
            const int hj = u.pn - 3, kc = 128 * hj + 32 * wc + 8 * fq;
#pragma unroll
            for (int ai = 0; ai < 2; ++ai) decay_half<true>(acc[ai][1], acc[ai][0], 0, kc, u, ai, wr, wc, fr, fq);
            return false;
        }
        if (u.pn >= 7 && u.pn < 9) {
#pragma unroll
            for (int ai = 0; ai < 2; ++ai)
#pragma unroll
                for (int bj = 0; bj < 2; ++bj) decay_half<false>(acc[ai][bj], acc[ai][bj], 1, 256 * (u.pn - 7) + 128 * bj + 32 * wc + 8 * fq, u, ai, wr, wc, fr, fq);
            return false;
        }
        if (u.pn >= 9) {
#pragma unroll
            for (int bj = 0; bj < 2; ++bj) {
                bf16_t* zp = (bf16_t*)((unsigned char*)Z + ZO_IH + (size_t)(2 * (u.pn - 9) + bj) * ZA_BYTES) + (size_t)(u.pm * 256 + wr * 64 + fr) * 128 + 32 * wc + 8 * fq;
#pragma unroll
                for (int ai = 0; ai < 2; ++ai)
#pragma unroll
                    for (int m = 0; m < 4; ++m) *(u32x4*)(zp + (size_t)(ai * 128 + m * 16) * 128) = pack8(acc[ai][bj][m][0], acc[ai][bj][m][1]);
            }
            return false;
        }
        f32x4 rcs[2][4], rsn[2][4];
        if (latent && u.pn < 3) {
#pragma unroll
            for (int ai = 0; ai < 2; ++ai)
#pragma unroll
                for (int m = 0; m < 4; ++m) {
                    const int t = (u.pm * 256 + ai * 128 + wr * 64 + m * 16 + fr) & (SEQ - 1); const int pos = (wc & 1) ? (t & 63) : (t >> 6);
                    rcs[ai][m] = *(const f32x4*)(rope + pos * 16 + 4 * fq); rsn[ai][m] = *(const f32x4*)(rope + 2048 + pos * 16 + 4 * fq);
                }
            __builtin_amdgcn_sched_barrier(0);
        }
#pragma unroll
        for (int bj = 0; bj < 2; ++bj) {
            const int hidx = 2 * u.pn + bj;
            const int col0 = 128 * hidx + 32 * wc + 4 * fq;
            bf16_t* zp = Z + (size_t)(u.pm * 256 + wr * 64 + fr) * ZQP + col0;
            if (hidx < 5) {
                const float qs = hidx < 4 ? 0.125f * 1.44269504089f : 1.0f;
#pragma unroll
                for (int ai = 0; ai < 2; ++ai)
#pragma unroll
                    for (int m = 0; m < 4; ++m) {
                        f32x4 v0 = acc[ai][bj][m][0], v1 = acc[ai][bj][m][1];
                        if (latent) {
                            const f32x4 cs = rcs[ai][m], sn = rsn[ai][m];
                            const f32x4 o0 = v0 * cs - v1 * sn, o1 = v1 * cs + v0 * sn; v0 = o0; v1 = o1;
                        }
                        bf16_t* p = zp + (size_t)(ai * 128 + m * 16) * ZQP;
                        *(u32x2*)p = pack4(v0 * qs); *(u32x2*)(p + 16) = pack4(v1 * qs);
                    }
            } else {
#pragma unroll
                for (int ai = 0; ai < 2; ++ai)
#pragma unroll
                    for (int m = 0; m < 4; ++m) {
                        bf16_t* p = zp + (size_t)(ai * 128 + m * 16) * ZQP;
                        *(u32x2*)p = pack4(acc[ai][bj][m][0]); *(u32x2*)(p + 16) = pack4(acc[ai][bj][m][1]);
                    }
            }
        }
        return false;
    }
};
struct EpiIn2 {
    bf16_t* GH; unsigned char* ZG;
    static constexpr bool HAS_MID = false; static constexpr int MIN_VM = 16;
    __device__ __forceinline__ bool perm(const Unit&) const { return true; }
    __device__ __forceinline__ bool operator()(f32x4 (&acc)[2][2][4][2], const Unit& u, int wr, int wc, int fr, int fq) const {
        { int ln_; asm volatile("v_mbcnt_lo_u32_b32 %0, -1, 0\n\tv_mbcnt_hi_u32_b32 %0, -1, %0" : "=v"(ln_)); fr = ln_ & 15; fq = ln_ >> 4; }
        const bool gh = u.pn < 2;
        unsigned char* base = ZG + ((size_t)(u.pm * 8 + (u.pn - 2)) * 2) * 65536 + ((size_t)((wr * 4 + wc) * 8) * 64 + (fq * 16 + fr)) * 16;
#pragma unroll
        for (int ai = 0; ai < 2; ++ai)
#pragma unroll
            for (int m = 0; m < 4; ++m) {
                f32x4 e[2][2];
#pragma unroll
                for (int bj = 0; bj < 2; ++bj)
#pragma unroll
                    for (int n = 0; n < 2; ++n)
#pragma unroll
                        for (int i = 0; i < 4; ++i) e[bj][n][i] = __expf(-acc[ai][bj][m][n][i]);
                if (gh) {
                    const int row = u.pm * 256 + ai * 128 + wr * 64 + m * 16 + fr;
#pragma unroll
                    for (int bj = 0; bj < 2; ++bj) {
                        f32x4 v0, v1;
#pragma unroll
                        for (int i = 0; i < 4; ++i) { v0[i] = acc[ai][bj][m][0][i] * __builtin_amdgcn_rcpf(1.0f + e[bj][0][i]); v1[i] = acc[ai][bj][m][1][i] * __builtin_amdgcn_rcpf(1.0f + e[bj][1][i]); }
                        *(u32x4*)(GH + (size_t)row * 512 + u.pn * 256 + bj * 128 + wc * 32 + 8 * fq) = pack8(v0, v1);
                    }
                } else {
                    f32x4 r0, r1, g0, g1;
#pragma unroll
                    for (int i = 0; i < 4; ++i) {
                        g0[i] = __builtin_amdgcn_rcpf(1.0f + e[1][0][i]); r0[i] = (1.0f + e[1][0][i]) * __builtin_amdgcn_rcpf(1.0f + e[0][0][i]);
                        g1[i] = __builtin_amdgcn_rcpf(1.0f + e[1][1][i]); r1[i] = (1.0f + e[1][1][i]) * __builtin_amdgcn_rcpf(1.0f + e[0][1][i]);
                    }
                    *(u32x4*)(base + (size_t)((ai * 4 + m) * 64) * 16) = pack8(r0, r1);
                    *(u32x4*)(base + 65536 + (size_t)((ai * 4 + m) * 64) * 16) = pack8(g0, g1);
                }
                __builtin_amdgcn_sched_barrier(0);
            }
        return false;
    }
};
struct EpiPlain {
    bf16_t* O;
    static constexpr bool HAS_MID = false; static constexpr int MIN_VM = 16;
    __device__ __forceinline__ bool perm(const Unit&) const { return true; }
    __device__ __forceinline__ bool operator()(f32x4 (&acc)[2][2][4][2], const Unit& u, int wr, int wc, int fr, int fq) const {
        { int ln_; asm volatile("v_mbcnt_lo_u32_b32 %0, -1, 0\n\tv_mbcnt_hi_u32_b32 %0, -1, %0" : "=v"(ln_)); fr = ln_ & 15; fq = ln_ >> 4; }
#pragma unroll
        for (int ai = 0; ai < 2; ++ai)
#pragma unroll
            for (int m = 0; m < 4; ++m) {
                const int row = u.pm * 256 + ai * 128 + wr * 64 + m * 16 + fr;
#pragma unroll
                for (int bj = 0; bj < 2; ++bj) {
                    *(u32x4*)(O + (size_t)row * D + u.pn * 256 + bj * 128 + wc * 32 + 8 * fq) = pack8(acc[ai][bj][m][0], acc[ai][bj][m][1]);
                }
            }
        return false;
    }
};
struct EpiBranch {
    static constexpr int MIN_VM = 32;
    static constexpr bool HAS_MID = true;
    const unsigned char* ZG; bf16_t* MB;
    __device__ __forceinline__ bool perm(const Unit&) const { return true; }
    __device__ __forceinline__ void mid(f32x4 (&acc)[2][2][4][2], const Unit& u, int wr, int wc) const {
        int ln_; asm volatile("v_mbcnt_lo_u32_b32 %0, -1, 0\n\tv_mbcnt_hi_u32_b32 %0, -1, %0" : "=v"(ln_));
        u32x4 w[2][8];
#pragma unroll
        for (int bj = 0; bj < 2; ++bj) {
            const unsigned char* base = ZG + ((size_t)(u.pm * 8 + (2 * u.pn + bj)) * 2) * 65536 + ((size_t)((wr * 4 + wc) * 8) * 64 + ln_) * 16;
#pragma unroll
            for (int k = 0; k < 8; ++k) w[bj][k] = *(const u32x4*)(base + (size_t)(k * 64) * 16);
        }
        __builtin_amdgcn_sched_barrier(0);
#pragma unroll
        for (int bj = 0; bj < 2; ++bj)
#pragma unroll
            for (int ai = 0; ai < 2; ++ai)
#pragma unroll
                for (int m = 0; m < 4; ++m) {
                    f32x4 g0, g1; unpack8(w[bj][ai * 4 + m], g0, g1);
                    acc[ai][bj][m][0] *= g0; acc[ai][bj][m][1] *= g1;
                }
        __builtin_amdgcn_sched_barrier(0);
    }
    __device__ __forceinline__ bool operator()(f32x4 (&acc)[2][2][4][2], const Unit& u, int wr, int wc, int fr, int fq) const {
        { int ln_; asm volatile("v_mbcnt_lo_u32_b32 %0, -1, 0\n\tv_mbcnt_hi_u32_b32 %0, -1, %0" : "=v"(ln_)); fr = ln_ & 15; fq = ln_ >> 4; }
        u32x4 w[2][8];
#pragma unroll
        for (int bj = 0; bj < 2; ++bj) {
            const unsigned char* base = ZG + ((size_t)(u.pm * 8 + (2 * u.pn + bj)) * 2 + 1) * 65536 + ((size_t)((wr * 4 + wc) * 8) * 64 + (fq * 16 + fr)) * 16;
#pragma unroll
            for (int k = 0; k < 8; ++k) w[bj][k] = *(const u32x4*)(base + (size_t)(k * 64) * 16);
        }
        __builtin_amdgcn_sched_barrier(0);
#pragma unroll
        for (int bj = 0; bj < 2; ++bj)
#pragma unroll
            for (int ai = 0; ai < 2; ++ai)
#pragma unroll
                for (int m = 0; m < 4; ++m) {
                    f32x4 g0, g1; unpack8(w[bj][ai * 4 + m], g0, g1);
                    const int row = u.pm * 256 + ai * 128 + wr * 64 + m * 16 + fr;
                    *(u32x4*)(MB + (size_t)row * D + u.pn * 256 + bj * 128 + wc * 32 + 8 * fq) = pack8(acc[ai][bj][m][0] * g0, acc[ai][bj][m][1] * g1);
                }
        return false;
    }
};
struct EpiSwiglu {
    bf16_t* H;
    static constexpr bool HAS_MID = false; static constexpr int MIN_VM = 8;
    __device__ __forceinline__ bool perm(const Unit&) const { return true; }
    __device__ __forceinline__ bool operator()(f32x4 (&acc)[2][2][4][2], const Unit& u, int wr, int wc, int fr, int fq) const {
        { int ln_; asm volatile("v_mbcnt_lo_u32_b32 %0, -1, 0\n\tv_mbcnt_hi_u32_b32 %0, -1, %0" : "=v"(ln_)); fr = ln_ & 15; fq = ln_ >> 4; }
#pragma unroll
        for (int ai = 0; ai < 2; ++ai)
#pragma unroll
            for (int m = 0; m < 4; ++m) {
                const int row = u.pm * 256 + ai * 128 + wr * 64 + m * 16 + fr;
                f32x4 h[2];
#pragma unroll
                for (int n = 0; n < 2; ++n) {
                    const f32x4 g = acc[ai][0][m][n], up = acc[ai][1][m][n];
#pragma unroll
                    for (int i = 0; i < 4; ++i) h[n][i] = siluf_(g[i]) * up[i];
                }
                *(u32x4*)(H + (size_t)row * D + u.pn * 128 + wc * 32 + 8 * fq) = pack8(h[0], h[1]);
            }
        return false;
    }
};
struct MoeSched1 {
    const char* XS; const char* W; const int* SEL; int total, G, c;
    __device__ __forceinline__ bool next(int i, Unit& u) const {
        const int L = i * G + c; if (L >= total) return false;
        if (L < 4096) { const int b = L & 7, rt = (L >> 3) & 3, j = (L >> 5) & 7, e = L >> 8; u.pm = (b * NE + e) * 4 + rt; u.pn = j; u.aux = e; }
        else { const int q = L - 4096; u.pn = q & 7; u.aux = q >> 3; u.pm = 512 + u.aux; }
        return true;
    }
    __device__ __forceinline__ const char* aptr(const Unit&) const { return XS; }
    __device__ __forceinline__ unsigned arow(const Unit& u, int r) const { return (unsigned)SEL[u.pm * 256 + r] * (unsigned)(D * 2); }
    __device__ __forceinline__ const int* selrow(const Unit& u) const { return SEL + u.pm * 256; }
    __device__ __forceinline__ const char* bptr(const Unit& u) const { return W + ((size_t)u.aux * 2048 + (size_t)u.pn * 256) * D * 2; }
};
struct MoeSched2 {
    const char* HB; const char* W; int total, G, c;
    __device__ __forceinline__ bool next(int i, Unit& u) const {
        const int L = i * G + c; if (L >= total) return false;
        if (L < 2048) { const int b = L & 7, rt = (L >> 3) & 3, j = (L >> 5) & 3, e = L >> 7; u.pm = (b * NE + e) * 4 + rt; u.pn = j; u.aux = e; }
        else { const int q = L - 2048; u.pn = q & 3; u.aux = q >> 2; u.pm = 512 + u.aux; }
        return true;
    }
    __device__ __forceinline__ const char* aptr(const Unit& u) const { return HB + (size_t)u.pm * 256 * D * 2; }
    __device__ __forceinline__ const char* bptr(const Unit& u) const { return W + ((size_t)u.aux * 1024 + (size_t)u.pn * 256) * D * 2; }
};

__device__ __forceinline__ void transpose_item(const float* W, int srcN, int k0, int n0, bf16_t* WT, int dpitch, int drow0, int dcol0, LAS float* scr, int lane) {
    float wv[32];
#pragma unroll
    for (int i = 0; i < 32; ++i) { const int kk = 2 * i + (lane >> 5); wv[i] = __builtin_nontemporal_load(W + (size_t)(k0 + kk) * srcN + n0 + (lane & 31)); }
    __builtin_amdgcn_sched_barrier(0);
#pragma unroll
    for (int i = 0; i < 32; ++i) { const int kk = 2 * i + (lane >> 5); scr[kk * 33 + (lane & 31)] = wv[i]; }
    asm volatile("s_waitcnt lgkmcnt(0)" ::: "memory");
    const int c = lane & 7;
#pragma unroll
    for (int j = 0; j < 4; ++j) { const int n = (lane >> 3) + 8 * j; const LAS float* s = scr + (8 * c) * 33 + n;
        u32x4 o; o.x = pk2(s[0 * 33], s[1 * 33]); o.y = pk2(s[2 * 33], s[3 * 33]); o.z = pk2(s[4 * 33], s[5 * 33]); o.w = pk2(s[6 * 33], s[7 * 33]);
        *(u32x4*)(WT + (size_t)(drow0 + n) * dpitch + dcol0 + k0 + 8 * c) = o; }
    asm volatile("s_waitcnt lgkmcnt(0)" ::: "memory");
}
constexpr int CV_IN = 16 * (IN_DIM / 32), CV_BR = 8 * 32, CV_OUT = 16 * 32, CV_E = 16 * 32;
constexpr int CV_DENSE = CV_IN + 2 * CV_BR + CV_OUT, CV_GU_END = CV_DENSE + NE * 2 * CV_E, CV_ITEMS = CV_GU_END + NE * CV_E;
__device__ __forceinline__ bf16_t* weights_of(const Frame& F, const Args& a, int l) { return l == 0 ? (bf16_t*)(F.ws + WS_W) : (bf16_t*)((unsigned char*)a.out + W1_OFF); }
__device__ __forceinline__ void convert_weights(const Frame& F, const Args& a, int l, int it_lo, int it_hi, int worker, int nworkers) {
    LAS float* scr = (LAS float*)(F.lds + F.wave * 8448);
    bf16_t* Wb = weights_of(F, a, l);
    bf16_t* WIN = Wb + W_IN / 2; bf16_t* WBR = Wb + W_BR / 2; bf16_t* WOUT = Wb + W_OUT / 2; bf16_t* WGU = Wb + W_GU / 2; bf16_t* WDN = Wb + W_DN / 2;
    constexpr int I_IN = CV_IN, I_BR = CV_BR, I_OUT = CV_OUT, I_E = CV_E;
    const int gw = worker * 8 + F.wave, NGW = nworkers * 8;
    for (int it = it_lo + gw; it < it_hi; it += NGW) {
        int r = it;
        if (r < I_IN) { const int nblk = IN_DIM / 32, kb = r / nblk, nb = r % nblk; const int src = 32 * nb; int d0;
            if (src < 768) d0 = src;
            else if (src < 1280) { const int j = (src - 768) >> 7, c = (src - 768) & 127; d0 = 768 + 256 * j + c; }
            else if (src < 1792) { const int j = (src - 1280) >> 7, c = (src - 1280) & 127; d0 = 768 + 256 * j + 128 + c; }
            else if (src < 2304) d0 = 1792 + (src - 1792);
            else if (src < 2816) d0 = 2304 + (src - 2304);
            else if (src < 3328) d0 = N1 + (src - 2816);
            else if (src < 4352) { const int c = src - 3328; d0 = N1 + 512 + 256 * (c >> 7) + (c & 127); }
            else { const int c = src - 4352; d0 = N1 + 512 + 256 * (c >> 7) + 128 + (c & 127); }
            transpose_item(a.w_in + (size_t)l * D * IN_DIM, IN_DIM, 64 * kb, src, WIN, D, d0, 0, scr, F.lane);
            continue; } r -= I_IN;
        if (r < I_BR) { const int kb = r / 32, nb = r % 32; transpose_item(a.w_bra + (size_t)l * 512 * D, D, 64 * kb, 32 * nb, WBR, D, 32 * nb, 0, scr, F.lane); continue; } r -= I_BR;
        if (r < I_BR) { const int kb = r / 32, nb = r % 32; transpose_item(a.w_brh + (size_t)l * 512 * D, D, 64 * kb, 32 * nb, WBR, D, 32 * nb, 512, scr, F.lane); continue; } r -= I_BR;
        if (r < I_OUT) { const int kb = r / 32, nb = r % 32; transpose_item(a.w_out + (size_t)l * D * D, D, 64 * kb, 32 * nb, WOUT, D, 32 * nb, 0, scr, F.lane); continue; } r -= I_OUT;
        if (r < NE * 2 * I_E) {
            const int e = r / (2 * I_E), q = r % (2 * I_E), which = q / I_E, s = q % I_E, kb = s / 32, nb = s % 32;
            const size_t eoff = ((size_t)l * NE + e) * D * D;
            if (which == 0) transpose_item(a.w_gate + eoff, D, 64 * kb, 32 * nb, WGU + (size_t)e * 2048 * D, D, (nb >> 2) * 256 + (nb & 3) * 32, 0, scr, F.lane);
            else            transpose_item(a.w_up + eoff, D, 64 * kb, 32 * nb, WGU + (size_t)e * 2048 * D, D, (nb >> 2) * 256 + 128 + (nb & 3) * 32, 0, scr, F.lane);
            continue; } r -= NE * 2 * I_E;
        { const int e = r / I_E, s = r % I_E, kb = s / 32, nb = s % 32;
          transpose_item(a.w_down + ((size_t)l * NE + e) * D * D, D, 64 * kb, 32 * nb, WDN + (size_t)e * D * D, D, 32 * nb, 0, scr, F.lane); }
    }
}
__device__ __forceinline__ void convert_in_tail(const Frame& F, const Args& a, int total, int l, int it_lo, int it_hi) {
    const int rem = total % F.G, c = F.bx;
    if (rem == 0) convert_weights(F, a, l, it_lo, it_hi, c, F.G);
    else if (c >= rem) convert_weights(F, a, l, it_lo, it_hi, c - rem, F.G - rem);
}
constexpr int CVS_P0 = CV_DENSE;
constexpr int CVS_A = CVS_P0 + 9000, CVS_B = CVS_A + 6500;
constexpr int CVS_C = CV_DENSE + 4000, CVS_D = CVS_C + 5000;
static_assert(CVS_B < CV_ITEMS && CVS_D < CV_GU_END, "conversion slices");
__device__ __forceinline__ void mod_items(const Frame& F, const Args& a) {
    LAS float* sct = (LAS float*)(F.lds + 69632);
    LAS float* red = (LAS float*)(F.lds);
    if (blockIdx.x < 192) {
        for (int i = F.tid; i < 9 * 1024; i += 512) { const int g = i >> 10, k = i & 1023; const float cv = g < NB ? a.c[g * D + k] : a.c_ctx[k]; sct[k * 12 + g] = siluf_(cv); }
    }
    __syncthreads();
    if (blockIdx.x < 192) {
        const int it = blockIdx.x, l = it / 96, n = (it % 96) * 64 + F.lane;
        const float* W = a.w_mod + (size_t)l * D * 6144 + n;
        float acc[9];
#pragma unroll
        for (int g = 0; g < 9; ++g) acc[g] = 0.f;
        for (int k0 = 128 * F.wave; k0 < 128 * F.wave + 128; k0 += 16) {
            float w[16];
#pragma unroll
            for (int j = 0; j < 16; ++j) w[j] = W[(size_t)(k0 + j) * 6144];
#pragma unroll
            for (int j = 0; j < 16; ++j) {
                const f32x4 s0 = *(const LAS f32x4*)(sct + (k0 + j) * 12), s1 = *(const LAS f32x4*)(sct + (k0 + j) * 12 + 4); const float s8 = sct[(k0 + j) * 12 + 8];
                acc[0] += s0[0] * w[j]; acc[1] += s0[1] * w[j]; acc[2] += s0[2] * w[j]; acc[3] += s0[3] * w[j];
                acc[4] += s1[0] * w[j]; acc[5] += s1[1] * w[j]; acc[6] += s1[2] * w[j]; acc[7] += s1[3] * w[j]; acc[8] += s8 * w[j];
            }
        }
#pragma unroll
        for (int g = 0; g < 9; ++g) red[(F.wave * 9 + g) * 64 + F.lane] = acc[g];
    }
    __syncthreads();
    if (blockIdx.x < 192) {
        const int it = blockIdx.x, l = it / 96;
        float* MOD = (float*)(F.ws + WS_MOD);
        for (int i = F.tid; i < 9 * 64; i += 512) { const int g = i >> 6, ln = i & 63; const int n = (it % 96) * 64 + ln;
            float v = a.b_mod[l * 6144 + n];
#pragma unroll
            for (int w = 0; w < 8; ++w) v += red[(w * 9 + g) * 64 + ln];
            MOD[(size_t)(l * 9 + g) * 6144 + n] = v; }
    }
    __syncthreads();
}
__device__ __forceinline__ void small_tables(const Frame& F, const Args& a) {
    if (blockIdx.x == gridDim.x - 1) {
        float* rope = (float*)(F.ws + WS_ROPE);
        for (int i = F.tid; i < 2048; i += 512) { const int pos = i >> 4, d = i & 15; const float inv = powf(10000.0f, -(float)d / 16.0f); const float ang = (float)pos * inv; rope[i] = cosf(ang); rope[2048 + i] = sinf(ang); }
        float* LB = (float*)(F.ws + WS_LB);
        for (int i = F.tid; i < 1024; i += 512) { const int dir = i >> 9, k = i & 511; const float* src = dir ? a.lb_bw : a.lb_fw;
            const float a0 = src[k], a1 = src[512 + k]; const float mx = fmaxf(a0, a1); const float e0 = expf(a0 - mx), e1 = expf(a1 - mx);
            LB[0 * 1024 + i] = 0.0f; LB[1 * 1024 + i] = e1 / (e0 + e1); }
    }
}
__device__ __forceinline__ void ln_mod_rows(const Frame& F, const Args& a) {
    const float* MOD = (const float*)(F.ws + WS_MOD);
    bf16_t* U = (bf16_t*)(F.ws + WS_U);
    const int gw = F.vcu * 8 + F.wave, NGW = F.G * 8, lane = F.lane;
    f32x4 xr[4][4];
    auto ld = [&](int grp) {
        const int row0 = grp * 4;
        const float* xin = row0 < NLAT ? a.x + (size_t)row0 * D : a.ctx + (size_t)(row0 - NLAT) * D;
#pragma unroll
        for (int s2 = 0; s2 < 2; ++s2)
#pragma unroll
            for (int r = 0; r < 4; ++r) { const int c0 = 512 * s2 + 8 * lane; xr[r][2 * s2] = *(const f32x4*)(xin + (size_t)r * D + c0); xr[r][2 * s2 + 1] = *(const f32x4*)(xin + (size_t)r * D + c0 + 4); }
    };
    if (gw < MROWS / 4) ld(gw);
    for (int grp = gw; grp < MROWS / 4; grp += NGW) {
        const int row0 = grp * 4;
        const float* md = MOD + (size_t)(0 * 9 + mod_group(row0)) * 6144;
        f32x4 v[4][4];
#pragma unroll
        for (int r = 0; r < 4; ++r)
#pragma unroll
            for (int q = 0; q < 4; ++q) v[r][q] = xr[r][q];
        if (grp + NGW < MROWS / 4) ld(grp + NGW);
        float rstd[4];
#pragma unroll
        for (int r = 0; r < 4; ++r) {
            const float mean = wsum((hsum4(v[r][0]) + hsum4(v[r][1])) + (hsum4(v[r][2]) + hsum4(v[r][3]))) * (1.f / D);
#pragma unroll
            for (int q = 0; q < 4; ++q) v[r][q] = v[r][q] - mean;
            rstd[r] = 1.0f / sqrtf(wsum((hsq4(v[r][0]) + hsq4(v[r][1])) + (hsq4(v[r][2]) + hsq4(v[r][3]))) * (1.f / D) + LN_EPS);
        }
#pragma unroll
        for (int s2 = 0; s2 < 2; ++s2) {
            const int c0 = 512 * s2 + 8 * lane;
            const f32x4 sca = *(const f32x4*)(md + 1024 + c0) + 1.0f, scb = *(const f32x4*)(md + 1024 + c0 + 4) + 1.0f, sha = *(const f32x4*)(md + c0), shb = *(const f32x4*)(md + c0 + 4);
#pragma unroll
            for (int r = 0; r < 4; ++r) *(u32x4*)(U + (size_t)(row0 + r) * D + c0) = pack8(v[r][2 * s2] * rstd[r] * sca + sha, v[r][2 * s2 + 1] * rstd[r] * scb + shb);
        }
    }
}

constexpr int AT_PITCH = 144;
__device__ __forceinline__ int crow(int r, int hi) { return (r & 3) + 8 * (r >> 2) + 4 * hi; }
typedef short v4i16_t __attribute__((ext_vector_type(4)));
__device__ __forceinline__ s16x4 tr_read(const LAS unsigned char* p) { return __builtin_bit_cast(s16x4, __builtin_amdgcn_ds_read_tr16_b64_v4i16((LAS v4i16_t*)p)); }

__device__ __forceinline__ void attn_unit(const Frame& F, const bf16_t* Z1, bf16_t* AH, const float* sink, int qrow0, int g, int crow0, int wrow0, int nb) {
    const int tid = F.tid, lane = F.lane, wid = F.wave, r32 = lane & 31, hi = lane >> 5;
    const int hh = wid >> 1, th = wid & 1, head = 4 * g + hh;
    LAS unsigned char* Kt = F.lds; LAS unsigned char* Vt = F.lds + 2 * 64 * AT_PITCH;
    bf16x8 qf[2][4];
#pragma unroll
    for (int qb = 0; qb < 2; ++qb)
#pragma unroll
        for (int s = 0; s < 4; ++s) qf[qb][s] = *(const bf16x8*)(Z1 + (size_t)(qrow0 + 64 * th + 32 * qb + r32) * ZQP + ZC_Q + 64 * head + 16 * s + 8 * hi);
    f32x16 ot[2][2];
#pragma unroll
    for (int a = 0; a < 2; ++a)
#pragma unroll
        for (int b = 0; b < 2; ++b) ot[a][b] = (f32x16){};
    const float sk = sink[head] * 1.44269504089f;
    float mrun[2] = {sk, sk}, lsum[2] = {hi == 0 ? 1.0f : 0.0f, hi == 0 ? 1.0f : 0.0f};
    const int srow = tid >> 3, sch = tid & 7;
    u32x4 kreg, vreg;
    auto tile_row0 = [&](int ti) -> int { if (ti < 4) return crow0 + 64 * ti; if (nb < 0) return -1; const int ts = 128 * nb - 128 + 64 * (ti - 4); return (ts < 0 || ts >= SEQ) ? -1 : wrow0 + ts; };
    auto load_tile = [&](int row0) { const bf16_t* p = Z1 + (size_t)(row0 + srow) * ZQP + 64 * g + 8 * sch; kreg = *(const u32x4*)(p + ZC_K); vreg = *(const u32x4*)(p + ZC_V); };
    int ti = 0; int row0 = tile_row0(0); load_tile(row0);
    int buf = 0;
    while (ti < 10) {
        *(LAS u32x4*)(Kt + buf * 64 * AT_PITCH + srow * AT_PITCH + sch * 16) = kreg;
        *(LAS u32x4*)(Vt + buf * 64 * AT_PITCH + srow * AT_PITCH + sch * 16) = vreg;
        __syncthreads();
        int tn = ti + 1, rown = -1;
        while (tn < 10) { rown = tile_row0(tn); if (rown >= 0) break; ++tn; }
        if (tn < 10) load_tile(rown);
        const bool win = ti >= 4;
        const int w = ti - 4;
        const bool skip = win && ((th == 0 && w == 5) || (th == 1 && w == 0));
        if (!skip) {
            const LAS unsigned char* Kb = Kt + buf * 64 * AT_PITCH; const LAS unsigned char* Vb = Vt + buf * 64 * AT_PITCH;
#pragma unroll
            for (int kb = 0; kb < 2; ++kb) {
                bf16x8 kf[4];
#pragma unroll
                for (int s = 0; s < 4; ++s) kf[s] = *(const LAS bf16x8*)(Kb + (32 * kb + r32) * AT_PITCH + (16 * s + 8 * hi) * 2);
                f32x16 sc[2];
#pragma unroll
                for (int qb = 0; qb < 2; ++qb) { sc[qb] = (f32x16){};
#pragma unroll
                    for (int s = 0; s < 4; ++s) sc[qb] = __builtin_amdgcn_mfma_f32_32x32x16_bf16(kf[s], qf[qb][s], sc[qb], 0, 0, 0); }
                bf16x8 pb[2][2];
#pragma unroll
                for (int qb = 0; qb < 2; ++qb) {
                    if (win && (w == th || w == th + 4)) {
                        const int irel = 64 * th + 32 * qb + r32;
                        const int jrel0 = -128 + 64 * w + 32 * kb;
#pragma unroll
                        for (int r = 0; r < 16; ++r) { const int dj = jrel0 + crow(r, hi) - irel; if (dj > 128 || dj < -128) sc[qb][r] = -INFINITY; }
                    }
                    float mx = sc[qb][0];
#pragma unroll
                    for (int r = 1; r < 16; ++r) mx = fmaxf(mx, sc[qb][r]);
                    { const auto sw = __builtin_amdgcn_permlane32_swap(__float_as_uint(mx), __float_as_uint(mx), false, false); mx = fmaxf(__uint_as_float(sw[0]), __uint_as_float(sw[1])); }
                    const float mnew = fmaxf(mrun[qb], mx);
                    const float fsc = __builtin_amdgcn_exp2f(mrun[qb] - mnew);
                    mrun[qb] = mnew;
                    float p[16];
                    f32x2_t ps2 = {0.f, 0.f};
                    const f32x2_t mn2 = {mnew, mnew};
#pragma unroll
                    for (int r = 0; r < 16; r += 2) { const f32x2_t d = (f32x2_t){sc[qb][r], sc[qb][r + 1]} - mn2; p[r] = __builtin_amdgcn_exp2f(d[0]); p[r + 1] = __builtin_amdgcn_exp2f(d[1]); ps2 += (f32x2_t){p[r], p[r + 1]}; }
                    const float ps = ps2[0] + ps2[1];
                    lsum[qb] = lsum[qb] * fsc + ps;
                    if (__any(fsc != 1.0f)) {
#pragma unroll
                        for (int dbl = 0; dbl < 2; ++dbl)
#pragma unroll
                            for (int r = 0; r < 16; ++r) ot[qb][dbl][r] *= fsc;
                    }
#pragma unroll
                    for (int s2 = 0; s2 < 2; ++s2) { u32x4 wv; wv.x = pk2(p[8 * s2 + 0], p[8 * s2 + 1]); wv.y = pk2(p[8 * s2 + 2], p[8 * s2 + 3]); wv.z = pk2(p[8 * s2 + 4], p[8 * s2 + 5]); wv.w = pk2(p[8 * s2 + 6], p[8 * s2 + 7]);
                        pb[qb][s2] = __builtin_bit_cast(bf16x8, wv); }
                }
#pragma unroll
                for (int dbl = 0; dbl < 2; ++dbl)
#pragma unroll
                    for (int s2 = 0; s2 < 2; ++s2) {
                        const int kv0 = 32 * kb + 16 * s2 + 4 * hi + ((lane & 15) >> 2);
                        const int dcol = 32 * dbl + 16 * ((lane >> 4) & 1) + 4 * (lane & 3);
                        const s16x4 lo = tr_read(Vb + kv0 * AT_PITCH + dcol * 2);
                        const s16x4 hi4 = tr_read(Vb + (kv0 + 8) * AT_PITCH + dcol * 2);
                        const bf16x8 va = (bf16x8){lo[0], lo[1], lo[2], lo[3], hi4[0], hi4[1], hi4[2], hi4[3]};
#pragma unroll
                        for (int qb = 0; qb < 2; ++qb) ot[qb][dbl] = __builtin_amdgcn_mfma_f32_32x32x16_bf16(va, pb[qb][s2], ot[qb][dbl], 0, 0, 0);
                    }
            }
        }
        ti = tn; buf ^= 1;
    }
    __syncthreads();
#pragma unroll
    for (int qb = 0; qb < 2; ++qb) {
        float lt; { const auto sw = __builtin_amdgcn_permlane32_swap(__float_as_uint(lsum[qb]), __float_as_uint(lsum[qb]), false, false); lt = __uint_as_float(sw[0]) + __uint_as_float(sw[1]); }
        const float inv = 1.0f / lt;
        bf16_t* orow = AH + (size_t)(qrow0 + 64 * th + 32 * qb + r32) * D + 64 * head;
#pragma unroll
        for (int dbl = 0; dbl < 2; ++dbl)
#pragma unroll
            for (int gq = 0; gq < 4; ++gq) {
                const f32x4 v = (f32x4){ot[qb][dbl][4 * gq + 0], ot[qb][dbl][4 * gq + 1], ot[qb][dbl][4 * gq + 2], ot[qb][dbl][4 * gq + 3]} * inv;
                *(u32x2*)(orow + 32 * dbl + 8 * gq + 4 * hi) = pack4(v);
            }
    }
}
__device__ __forceinline__ void attn_phase(const Frame& F, const Args& a, int l) {
    asm volatile("s_nop 0");
    const bf16_t* Z1 = (const bf16_t*)(F.ws + WS_Z); bf16_t* AH = (bf16_t*)(F.ws + WS_AH);
    const float* sink = a.attn_sink + l * 8;
    const int total = 1024 + (l == 0 ? 32 : 0);
    for (int u = F.vcu; u < total; u += F.G) {
        if (u < 1024) { const int g = u & 1, nb = (u >> 1) & 63, b = u >> 7; attn_unit(F, Z1, AH, sink, b * SEQ + 128 * nb, g, NLAT + b * CTXL, b * SEQ, nb); }
        else { const int q = u - 1024, g = q & 1, half = (q >> 1) & 1, b = q >> 2; attn_unit(F, Z1, AH, sink, NLAT + b * CTXL + 128 * half, g, NLAT + b * CTXL, 0, -1); }
    }
}

constexpr int HG_P128 = 272, HG_PV = 80;
constexpr int HG_QK = 0, HG_QKSZ = 2 * 64 * HG_P128;
constexpr int HG_VT = 2 * HG_QKSZ, HG_VTSZ = 64 * HG_PV;
constexpr int HG_ST = HG_VT + 2 * HG_VTSZ, HG_STSZ = 32 * HG_P128, HG_END = HG_ST + 2 * HG_STSZ;
static_assert(HG_END <= RING_BYTES, "hgrn LDS");
__device__ __forceinline__ int hg_row(int b, int dir, int c, int t) {
    const int p = 64 * (c < 4 ? c : c - 4) + t;
    if (c < 4) return NLAT + b * CTXL + (dir ? (CTXL - 1 - p) : p);
    return b * SEQ + (dir ? (SEQ - 1 - p) : p);
}
template <int V> struct IntC { static constexpr int value = V; };
__device__ __forceinline__ void hgrn_item(const Frame& F, const bf16_t* Z1, const float* VECS, const bf16_t* QS  , bf16_t* OUT  , int b, int h, int dir, int vq) {
    const int tid = F.tid, lane = F.lane, wid = F.wave;
    LAS unsigned char* L = F.lds;
    const int sr = tid >> 3, sc8 = tid & 7;
    const int tv = tid >> 2, vp = tid & 3;
    const int fr = lane & 15, fq = lane >> 4;
    const int tb = wid < 4 ? (wid >> 1) : 3 - ((wid - 4) >> 1), vb = wid & 1;
    const int NC = 132;
    const size_t zq = (ZO_HG + (size_t)((dir * 4 + h) * 2) * ZA_BYTES) / 2, zk = zq + ZA_BYTES / 2;
    for (int i = tid; i < 2 * HG_STSZ / 4; i += 512) ((LAS unsigned*)(L + HG_ST))[i] = 0u;
    f32x4 Sacc[2]; Sacc[0] = (f32x4){0.f, 0.f, 0.f, 0.f}; Sacc[1] = Sacc[0];
    struct GSet { u32x4 q[2], k[2], v, qx[2]; };
    GSet g0, g1; f32x4 mte, mdc;
    g0.v = (u32x4){0u, 0u, 0u, 0u}; g1.v = g0.v; mte = (f32x4){0.f, 0.f, 0.f, 0.f}; mdc = mte;
    auto hg_load = [&](int c, GSet& g) {
        const int row_ = hg_row(b, dir, c, sr); const bf16_t* p_ = Z1 + (size_t)row_ * 128 + 16 * sc8;
        g.q[0] = *(const u32x4*)(p_ + zq); g.q[1] = *(const u32x4*)(p_ + zq + 8); g.k[0] = *(const u32x4*)(p_ + zk); g.k[1] = *(const u32x4*)(p_ + zk + 8);
        if (dir) { const bf16_t* qp_ = QS + (size_t)row_ * D + 512 + h * 128 + 16 * sc8; g.qx[0] = *(const u32x4*)qp_; g.qx[1] = *(const u32x4*)(qp_ + 8); }
        if (tid < 256) { const int rv_ = hg_row(b, dir, c, tv); g.v = *(const u32x4*)(Z1 + (ZO_IH + (size_t)h * ZA_BYTES) / 2 + (size_t)rv_ * 128 + vq * 32 + 8 * vp); }
    };
    f32x4 pte = (f32x4){0.f, 0.f, 0.f, 0.f}, pdc = pte, pee = pte;
    auto hv_load = [&](int c) { const float* vp_ = VECS + ((size_t)(dir * NCHUNK + (hg_row(b, dir, c, 0) >> 6)) * 3) * 512 + h * 128 + 16 * wid + 4 * fq;
        pte = *(const f32x4*)vp_; pdc = *(const f32x4*)(vp_ + 512); pee = *(const f32x4*)(vp_ + 1024); };
    hv_load(0);
    hg_load(0, g0); hg_load(1, g1);
    __syncthreads();
    auto step = [&](int it, GSet& g, auto parc) {
        constexpr int PAR = decltype(parc)::value;
        const f32x4 eenext = pee, tenext = pte, dcnext = pdc;
        if (it + 1 < NC) hv_load(it + 1);
        if (it < NC) {
            constexpr int pp = PAR;
            LAS unsigned char* QMt = L + HG_QK + pp * HG_QKSZ; LAS unsigned char* KMt = QMt + 64 * HG_P128;
            if (dir) {
#pragma unroll
                for (int j = 0; j < 2; ++j) { f32x4 e0, e1, q0, q1; unpack8(g.q[j], e0, e1); unpack8(g.qx[j], q0, q1); g.q[j] = pack8(e0 * q0, e1 * q1); }
            }
            *(LAS u32x4*)(QMt + sr * HG_P128 + 32 * sc8) = g.q[0]; *(LAS u32x4*)(QMt + sr * HG_P128 + 32 * sc8 + 16) = g.q[1];
            *(LAS u32x4*)(KMt + sr * HG_P128 + 32 * sc8) = g.k[0]; *(LAS u32x4*)(KMt + sr * HG_P128 + 32 * sc8 + 16) = g.k[1];
            if (tid < 256) *(LAS u32x4*)(L + HG_VT + pp * HG_VTSZ + tv * HG_PV + 16 * vp) = g.v;
        }
        const f32x4 cte = mte, cdc = mdc;
        __builtin_amdgcn_sched_barrier(0);
        if (it + 2 < NC) hg_load(it + 2, g);
        __builtin_amdgcn_sched_barrier(0);
        if (it >= 1) {
            const int c = it - 1; constexpr int pm = 1 - PAR;
            const LAS unsigned char* QMt = L + HG_QK + pm * HG_QKSZ; const LAS unsigned char* KMt = QMt + 64 * HG_P128;
            const LAS unsigned char* Vt = L + HG_VT + pm * HG_VTSZ;
            const LAS unsigned char* STr = L + HG_ST + pm * HG_STSZ;
            bf16x8 qbs[4], sas[4], ka[4][2];
#pragma unroll
            for (int s = 0; s < 4; ++s) {
                qbs[s] = *(const LAS bf16x8*)(QMt + (16 * tb + fr) * HG_P128 + (32 * s + 8 * fq) * 2);
                sas[s] = *(const LAS bf16x8*)(STr + (16 * vb + fr) * HG_P128 + (32 * s + 8 * fq) * 2);
                ka[s][0] = *(const LAS bf16x8*)(KMt + fr * HG_P128 + (32 * s + 8 * fq) * 2);
            }
            if (tb >= 1) {
#pragma unroll
                for (int s = 0; s < 4; ++s) ka[s][1] = *(const LAS bf16x8*)(KMt + (16 + fr) * HG_P128 + (32 * s + 8 * fq) * 2);
            }
            __builtin_amdgcn_sched_barrier(0);
            f32x4 sc4[4], ov = (f32x4){0.f, 0.f, 0.f, 0.f}, sv[2];
#pragma unroll
            for (int sb = 0; sb < 4; ++sb) sc4[sb] = (f32x4){0.f, 0.f, 0.f, 0.f};
            sv[0] = (f32x4){0.f, 0.f, 0.f, 0.f}; sv[1] = sv[0];
#pragma unroll
            for (int s = 0; s < 4; ++s) {
                sc4[0] = __builtin_amdgcn_mfma_f32_16x16x32_bf16(ka[s][0], qbs[s], sc4[0], 0, 0, 0);
                ov = __builtin_amdgcn_mfma_f32_16x16x32_bf16(sas[s], qbs[s], ov, 0, 0, 0);
            }
            if (tb >= 1) {
#pragma unroll
                for (int s = 0; s < 4; ++s) sc4[1] = __builtin_amdgcn_mfma_f32_16x16x32_bf16(ka[s][1], qbs[s], sc4[1], 0, 0, 0);
            }
            if (tb >= 2) {
#pragma unroll
                for (int s = 0; s < 4; ++s) ka[s][0] = *(const LAS bf16x8*)(KMt + (32 + fr) * HG_P128 + (32 * s + 8 * fq) * 2);
                if (tb >= 3) {
#pragma unroll
                    for (int s = 0; s < 4; ++s) ka[s][1] = *(const LAS bf16x8*)(KMt + (48 + fr) * HG_P128 + (32 * s + 8 * fq) * 2);
                }
#pragma unroll
                for (int s = 0; s < 4; ++s) sc4[2] = __builtin_amdgcn_mfma_f32_16x16x32_bf16(ka[s][0], qbs[s], sc4[2], 0, 0, 0);
                if (tb >= 3) {
#pragma unroll
                    for (int s = 0; s < 4; ++s) sc4[3] = __builtin_amdgcn_mfma_f32_16x16x32_bf16(ka[s][1], qbs[s], sc4[3], 0, 0, 0);
                }
            }
            bf16x8 va[2], kfr[2], vf[2][2];
#pragma unroll
            for (int p2 = 0; p2 < 2; ++p2) {
                const int vrow = 32 * p2 + 4 * fq + ((lane & 15) >> 2), vcolb = (16 * vb + 4 * (lane & 3)) * 2;
                const s16x4 lo = tr_read(Vt + vrow * HG_PV + vcolb), hi4 = tr_read(Vt + (vrow + 16) * HG_PV + vcolb);
                va[p2] = (bf16x8){lo[0], lo[1], lo[2], lo[3], hi4[0], hi4[1], hi4[2], hi4[3]};
                const int krow = 32 * p2 + 8 * fq + ((lane & 15) >> 2), kcolb = (16 * wid + 4 * (lane & 3)) * 2;
                const s16x4 klo = tr_read(KMt + krow * HG_P128 + kcolb), khi = tr_read(KMt + (krow + 4) * HG_P128 + kcolb);
                kfr[p2] = (bf16x8){klo[0], klo[1], klo[2], klo[3], khi[0], khi[1], khi[2], khi[3]};
#pragma unroll
                for (int v2 = 0; v2 < 2; ++v2) {
                    const int v2colb = (16 * v2 + 4 * (lane & 3)) * 2;
                    const s16x4 l2 = tr_read(Vt + krow * HG_PV + v2colb), h2 = tr_read(Vt + (krow + 4) * HG_PV + v2colb);
                    vf[v2][p2] = (bf16x8){l2[0], l2[1], l2[2], l2[3], h2[0], h2[1], h2[2], h2[3]};
                }
            }
#pragma unroll
            for (int s = 0; s < 2; ++s) { sv[0] = __builtin_amdgcn_mfma_f32_16x16x32_bf16(kfr[s], vf[0][s], sv[0], 0, 0, 0); sv[1] = __builtin_amdgcn_mfma_f32_16x16x32_bf16(kfr[s], vf[1][s], sv[1], 0, 0, 0); }
#pragma unroll
            for (int sb = 0; sb < 4; ++sb) if (tb == sb) {
#pragma unroll
                for (int r = 0; r < 4; ++r) if (4 * fq + r > fr) sc4[sb][r] = 0.f;
            }
            {
                const u32x2 blo = pack4(sc4[0]), bhi = pack4(sc4[1]);
                const bf16x8 ab = __builtin_bit_cast(bf16x8, (u32x4){blo.x, blo.y, bhi.x, bhi.y});
                ov = __builtin_amdgcn_mfma_f32_16x16x32_bf16(va[0], ab, ov, 0, 0, 0);
            }
            if (tb >= 2) {
                const u32x2 blo = pack4(sc4[2]), bhi = pack4(sc4[3]);
                const bf16x8 ab = __builtin_bit_cast(bf16x8, (u32x4){blo.x, blo.y, bhi.x, bhi.y});
                ov = __builtin_amdgcn_mfma_f32_16x16x32_bf16(va[1], ab, ov, 0, 0, 0);
            }
            { const int row = hg_row(b, dir, c, 16 * tb + fr);
              *(u32x2*)(OUT + (size_t)row * 512 + h * 128 + vq * 32 + 16 * vb + 4 * fq) = pack4(ov); }
            Sacc[0] = Sacc[0] * cdc + sv[0] * cte; Sacc[1] = Sacc[1] * cdc + sv[1] * cte;
            if (it < NC) {
#pragma unroll
                for (int v2 = 0; v2 < 2; ++v2) *(LAS u32x2*)(L + HG_ST + PAR * HG_STSZ + (16 * v2 + fr) * HG_P128 + (16 * wid + 4 * fq) * 2) = pack4(Sacc[v2] * eenext);
            }
        }
        mte = tenext; mdc = dcnext;
        asm volatile("s_waitcnt lgkmcnt(0)" ::: "memory"); __builtin_amdgcn_s_barrier(); asm volatile("" ::: "memory");
    };
    for (int it = 0; it <= NC; it += 2) { step(it, g0, IntC<0>{}); if (it + 1 <= NC) step(it + 1, g1, IntC<1>{}); }
}
__device__ __forceinline__ void hgrn_phase(const Frame& F) {
    const bf16_t* Z1 = (const bf16_t*)(F.ws + WS_Z);
    bf16_t* OFW = (bf16_t*)(F.ws + WS_O); bf16_t* OBW = OFW + (size_t)MROWS * 512;
    for (int it = F.vcu; it < 256; it += F.G) {
        const int vq = it & 3, dir = (it >> 2) & 1, h = (it >> 3) & 3, b = it >> 5;
        hgrn_item(F, Z1, (const float*)(F.ws + WS_VECS), (const bf16_t*)(F.ws + WS_AH), dir ? OBW : OFW, b, h, dir, vq);
        __syncthreads();
    }
}
__device__ __forceinline__ void readout_phase(const Frame& F, const Args& a, int l, int M) {
    const bf16_t* OFW = (const bf16_t*)(F.ws + WS_O); const bf16_t* OBW = OFW + (size_t)MROWS * 512;
    const bf16_t* Z2 = (const bf16_t*)(F.ws + WS_Z); bf16_t* AH = (bf16_t*)(F.ws + WS_AH);
    const float* ng = a.norm_g + l * 512;
    const int gw = F.vcu * 8 + F.wave, NGW = F.G * 8, lane = F.lane;
    const f32x4 g0 = *(const f32x4*)(ng + 8 * lane), g1 = *(const f32x4*)(ng + 8 * lane + 4);
    u32x4 ra[4], rb[4], rs4[4];
    auto ld = [&](int grp) {
#pragma unroll
        for (int r = 0; r < 4; ++r) { const size_t off = (size_t)(grp * 4 + r) * 512 + 8 * lane; ra[r] = *(const u32x4*)(OFW + off); rb[r] = *(const u32x4*)(OBW + off); rs4[r] = *(const u32x4*)(Z2 + off); }
    };
    if (gw < M / 4) ld(gw);
    for (int grp = gw; grp < M / 4; grp += NGW) {
        f32x4 oa[4], ob[4], sa[4], sb[4];
#pragma unroll
        for (int r = 0; r < 4; ++r) { f32x4 x0, x1, y0, y1; unpack8(ra[r], x0, x1); unpack8(rb[r], y0, y1); oa[r] = x0 + y0; ob[r] = x1 + y1; unpack8(rs4[r], sa[r], sb[r]); }
        if (grp + NGW < M / 4) ld(grp + NGW);
#pragma unroll
        for (int r = 0; r < 4; ++r) {
            const float ss = row16_sum(hsq4(oa[r]) + hsq4(ob[r]));
            const float rs = 1.0f / sqrtf(ss * (1.0f / 128.0f) + LN_EPS);
            *(u32x4*)(AH + (size_t)(grp * 4 + r) * D + 512 + 8 * lane) = pack8(oa[r] * rs * g0 * sa[r], ob[r] * rs * g1 * sb[r]);
        }
    }
}

__device__ __forceinline__ void row_pass1(const Frame& F, const Args& a, int l, int M) {
    LAS float* wrT = (LAS float*)F.lds;
    constexpr int WRP = D + 4;
    const float* wr = a.w_router + (size_t)l * D * NE;
    for (int i = F.tid; i < D * NE; i += 512) { const int d = i >> 4, e = i & 15; wrT[e * WRP + d] = wr[i]; }
    __syncthreads();
    const float* MOD = (const float*)(F.ws + WS_MOD);
    const bf16_t* Y = (const bf16_t*)(F.ws + WS_AH);
    bf16_t* U2 = (bf16_t*)(F.ws + WS_U);
    float* XC = (float*)(F.ws + WS_XC);
    float* AFF = (float*)(F.ws + WS_AFF); float* AFFT = (float*)(F.ws + WS_AFFT);
    const float* lng = a.ln_g + (size_t)(l * 2 + 0) * D; const float* lnb = a.ln_b + (size_t)(l * 2 + 0) * D;
    const int gw = F.vcu * 8 + F.wave, NGW = F.G * 8, lane = F.lane;
    u32x4 xr[4][4];
    const bool xbf = l == 1;
    bf16_t* X1 = (bf16_t*)(F.ws + WS_O);
    auto rp1_load = [&](int grp) {
        const int row0 = grp * 4; const bool lat = row0 < NLAT;
        if (lat && xbf) {
            const bf16_t* xin = (const bf16_t*)a.out + (size_t)row0 * D;
#pragma unroll
            for (int s2 = 0; s2 < 2; ++s2)
#pragma unroll
                for (int r = 0; r < 4; ++r) xr[r][2 * s2] = *(const u32x4*)(xin + (size_t)r * D + 512 * s2 + 8 * lane);
        } else {
            const float* xin = lat ? a.x + (size_t)row0 * D : (l == 0 ? a.ctx + (size_t)(row0 - NLAT) * D : XC + (size_t)(row0 - NLAT) * D);
#pragma unroll
            for (int s2 = 0; s2 < 2; ++s2)
#pragma unroll
                for (int r = 0; r < 4; ++r) {
                    const int c0 = 512 * s2 + 8 * lane;
                    xr[r][2 * s2] = *(const u32x4*)(xin + (size_t)r * D + c0); xr[r][2 * s2 + 1] = *(const u32x4*)(xin + (size_t)r * D + c0 + 4);
                }
        }
    };
    if (gw < M / 4) rp1_load(gw);
    for (int grp = gw; grp < M / 4; grp += NGW) {
        const int row0 = grp * 4; const bool lat = row0 < NLAT;
        float* xo = XC + (size_t)(lat ? 0 : row0 - NLAT) * D;
        const float* md = MOD + (size_t)(l * 9 + mod_group(row0)) * 6144;
        f32x4 v[4][4];
#pragma unroll
        for (int s2 = 0; s2 < 2; ++s2) {
            const int c0 = 512 * s2 + 8 * lane;
            const f32x4 ga = *(const f32x4*)(md + 2048 + c0), gb = *(const f32x4*)(md + 2048 + c0 + 4);
#pragma unroll
            for (int r = 0; r < 4; ++r) {
                f32x4 ya, yb; unpack8(*(const u32x4*)(Y + (size_t)(row0 + r) * D + c0), ya, yb);
                f32x4 xa, xb; if (lat && xbf) unpack8(xr[r][2 * s2], xa, xb); else { xa = __builtin_bit_cast(f32x4, xr[r][2 * s2]); xb = __builtin_bit_cast(f32x4, xr[r][2 * s2 + 1]); }
                v[r][2 * s2] = xa * ALPHA + ga * ya; v[r][2 * s2 + 1] = xb * ALPHA + gb * yb;
            }
        }
        if (grp + NGW < M / 4) rp1_load(grp + NGW);
        float rstd[4];
#pragma unroll
        for (int r = 0; r < 4; ++r) {
            const float mean = wsum((hsum4(v[r][0]) + hsum4(v[r][1])) + (hsum4(v[r][2]) + hsum4(v[r][3]))) * (1.f / D);
#pragma unroll
            for (int q = 0; q < 4; ++q) v[r][q] = v[r][q] - mean;
            rstd[r] = 1.0f / sqrtf(wsum((hsq4(v[r][0]) + hsq4(v[r][1])) + (hsq4(v[r][2]) + hsq4(v[r][3]))) * (1.f / D) + LN_EPS);
        }
#pragma unroll
        for (int q = 0; q < 4; ++q) {
            const int c0 = 512 * (q >> 1) + 8 * lane + 4 * (q & 1);
            const f32x4 g = *(const f32x4*)(lng + c0), bb = *(const f32x4*)(lnb + c0);
#pragma unroll
            for (int r = 0; r < 4; ++r) { v[r][q] = v[r][q] * rstd[r] * g + bb; if (!lat) *(f32x4*)(xo + (size_t)r * D + c0) = v[r][q]; }
        }
        if (lat) {
#pragma unroll
            for (int s2 = 0; s2 < 2; ++s2)
#pragma unroll
                for (int r = 0; r < 4; ++r) *(u32x4*)(X1 + (size_t)(row0 + r) * D + 512 * s2 + 8 * lane) = pack8(v[r][2 * s2], v[r][2 * s2 + 1]);
        }
#pragma unroll
        for (int r = 0; r < 4; ++r) {
            const float mean = wsum((hsum4(v[r][0]) + hsum4(v[r][1])) + (hsum4(v[r][2]) + hsum4(v[r][3]))) * (1.f / D);
#pragma unroll
            for (int q = 0; q < 4; ++q) v[r][q] = v[r][q] - mean;
            rstd[r] = 1.0f / sqrtf(wsum((hsq4(v[r][0]) + hsq4(v[r][1])) + (hsq4(v[r][2]) + hsq4(v[r][3]))) * (1.f / D) + LN_EPS);
        }
#pragma unroll
        for (int s2 = 0; s2 < 2; ++s2) {
            const int c0 = 512 * s2 + 8 * lane;
            const f32x4 sca = *(const f32x4*)(md + 4096 + c0) + 1.0f, scb = *(const f32x4*)(md + 4096 + c0 + 4) + 1.0f, sha = *(const f32x4*)(md + 3072 + c0), shb = *(const f32x4*)(md + 3072 + c0 + 4);
#pragma unroll
            for (int r = 0; r < 4; ++r) {
                v[r][2 * s2] = v[r][2 * s2] * rstd[r] * sca + sha; v[r][2 * s2 + 1] = v[r][2 * s2 + 1] * rstd[r] * scb + shb;
                *(u32x4*)(U2 + (size_t)(row0 + r) * D + c0) = pack8(v[r][2 * s2], v[r][2 * s2 + 1]);
            }
        }
        float p[64];
#pragma unroll
        for (int e = 0; e < 16; ++e) {
            f32x4 pa[4];
#pragma unroll
            for (int r = 0; r < 4; ++r) pa[r] = (f32x4){0.f, 0.f, 0.f, 0.f};
#pragma unroll
            for (int q = 0; q < 4; ++q) {
                const f32x4 w4 = *(const LAS f32x4*)(wrT + e * WRP + 512 * (q >> 1) + 8 * lane + 4 * (q & 1));
#pragma unroll
                for (int r = 0; r < 4; ++r) pa[r] = __builtin_elementwise_fma(v[r][q], w4, pa[r]);
            }
#pragma unroll
            for (int r = 0; r < 4; ++r) p[r * 16 + e] = hsum4(pa[r]);
            asm volatile("" ::: "memory");
        }
#pragma unroll
        for (int i = 0; i < 32; ++i) { const auto sw = __builtin_amdgcn_permlane32_swap(__float_as_uint(p[i]), __float_as_uint(p[i + 32]), false, false); p[i] = __uint_as_float(sw[0]) + __uint_as_float(sw[1]); }
#define BFLY_(N, MK) { const bool hi_ = (lane & MK) != 0; _Pragma("unroll") for (int i = 0; i < N / 2; ++i) { const float send = hi_ ? p[i] : p[i + N / 2]; const float keep = hi_ ? p[i + N / 2] : p[i]; p[i] = keep + shx(send, MK, lane); } }
        BFLY_(32, 16) BFLY_(16, 8) BFLY_(8, 4) BFLY_(4, 2) BFLY_(2, 1)
#undef BFLY_
        const float lg = p[0];
        const float mx = row16_max(lg);
        const float ex = expf(lg - mx);
        const float mine = ex / row16_sum(ex);
        const int r = lane >> 4, e = lane & 15, row = row0 + r;
        AFF[(size_t)row0 * 16 + lane] = mine;
        if (lat) AFFT[((size_t)(row >> 13) * 16 + e) * SEQ + (row & (SEQ - 1))] = mine;
        else { const int rc = row - NLAT; AFFT[(size_t)NB * 16 * SEQ + ((size_t)(rc >> 8) * 16 + e) * CTXL + (rc & (CTXL - 1))] = mine; }
    }
}
__device__ __forceinline__ void topk_phase(const Frame& F, int l) {
    LAS unsigned* vals = (LAS unsigned*)F.lds;
    LAS unsigned* hist = (LAS unsigned*)(F.lds + 32768);
    LAS unsigned* wtot = (LAS unsigned*)(F.lds + 32768 + 1024);
    LAS unsigned* ctl = (LAS unsigned*)(F.lds + 32768 + 1024 + 64);
    const float* AFFT = (const float*)(F.ws + WS_AFFT);
    int* SEL = (int*)(F.ws + WS_SEL); int* INV = (int*)(F.ws + WS_INV);
    const int total = 128 + (l == 0 ? 128 : 0);
    for (int u = F.vcu; u < total; u += F.G) {
        const bool lat = u < 128; const int q = lat ? u : u - 128, b = q >> 4, e = q & 15;
        const int n = lat ? SEQ : CTXL, cap = lat ? CAP : CAPC;
        const float* src = lat ? AFFT + (size_t)q * SEQ : AFFT + (size_t)NB * 16 * SEQ + (size_t)q * CTXL;
        for (int i = F.tid; i < n; i += 512) vals[i] = __float_as_uint(src[i]);
        if (F.tid == 0) { ctl[0] = 0u; ctl[1] = (unsigned)cap; }
        __syncthreads();
        unsigned mask = 0u;
        for (int pass = 0; pass < 4; ++pass) {
            const int shift = 24 - 8 * pass;
            if (F.tid < 256) hist[F.tid] = 0u;
            __syncthreads();
            const unsigned prefix = ctl[0];
            for (int i = F.tid; i < n; i += 512) { const unsigned v = vals[i]; if ((v & mask) == prefix) __hip_atomic_fetch_add(&hist[(v >> shift) & 255u], 1u, __ATOMIC_RELAXED, __HIP_MEMORY_SCOPE_WORKGROUP); }
            __syncthreads();
            if (F.wave == 0) {
                const unsigned kk = ctl[1];
                const u32x4 h4 = *(const LAS u32x4*)(hist + 4 * F.lane);
                const unsigned sl = (h4.x + h4.y) + (h4.z + h4.w);
                unsigned inc = sl;
#pragma unroll
                for (int o = 1; o < 64; o <<= 1) { const unsigned x = shup_u(inc, o, F.lane); if (F.lane >= o) inc += x; }
                const unsigned tot = (unsigned)__builtin_amdgcn_readlane((int)inc, 63);
                const bool reach = tot - (inc - sl) >= kk;
                const unsigned long long bm = __ballot(reach);
                const int ls = bm ? 63 - __builtin_clzll(bm) : 0;
                unsigned cum = tot - (unsigned)__builtin_amdgcn_readlane((int)inc, ls);
                const unsigned c3 = (unsigned)__builtin_amdgcn_readlane((int)h4.w, ls), c2 = (unsigned)__builtin_amdgcn_readlane((int)h4.z, ls), c1 = (unsigned)__builtin_amdgcn_readlane((int)h4.y, ls);
                int bin = 4 * ls + 3;
                if (cum + c3 < kk) { cum += c3; bin = 4 * ls + 2; if (cum + c2 < kk) { cum += c2; bin = 4 * ls + 1; if (cum + c1 < kk) { cum += c1; bin = 4 * ls; } } }
                if (F.lane == 0) { ctl[0] = prefix | ((unsigned)bin << shift); ctl[1] = kk - cum; }
            }
            mask |= 255u << shift;
            __syncthreads();
        }
        const unsigned T = ctl[0], keq = ctl[1];
        const int per = n >= 512 ? n / 512 : 1; const int base = F.tid * per; const bool active = base < n;
        unsigned ngt = 0u, neq = 0u;
        if (active) for (int i = 0; i < per; ++i) { const unsigned v = vals[base + i]; ngt += v > T; neq += v == T; }
        unsigned pk = ngt | (neq << 16), inc = pk;
#pragma unroll
        for (int o = 1; o < 64; o <<= 1) { const unsigned x = shup_u(inc, o, F.lane); if (F.lane >= o) inc += x; }
        if (F.lane == 63) wtot[F.wave] = inc;
        __syncthreads();
        unsigned wpre = 0u;
        for (int w = 0; w < F.wave; ++w) wpre += wtot[w];
        const unsigned excl = wpre + inc - pk;
        unsigned cgt = excl & 0xffffu, ceq = excl >> 16;
        if (active) for (int i = 0; i < per; ++i) {
            const int t = base + i; const unsigned v = vals[t];
            bool take = false; unsigned slot = 0u;
            if (v > T) { take = true; slot = cgt + (ceq < keq ? ceq : keq); ++cgt; }
            else if (v == T) { if (ceq < keq) { take = true; slot = cgt + ceq; } ++ceq; }
            const int row = lat ? b * SEQ + t : NLAT + b * CTXL + t;
            INV[(size_t)row * 16 + e] = take ? (int)slot : -1;
            if (take) { const int xr = lat ? (b * NE + e) * CAP + (int)slot : NB * NE * CAP + (e * NB + b) * CAPC + (int)slot; SEL[xr] = row; }
        }
        __syncthreads();
    }
}
__device__ __forceinline__ void gather_phase(const Frame& F, int l) {
    const int* SEL = (const int*)(F.ws + WS_SEL);
    const bf16_t* U2 = (const bf16_t*)(F.ws + WS_U); bf16_t* XS = (bf16_t*)(F.ws + WS_Z);
    const int total = NB * NE * CAP + (l == 0 ? NB * NE * CAPC : 0);
    const int gw = F.vcu * 8 + F.wave, NGW = F.G * 8;
    for (int r = gw; r < total; r += NGW) {
        const int src = SEL[r];
        const u32x4 a0 = *(const u32x4*)(U2 + (size_t)src * D + 8 * F.lane), a1 = *(const u32x4*)(U2 + (size_t)src * D + 512 + 8 * F.lane);
        *(u32x4*)(XS + (size_t)r * D + 8 * F.lane) = a0; *(u32x4*)(XS + (size_t)r * D + 512 + 8 * F.lane) = a1;
    }
}
__device__ __forceinline__ void row_pass2(const Frame& F, const Args& a, int l, int M) {
    const float* MOD = (const float*)(F.ws + WS_MOD);
    const bf16_t* YE = (const bf16_t*)(F.ws + WS_Z);
    bf16_t* U = (bf16_t*)(F.ws + WS_U);
    float* XC = (float*)(F.ws + WS_XC);
    const float* AFF = (const float*)(F.ws + WS_AFF); const int* INV = (const int*)(F.ws + WS_INV);
    const float* lng = a.ln_g + (size_t)(l * 2 + 1) * D; const float* lnb = a.ln_b + (size_t)(l * 2 + 1) * D;
    const int gw = F.vcu * 8 + F.wave, NGW = F.G * 8, lane = F.lane;
    u32x4 xr[4][4]; int inv_n = -1; float af_n = 0.f;
    const bf16_t* X1 = (const bf16_t*)(F.ws + WS_O);
    auto rp2_load = [&](int grp) {
        const int row0 = grp * 4; const bool lat = row0 < NLAT;
        inv_n = INV[(size_t)row0 * 16 + lane]; af_n = AFF[(size_t)row0 * 16 + lane];
        if (lat) {
#pragma unroll
            for (int s2 = 0; s2 < 2; ++s2)
#pragma unroll
                for (int r = 0; r < 4; ++r) xr[r][2 * s2] = *(const u32x4*)(X1 + (size_t)(row0 + r) * D + 512 * s2 + 8 * lane);
        } else {
            const float* xin = XC + (size_t)(row0 - NLAT) * D;
#pragma unroll
            for (int q = 0; q < 4; ++q)
#pragma unroll
                for (int r = 0; r < 4; ++r) xr[r][q] = *(const u32x4*)(xin + (size_t)r * D + 512 * (q >> 1) + 8 * lane + 4 * (q & 1));
        }
    };
    if (gw < M / 4) rp2_load(gw);
    for (int grp = gw; grp < M / 4; grp += NGW) {
        const int row0 = grp * 4; const bool lat = row0 < NLAT;
        float* xio = lat ? a.out + (size_t)row0 * D : XC + (size_t)(row0 - NLAT) * D;
        const bool obf = lat && l == 0;
        const int g9 = mod_group(row0);
        const float* md = MOD + (size_t)(l * 9 + g9) * 6144;
        const int inv = inv_n; const float af = af_n;
        const unsigned long long selm = __ballot(inv >= 0);
        unsigned sel_lo = (unsigned)selm, sel_hi = (unsigned)(selm >> 32); asm volatile("" : "+s"(sel_lo), "+s"(sel_hi));
        const int b = lat ? (row0 >> 13) : ((row0 - NLAT) >> 8);
        f32x4 v[4][4];
        unsigned mk[4];
#pragma unroll
        for (int r = 0; r < 4; ++r) {
#pragma unroll
            for (int q = 0; q < 4; ++q) v[r][q] = (f32x4){0.f, 0.f, 0.f, 0.f};
            mk[r] = ((r < 2 ? sel_lo : sel_hi) >> (16 * (r & 1))) & 0xffffu;
        }
        while ((mk[0] | mk[1]) | (mk[2] | mk[3])) {
            u32x4 y0[4], y1[4]; float w[4];
#pragma unroll
            for (int r = 0; r < 4; ++r) {
                w[r] = 0.f;
                if (mk[r]) {
                    const int e = __builtin_ctz(mk[r]); mk[r] &= mk[r] - 1u;
                    const int slot = __builtin_amdgcn_readlane(inv, 16 * r + e); w[r] = rdlane(af, 16 * r + e);
                    const size_t yr = lat ? (size_t)(b * NE + e) * CAP + slot : (size_t)NB * NE * CAP + (size_t)(e * NB + b) * CAPC + slot;
                    y0[r] = *(const u32x4*)(YE + yr * D + 8 * lane); y1[r] = *(const u32x4*)(YE + yr * D + 512 + 8 * lane);
                } else { y0[r] = (u32x4){0u, 0u, 0u, 0u}; y1[r] = y0[r]; }
            }
#pragma unroll
            for (int r = 0; r < 4; ++r) {
                f32x4 ya, yb; unpack8(y0[r], ya, yb); v[r][0] += ya * w[r]; v[r][1] += yb * w[r]; unpack8(y1[r], ya, yb); v[r][2] += ya * w[r]; v[r][3] += yb * w[r];
            }
        }
#pragma unroll
        for (int q = 0; q < 4; ++q) {
            const int c0 = 512 * (q >> 1) + 8 * lane + 4 * (q & 1);
            const f32x4 g2 = *(const f32x4*)(md + 5120 + c0);
#pragma unroll
            for (int r = 0; r < 4; ++r) {
                f32x4 xv;
                if (lat) { f32x4 xa, xb; unpack8(xr[r][q & 2], xa, xb); xv = (q & 1) ? xb : xa; } else xv = __builtin_bit_cast(f32x4, xr[r][q]);
                v[r][q] = xv * ALPHA + g2 * v[r][q];
            }
        }
        if (grp + NGW < M / 4) rp2_load(grp + NGW);
        float rstd[4];
#pragma unroll
        for (int r = 0; r < 4; ++r) {
            const float mean = wsum((hsum4(v[r][0]) + hsum4(v[r][1])) + (hsum4(v[r][2]) + hsum4(v[r][3]))) * (1.f / D);
#pragma unroll
            for (int q = 0; q < 4; ++q) v[r][q] = v[r][q] - mean;
            rstd[r] = 1.0f / sqrtf(wsum((hsq4(v[r][0]) + hsq4(v[r][1])) + (hsq4(v[r][2]) + hsq4(v[r][3]))) * (1.f / D) + LN_EPS);
        }
#pragma unroll
        for (int q = 0; q < 4; ++q) {
            const int c0 = 512 * (q >> 1) + 8 * lane + 4 * (q & 1);
            const f32x4 g = *(const f32x4*)(lng + c0), bb = *(const f32x4*)(lnb + c0);
#pragma unroll
            for (int r = 0; r < 4; ++r) { v[r][q] = v[r][q] * rstd[r] * g + bb; if (!obf) *(f32x4*)(xio + (size_t)r * D + c0) = v[r][q]; }
        }
        if (obf) {
            bf16_t* X2 = (bf16_t*)a.out;
#pragma unroll
            for (int s2 = 0; s2 < 2; ++s2)
#pragma unroll
                for (int r = 0; r < 4; ++r) *(u32x4*)(X2 + (size_t)(row0 + r) * D + 512 * s2 + 8 * lane) = pack8(v[r][2 * s2], v[r][2 * s2 + 1]);
        }
        if (l == 0) {
            const float* md1 = MOD + (size_t)(1 * 9 + g9) * 6144;
#pragma unroll
            for (int r = 0; r < 4; ++r) {
                const float mean = wsum((hsum4(v[r][0]) + hsum4(v[r][1])) + (hsum4(v[r][2]) + hsum4(v[r][3]))) * (1.f / D);
#pragma unroll
                for (int q = 0; q < 4; ++q) v[r][q] = v[r][q] - mean;
                rstd[r] = 1.0f / sqrtf(wsum((hsq4(v[r][0]) + hsq4(v[r][1])) + (hsq4(v[r][2]) + hsq4(v[r][3]))) * (1.f / D) + LN_EPS);
            }
#pragma unroll
            for (int s2 = 0; s2 < 2; ++s2) {
                const int c0 = 512 * s2 + 8 * lane;
                const f32x4 sca = *(const f32x4*)(md1 + 1024 + c0) + 1.0f, scb = *(const f32x4*)(md1 + 1024 + c0 + 4) + 1.0f, sha = *(const f32x4*)(md1 + c0), shb = *(const f32x4*)(md1 + c0 + 4);
#pragma unroll
                for (int r = 0; r < 4; ++r) *(u32x4*)(U + (size_t)(row0 + r) * D + c0) = pack8(v[r][2 * s2] * rstd[r] * sca + sha, v[r][2 * s2 + 1] * rstd[r] * scb + shb);
            }
        }
    }
}

constexpr int NPH_LAYER = 13, NPHASES = 2 + 2 * NPH_LAYER;
__global__ void __launch_bounds__(512, 2) fwd_kernel(Args args) {
    extern __shared__ __attribute__((aligned(16))) unsigned char lds_raw[];
    Frame F0;
    F0.lds = (LAS unsigned char*)lds_raw;
    F0.tid = threadIdx.x; F0.lane = F0.tid & 63; F0.wave = __builtin_amdgcn_readfirstlane(F0.tid >> 6);
    F0.G = gridDim.x; { const int bx = blockIdx.x; F0.vcu = (F0.G % 8 == 0) ? (bx % 8) * (F0.G / 8) + bx / 8 : bx; }
    F0.ws = args.ws;
    volatile LAS unsigned* MISC = (volatile LAS unsigned*)(F0.lds + MISC_OFF);
    if (F0.tid < 64) MISC[F0.tid] = 0u;
    __syncthreads();
    unsigned* ctl = (unsigned*)(F0.ws + WS_CTL);
    XcdBarrier bar; bar.bar = ctl + CW_BAR; bar.x = 0; bar.st = nullptr;
    const int lo = args.ph_lo, hi = args.ph_hi;
    if (hi - lo > 1) bar = xcd_barrier_post(ctl + CW_BAR, MISC + 8);
#ifndef PH_MASK
#define PH_MASK 0xffff
#endif
#define PHON(j) (((PH_MASK) >> (j)) & 1)
#ifndef PH_REP
#define PH_REP 0
#endif
#define REPS(j) for (int rep_ = 0; rep_ <= (((PH_REP) >> (j)) & 1); ++rep_)
#define IN(k) (lo <= (k) && (k) < hi)
#define SEAM(k) do { if (IN(k) && IN((k) + 1)) xcd_barrier(bar); } while (0)
    if (PHON(13) && IN(0)) { const Frame F = phase_frame(F0); mod_items(F, args); small_tables(F, args); convert_weights(F, args, 0, 0, CVS_P0, F.bx, F.G); }
    SEAM(0);
    if (PHON(14) && IN(1)) { const Frame F = phase_frame(F0); ln_mod_rows(F, args); }
    SEAM(1);
    for (int l = 0; l < 2; ++l) {
        const int pb = 2 + NPH_LAYER * l;
        const int M = l == 0 ? MROWS : NLAT;
        REPS(0) if (PHON(0) && IN(pb + 0)) { const Frame F = phase_frame(F0); bf16_t* Wb = weights_of(F, args, l);
            DenseSched<1> S{(const char*)(F.ws + WS_U), (const char*)(Wb + W_IN / 2), MROWS / 256, N1 / 256, F.G, F.bx, 0, 0};
            EpiIn1 E{(bf16_t*)(F.ws + WS_Z), (const float*)(F.ws + WS_ROPE), (const float*)(F.ws + WS_LB) + l * 1024, (float*)(F.ws + WS_VECS), (bf16_t*)(F.ws + WS_AH)};
            pg8::gemm_phase(F.lds, F.tid, D, D, D, S, E);
            { const Frame F2 = phase_frame(F0);
              if (l == 0) convert_in_tail(F2, args, (MROWS / 256) * (N1 / 256), 0, CVS_P0, CVS_A); else convert_in_tail(F2, args, (MROWS / 256) * (N1 / 256), 1, CV_GU_END, CV_ITEMS); }
        }
        SEAM(pb + 0);
        REPS(2) if (PHON(2) && IN(pb + 1)) { const Frame F = phase_frame(F0); bf16_t* Wb = weights_of(F, args, l); hgrn_phase(F); }
        if (IN(pb + 1) && IN(pb + 2)) __syncthreads();
        REPS(1) if (PHON(1) && IN(pb + 2)) { const Frame F = phase_frame(F0); bf16_t* Wb = weights_of(F, args, l); attn_phase(F, args, l); }
        SEAM(pb + 2);
        REPS(3) if (PHON(3) && IN(pb + 3)) { const Frame F = phase_frame(F0); bf16_t* Wb = weights_of(F, args, l);
            DenseSched<1> S{(const char*)(F.ws + WS_U), (const char*)(Wb + W_IN / 2 + (size_t)N1 * D), M / 256, N2 / 256, F.G, F.bx, 0, 0};
            EpiIn2 E{(bf16_t*)(F.ws + WS_Z), F.ws + WS_ZG};
            pg8::gemm_phase(F.lds, F.tid, D, D, D, S, E);
            { const Frame F2 = phase_frame(F0);
              if (l == 0) convert_in_tail(F2, args, (M / 256) * (N2 / 256), 0, CVS_A, CVS_B); }
        }
        SEAM(pb + 3);
        REPS(4) if (PHON(4) && IN(pb + 4)) { const Frame F = phase_frame(F0); bf16_t* Wb = weights_of(F, args, l); readout_phase(F, args, l, M); }
        SEAM(pb + 4);
        REPS(5) if (PHON(5) && IN(pb + 5)) { const Frame F = phase_frame(F0); bf16_t* Wb = weights_of(F, args, l);
            DenseSched<1> S{(const char*)(F.ws + WS_AH), (const char*)(Wb + W_BR / 2), M / 256, D / 256, F.G, F.bx, 0, 0};
            EpiBranch E{F.ws + WS_ZG, (bf16_t*)(F.ws + WS_O)};
            pg8::gemm_phase(F.lds, F.tid, D, D, D, S, E);
            { const Frame F2 = phase_frame(F0);
              if (l == 0) convert_in_tail(F2, args, (M / 256) * (D / 256), 0, CVS_B, CV_ITEMS); }
        }
        SEAM(pb + 5);
        REPS(6) if (PHON(6) && IN(pb + 6)) { const Frame F = phase_frame(F0); bf16_t* Wb = weights_of(F, args, l);
            DenseSched<1> S{(const char*)(F.ws + WS_O), (const char*)(Wb + W_OUT / 2), M / 256, D / 256, F.G, F.bx, 0, 0};
            EpiPlain E{(bf16_t*)(F.ws + WS_AH)};
            pg8::gemm_phase(F.lds, F.tid, D, D, D, S, E);
            { const Frame F2 = phase_frame(F0);
              if (l == 0) convert_in_tail(F2, args, (M / 256) * (D / 256), 1, 0, CVS_C); }
        }
        SEAM(pb + 6);
        REPS(7) if (PHON(7) && IN(pb + 7)) { const Frame F = phase_frame(F0); bf16_t* Wb = weights_of(F, args, l); row_pass1(F, args, l, M); }
        SEAM(pb + 7);
        REPS(8) if (PHON(8) && IN(pb + 8)) { const Frame F = phase_frame(F0); bf16_t* Wb = weights_of(F, args, l); topk_phase(F, l); }
        SEAM(pb + 8);
        REPS(10) if (PHON(10) && IN(pb + 10)) { const Frame F = phase_frame(F0); bf16_t* Wb = weights_of(F, args, l);
            MoeSched1 S{(const char*)(F.ws + WS_U), (const char*)(Wb + W_GU / 2), (const int*)(F.ws + WS_SEL), 4096 + (l == 0 ? 128 : 0), F.G, F.bx};
            EpiSwiglu E{(bf16_t*)(F.ws + WS_HB)};
            pg8::gemm_phase<true>(F.lds, F.tid, D, D, D, S, E);
            { const Frame F2 = phase_frame(F0);
              if (l == 0) convert_in_tail(F2, args, 4096 + 128, 1, CVS_C, CVS_D); }
        }
        SEAM(pb + 10);
        REPS(11) if (PHON(11) && IN(pb + 11)) { const Frame F = phase_frame(F0); bf16_t* Wb = weights_of(F, args, l);
            MoeSched2 S{(const char*)(F.ws + WS_HB), (const char*)(Wb + W_DN / 2), 2048 + (l == 0 ? 64 : 0), F.G, F.bx};
            EpiPlain E{(bf16_t*)(F.ws + WS_Z)};
            pg8::gemm_phase(F.lds, F.tid, D, D, D, S, E);
            { const Frame F2 = phase_frame(F0);
              if (l == 0) convert_in_tail(F2, args, 2048 + 64, 1, CVS_D, CV_GU_END); }
        }
        SEAM(pb + 11);
        REPS(12) if (PHON(12) && IN(pb + 12)) { const Frame F = phase_frame(F0); bf16_t* Wb = weights_of(F, args, l); row_pass2(F, args, l, M); }
        if (l == 0) SEAM(pb + 12);
    }
#undef IN
#undef SEAM
}

extern "C" void kernel_launch(void* const* d_in, const int* in_sizes, int n_in, void* d_out, int out_size, void* d_ws, size_t ws_size, hipStream_t stream) {
    static int grid = 0;
    if (grid == 0) {
        if (n_in != 20 || out_size != NLAT * D || ws_size < WS_END) { fprintf(stderr, "kernel_launch: unexpected shapes (n_in %d out %d ws %zu)\n", n_in, out_size, ws_size); grid = -1; return; }
        int dev = 0, cus = 0, per_cu = 0;
        if (hipGetDevice(&dev) != hipSuccess || hipDeviceGetAttribute(&cus, hipDeviceAttributeMultiprocessorCount, dev) != hipSuccess) { grid = -1; return; }
        if (hipFuncSetAttribute((const void*)fwd_kernel, hipFuncAttributeMaxDynamicSharedMemorySize, LDS_BYTES) != hipSuccess) { fprintf(stderr, "kernel_launch: hipFuncSetAttribute failed\n"); grid = -1; return; }
        if (hipOccupancyMaxActiveBlocksPerMultiprocessor(&per_cu, (const void*)fwd_kernel, 512, LDS_BYTES) != hipSuccess || per_cu < 1) fprintf(stderr, "kernel_launch: occupancy query reports %d\n", per_cu);
        (void)hipGetLastError();
        grid = cus;
    }
    if (grid < 0) return;
    (void)hipMemsetAsync((char*)d_ws + WS_CTL, 0, CTL_ZERO_BYTES, stream);
    Args a{};
    a.x = (const float*)d_in[0]; a.c = (const float*)d_in[1]; a.ctx = (const float*)d_in[2]; a.c_ctx = (const float*)d_in[3]; a.w_mod = (const float*)d_in[4]; a.b_mod = (const float*)d_in[5];
    a.w_in = (const float*)d_in[6]; a.attn_sink = (const float*)d_in[7]; a.lb_fw = (const float*)d_in[8]; a.lb_bw = (const float*)d_in[9]; a.norm_g = (const float*)d_in[10];
    a.w_bra = (const float*)d_in[11]; a.w_brh = (const float*)d_in[12]; a.w_out = (const float*)d_in[13]; a.w_router = (const float*)d_in[14]; a.w_gate = (const float*)d_in[15];
    a.w_up = (const float*)d_in[16]; a.w_down = (const float*)d_in[17]; a.ln_g = (const float*)d_in[18]; a.ln_b = (const float*)d_in[19];
    a.out = (float*)d_out; a.ws = (unsigned char*)d_ws;
#if MK_MULTI
    for (int p = 0; p < NPHASES; ++p) { a.ph_lo = p; a.ph_hi = p + 1; hipLaunchKernelGGL(fwd_kernel, dim3(grid), dim3(512), LDS_BYTES, stream, a); }
#else
    a.ph_lo = 0; a.ph_hi = NPHASES;
    hipLaunchKernelGGL(fwd_kernel, dim3(grid), dim3(512), LDS_BYTES, stream, a);
#endif
}
```

```cpp
#include <hip/hip_runtime.h>
#include <cstdint>
#include <cstdio>

#ifndef MK_MULTI
#define MK_MULTI 0
#endif
#ifndef PG8_SP2
#define PG8_SP2 1
#endif

#define LAS __attribute__((address_space(3)))
typedef unsigned short bf16_t;
typedef short bf16x8 __attribute__((ext_vector_type(8)));
typedef short s16x4 __attribute__((ext_vector_type(4)));
typedef float f32x4 __attribute__((ext_vector_type(4)));
typedef float f32x16 __attribute__((ext_vector_type(16)));
typedef unsigned u32x4 __attribute__((ext_vector_type(4)));
typedef unsigned u32x2 __attribute__((ext_vector_type(2)));

constexpr int D = 1024, NB = 8, SEQ = 8192, CTXL = 256;
constexpr int NLAT = NB * SEQ, NCTX = NB * CTXL, MROWS = NLAT + NCTX;
constexpr int IN_DIM = 5376, N1 = 2816, N2 = 2560;
constexpr int NE = 16, CAP = 1024, CAPC = 32;
constexpr int XSROWS = NB * NE * CAP + NB * NE * CAPC;
constexpr float LN_EPS = 1e-6f;
constexpr float ALPHA = 1.41421356237309515f;

constexpr int ZC_Q = 0, ZC_K = 512, ZC_V = 640, ZC_QM = 768, ZC_KM = 1280, ZC_IH = 2816;
constexpr int NCHUNK = MROWS / 64;
constexpr size_t ZO_HG = (size_t)MROWS * 768 * 2, ZA_BYTES = (size_t)MROWS * 128 * 2, ZO_IH = ZO_HG + 16 * ZA_BYTES;
constexpr int ZQP = 768;

constexpr size_t MiB = 1u << 20;
constexpr size_t WS_CTL = 0, CTL_ZERO_BYTES = 32 * 1024;
constexpr size_t WS_MOD = 1 * MiB;
constexpr size_t WS_ROPE = WS_MOD + 512 * 1024;
constexpr size_t WS_LB = WS_ROPE + 16384;
constexpr size_t WS_XC = 2 * MiB;
constexpr size_t WS_AFF = 18 * MiB;
constexpr size_t WS_INV = 23 * MiB;
constexpr size_t WS_AFFT = 28 * MiB;
constexpr size_t WS_SEL = 32 * MiB + 256 * 1024;
constexpr size_t WS_VECS = 18 * MiB;
constexpr size_t WS_W = 33 * MiB + 512 * 1024;
constexpr size_t W_IN = 0, W_BR = W_IN + (size_t)(N1 + N2) * D * 2, W_OUT = W_BR + (size_t)D * D * 2, W_GU = W_OUT + (size_t)D * D * 2,
                 W_DN = W_GU + (size_t)NE * 2048 * D * 2, W_END = W_DN + (size_t)NE * D * D * 2;
constexpr size_t WS_U = 145 * MiB;
constexpr size_t WS_Z = 277 * MiB;
constexpr size_t WS_ZG = WS_Z + 68 * MiB;
constexpr size_t WS_AH = 706 * MiB;
constexpr size_t WS_O = 838 * MiB;
constexpr size_t WS_HB = 541 * MiB;
constexpr size_t WS_END = 970 * MiB;
constexpr size_t W1_OFF = 128 * MiB;
static_assert(WS_W + W_END <= WS_U && WS_SEL + (size_t)XSROWS * 4 <= WS_W && WS_VECS + (size_t)2 * NCHUNK * 3 * 512 * 4 <= WS_SEL, "weights fit");
static_assert(WS_U + (size_t)MROWS * D * 2 <= WS_Z, "U fits");
static_assert(WS_Z + ZO_IH + 4 * ZA_BYTES <= WS_AH && WS_Z + (size_t)MROWS * 512 * 2 <= WS_ZG && WS_ZG + (size_t)(MROWS / 256) * 8 * 2 * 65536 <= WS_AH, "Z1 / Z2 fit");
static_assert(WS_AH + (size_t)MROWS * D * 2 <= WS_O, "AH fits");
static_assert(WS_O + (size_t)MROWS * D * 2 <= WS_END, "O fits");
static_assert(WS_Z + (size_t)XSROWS * D * 2 <= WS_HB && WS_HB + (size_t)XSROWS * D * 2 <= WS_O, "XS/HB fit");

constexpr int CW_BAR = 4096;

constexpr int RING_BYTES = 131072;
constexpr int MISC_OFF = RING_BYTES;
constexpr int LDS_BYTES = 147456;

__device__ __forceinline__ unsigned f2bf(float f) { unsigned u = __float_as_uint(f); return (u + 0x7fffu + ((u >> 16) & 1u)) >> 16; }
typedef float f32x2_t __attribute__((ext_vector_type(2))); typedef __bf16 bf16x2_t __attribute__((ext_vector_type(2)));
__device__ __forceinline__ unsigned pk2(float lo, float hi) { const f32x2_t v = {lo, hi}; const bf16x2_t b = __builtin_convertvector(v, bf16x2_t); return __builtin_bit_cast(unsigned, b); }
__device__ __forceinline__ float bflo(unsigned w) { return __uint_as_float(w << 16); }
__device__ __forceinline__ float bfhi(unsigned w) { return __uint_as_float(w & 0xffff0000u); }
__device__ __forceinline__ float shx(float v, int m, int lane) { return __int_as_float(__builtin_amdgcn_ds_bpermute((lane ^ m) << 2, __float_as_int(v))); }
__device__ __forceinline__ float shup(float v, int d, int lane) { return __int_as_float(__builtin_amdgcn_ds_bpermute((lane - d) << 2, __float_as_int(v))); }
__device__ __forceinline__ unsigned shup_u(unsigned v, int d, int lane) { return (unsigned)__builtin_amdgcn_ds_bpermute((lane - d) << 2, (int)v); }
__device__ __forceinline__ float shidx(float v, int src) { return __int_as_float(__builtin_amdgcn_ds_bpermute(src << 2, __float_as_int(v))); }
__device__ __forceinline__ int shidx_i(int v, int src) { return __builtin_amdgcn_ds_bpermute(src << 2, v); }
__device__ __forceinline__ float wave_sum(float v, int lane) {
#pragma unroll
    for (int o = 1; o < 64; o <<= 1) v += shx(v, o, lane);
    return v;
}

template <int CTRL> __device__ __forceinline__ float dppf(float v) { return __int_as_float(__builtin_amdgcn_update_dpp(0, __float_as_int(v), CTRL, 0xF, 0xF, true)); }
__device__ __forceinline__ float row16_sum(float v) { v += dppf<0xB1>(v); v += dppf<0x4E>(v); v += dppf<0x141>(v); v += dppf<0x140>(v); return v; }
__device__ __forceinline__ float row16_max(float v) { v = fmaxf(v, dppf<0xB1>(v)); v = fmaxf(v, dppf<0x4E>(v)); v = fmaxf(v, dppf<0x141>(v)); v = fmaxf(v, dppf<0x140>(v)); return v; }
template <int CTRL, int RM> __device__ __forceinline__ float dppz(float v) { return __int_as_float(__builtin_amdgcn_update_dpp(0, __float_as_int(v), CTRL, RM, 0xF, false)); }
__device__ __forceinline__ float wave_scan(float v) {
    v += dppz<0x111, 0xF>(v); v += dppz<0x112, 0xF>(v); v += dppz<0x114, 0xF>(v); v += dppz<0x118, 0xF>(v); v += dppz<0x142, 0xA>(v); v += dppz<0x143, 0xC>(v); return v; }
__device__ __forceinline__ float rdlane(float v, int l) { return __int_as_float(__builtin_amdgcn_readlane(__float_as_int(v), l)); }
__device__ __forceinline__ float wsum(float v) { v = row16_sum(v); return (rdlane(v, 0) + rdlane(v, 16)) + (rdlane(v, 32) + rdlane(v, 48)); }
__device__ __forceinline__ void unpack8(const u32x4 w, f32x4& a, f32x4& b) { a = (f32x4){bflo(w.x), bfhi(w.x), bflo(w.y), bfhi(w.y)}; b = (f32x4){bflo(w.z), bfhi(w.z), bflo(w.w), bfhi(w.w)}; }
__device__ __forceinline__ u32x4 pack8(const f32x4 a, const f32x4 b) { u32x4 w; w.x = pk2(a[0], a[1]); w.y = pk2(a[2], a[3]); w.z = pk2(b[0], b[1]); w.w = pk2(b[2], b[3]); return w; }
__device__ __forceinline__ float hsum4(const f32x4 v) { return (v[0] + v[1]) + (v[2] + v[3]); }
__device__ __forceinline__ float hsq4(const f32x4 v) { return (v[0] * v[0] + v[1] * v[1]) + (v[2] * v[2] + v[3] * v[3]); }
__device__ __forceinline__ float sigmoidf_(float z) { return __builtin_amdgcn_rcpf(1.0f + __expf(-z)); }
__device__ __forceinline__ float siluf_(float z) { return z * __builtin_amdgcn_rcpf(1.0f + __expf(-z)); }
__device__ __forceinline__ u32x2 pack4(const f32x4 v) { u32x2 w; w.x = pk2(v[0], v[1]); w.y = pk2(v[2], v[3]); return w; }
__device__ __forceinline__ f32x4 unpack4(const u32x2 w) { return (f32x4){bflo(w.x), bfhi(w.x), bflo(w.y), bfhi(w.y)}; }

#define XB_TMO      128
#define XB_XCNT(j)  (256  + 64 * (j))
#define XB_XSUB(j)  (1280 + 64 * (j))
#define XB_XGEN(j)  (2304 + 64 * (j))
#define XB_TOP      3328
#define XB_TOPGEN   3392
#define XCD_BAR_WORDS 3456
#define XB_SPIN_CAP (1u << 18)
__device__ __forceinline__ unsigned xb_ld(unsigned* p)              { return __hip_atomic_load(p, __ATOMIC_RELAXED, __HIP_MEMORY_SCOPE_AGENT); }
__device__ __forceinline__ unsigned xb_add(unsigned* p, unsigned v) { return __hip_atomic_fetch_add(p, v, __ATOMIC_RELAXED, __HIP_MEMORY_SCOPE_AGENT); }
__device__ __forceinline__ unsigned xb_xcc_id() { return (unsigned)__builtin_amdgcn_s_getreg((3 << 11) | 20) & 0xFu; }
#define XB_SPIN(cond, bar) do { unsigned _sp = 0; while (cond) { __builtin_amdgcn_s_sleep(1); \
    if ((++_sp & 255u) == 0u) { if (xb_ld(&(bar)[XB_TMO])) break; if (_sp > XB_SPIN_CAP) { atomicAdd(&(bar)[XB_TMO], 1u); break; } } } } while (0)
struct XcdBarrier { unsigned* bar; unsigned x; volatile LAS unsigned* st; };
__device__ __forceinline__ XcdBarrier xcd_barrier_post(unsigned* bar, volatile LAS unsigned* st) {
    XcdBarrier b; b.bar = bar; b.x = xb_xcc_id(); b.st = st;
    if (threadIdx.x == 0) (void)xb_add(&bar[XB_XCNT(b.x)], 1u);
    return b;
}
__device__ __forceinline__ void xcd_barrier_complete(unsigned* bar, unsigned x, unsigned& nloc, unsigned& nx) {
    const unsigned G = gridDim.x * gridDim.y * gridDim.z;
    unsigned sum, cnt, mine, sp = 0u;
    for (;;) {
        sum = 0u; cnt = 0u; mine = 0u;
#pragma unroll
        for (unsigned j = 0; j < 16; ++j) { const unsigned c = xb_ld(&bar[XB_XCNT(j)]); sum += c; cnt += (c > 0u) ? 1u : 0u; mine = (j == x) ? c : mine; }
        if (sum == G) break;
        __builtin_amdgcn_s_sleep(1);
        if ((++sp & 255u) == 0u) { if (xb_ld(&bar[XB_TMO])) break; if (sp > XB_SPIN_CAP) { atomicAdd(&bar[XB_TMO], 1u); break; } }
    }
    nloc = mine > 0u ? mine : 1u; nx = cnt > 0u ? cnt : 1u;
}
__device__ __forceinline__ void xcd_barrier(const XcdBarrier& b) {
    asm volatile("s_waitcnt vmcnt(0)" ::: "memory");
    __syncthreads();
    if (threadIdx.x == 0) {
        unsigned* bar = b.bar;
        __builtin_amdgcn_s_waitcnt(0);
        unsigned nloc = b.st[0], nx = b.st[1];
        if (nloc == 0u) { xcd_barrier_complete(bar, b.x, nloc, nx); b.st[0] = nloc; b.st[1] = nx; }
        const unsigned old = xb_add(&bar[XB_XSUB(b.x)], 1u);
        const unsigned gen = old / nloc;
        if (old + 1u == (gen + 1u) * nloc) {
            __builtin_amdgcn_fence(__ATOMIC_RELEASE, "agent");
            asm volatile("s_waitcnt vmcnt(0)" ::: "memory");
            const unsigned og = xb_add(&bar[XB_TOP], 1u);
            const unsigned tg = og / nx;
            if (og + 1u == (tg + 1u) * nx) xb_add(&bar[XB_TOPGEN], 1u);
            else XB_SPIN(xb_ld(&bar[XB_TOPGEN]) == tg, bar);
            xb_add(&bar[XB_XGEN(b.x)], 1u);
            __builtin_amdgcn_fence(__ATOMIC_ACQUIRE, "agent");
            asm volatile("s_waitcnt vmcnt(0)" ::: "memory");
        } else {
            XB_SPIN(xb_ld(&bar[XB_XGEN(b.x)]) == gen, bar);
            __builtin_amdgcn_fence(__ATOMIC_ACQUIRE, "agent");
            asm volatile("s_waitcnt vmcnt(0)" ::: "memory");
        }
    }
    __syncthreads();
}

namespace pg8 {
constexpr int BM = 256, BK = 64, HALF = 128, HTB = HALF * BK * 2, STAGE_BYTES = 8 * HTB, NXCD = 8, WGM = 8;
constexpr int SELBUF = STAGE_BYTES + 1024;
__host__ __device__ __forceinline__ int lds_byte(int r, int c) { const int st = (r >> 4) * 2 + (c >> 5), rr = r & 15, cc = c & 31, ob = rr * 64 + cc * 2; return st * 1024 + (ob ^ (((ob >> 9) & 1) << 5)); }
__host__ __device__ __forceinline__ int perm32(int rho) { const int n = rho >> 4, i = rho & 15; return 8 * (i >> 2) + 4 * n + (i & 3); }
__host__ __device__ __forceinline__ void stage_rc(int b, int& R, int& C) { const int st = b / 1024, sb = b % 1024, swz = sb ^ (((sb >> 9) & 1) << 5); R = (st >> 1) * 16 + swz / 64; C = (st & 1) * 32 + (swz % 64) / 2; }
struct Unit { int pm, pn, aux; };
__device__ __forceinline__ void tile_of(int wgid0, int nM, int nN, int& pm, int& pn) {
    const int nwg = nM * nN; int wgid = wgid0;
    { const int q = nwg / NXCD, r = nwg % NXCD, xcd = wgid % NXCD, off = wgid / NXCD; wgid = (xcd < r ? xcd * (q + 1) : r * (q + 1) + (xcd - r) * q) + off; }
    const int nig = WGM * nN, gid = wgid / nig, fm = gid * WGM, gsz = (nM - fm) < WGM ? (nM - fm) : WGM;
    pm = fm + ((wgid % nig) % gsz); pn = (wgid % nig) / gsz;
}
template <bool GATHER = false, class Epi, class Sched>
__device__ __forceinline__ void gemm_phase(LAS unsigned char* lds, const int tid, const int K, const int lda, const int ldb, const Sched& S, const Epi& E) {
    const int wid = __builtin_amdgcn_readfirstlane(tid >> 6), lane = tid & 63, wr = wid >> 2, wc = wid & 3, fr = lane & 15, fq = lane >> 4;
    const int nt = K / BK;
    unsigned voffA[2]; int Rr[2], Cc[2];
    unsigned sbv[2];
#pragma unroll
    for (int i = 0; i < 2; ++i) { int R, C; stage_rc(tid * 16 + i * 8192, R, C); Rr[i] = R; Cc[i] = C; voffA[i] = (unsigned)(R * lda + C) * 2u; sbv[i] = 0u; }
    auto bvoff = [&](bool perm, int i) -> unsigned { int ln_; asm volatile("v_mbcnt_lo_u32_b32 %0, -1, 0\n\tv_mbcnt_hi_u32_b32 %0, -1, %0" : "=v"(ln_)); int R, C; stage_rc((wid * 64 + ln_) * 16 + i * 8192, R, C);
        const int Rp = perm ? ((R & ~31) + perm32(R & 31)) : R; return (unsigned)(Rp * ldb + C) * 2u; };
    unsigned goff[2][2], ngoff[2][2], so[2][2];
#pragma unroll
    for (int h = 0; h < 2; ++h)
#pragma unroll
        for (int i = 0; i < 2; ++i) { goff[h][i] = 0u; ngoff[h][i] = 0u; so[h][i] = 0u; }
    const size_t kstep = (size_t)(BK * 2);
    const size_t hstepA = (size_t)HALF * lda * 2, hstepB = (size_t)HALF * ldb * 2;
    const unsigned ldsw = (unsigned)wid * 1024u;
    const int aoff = lds_byte(wr * 64 + fr, fq * 8), boff = lds_byte(wc * 32 + fr, fq * 8);
#define PG8_SA(b, h) (((b) * 2 + (h)) * HTB)
#define PG8_SB(b, h) ((4 + (b) * 2 + (h)) * HTB)
#define PG8_STAGE(bufoff, gbase, voff) do { _Pragma("unroll") for (int _i = 0; _i < 2; ++_i) \
        __builtin_amdgcn_global_load_lds((const unsigned*)((const char*)(gbase) + (voff)[_i]), (LAS unsigned*)(lds + (bufoff) + ldsw + _i * 8192), 16, 0, 0); } while (0)
#define PG8_STAGE_A(bufoff, gbase, h, VO) do { if constexpr (GATHER) { PG8_STAGE(bufoff, gbase, VO[h]); } else { PG8_STAGE(bufoff, (gbase) + (h) * hstepA, voffA); } } while (0)
#define PG8_LDA(dst, b, h) do { _Pragma("unroll") for (int m = 0; m < 4; ++m) _Pragma("unroll") for (int k = 0; k < 2; ++k) dst[m][k] = *(const LAS bf16x8*)(lds + PG8_SA(b, h) + aoff + m * 2048 + k * 1024); } while (0)
#define PG8_LDB(dst, b, h) do { _Pragma("unroll") for (int n = 0; n < 2; ++n) _Pragma("unroll") for (int k = 0; k < 2; ++k) dst[n][k] = *(const LAS bf16x8*)(lds + PG8_SB(b, h) + boff + n * 2048 + k * 1024); } while (0)
#define PG8_MMA(ai, bj, At, Bt) do { __builtin_amdgcn_s_setprio(1); _Pragma("unroll") for (int m = 0; m < 4; ++m) _Pragma("unroll") for (int n = 0; n < 2; ++n) _Pragma("unroll") for (int k = 0; k < 2; ++k) \
        acc[ai][bj][m][n] = __builtin_amdgcn_mfma_f32_16x16x32_bf16(Bt[n][k], At[m][k], acc[ai][bj][m][n], 0, 0, 0); __builtin_amdgcn_s_setprio(0); } while (0)
#define PG8_WAIT_V(n) asm volatile("s_waitcnt vmcnt(" #n ")" ::: "memory")
#define PG8_WAIT_VN(N) asm volatile("s_waitcnt vmcnt(%0)" :: "n"(N) : "memory")
#define PG8_WAIT_L(n) asm volatile("s_waitcnt lgkmcnt(" #n ")" ::: "memory")
#define PG8_BAR __builtin_amdgcn_s_barrier()
#define PG8_SCHED __builtin_amdgcn_sched_barrier(0)
    Unit cur, nxt; int ui = 0;
    if (!S.next(0, cur)) return;
    f32x4 acc[2][2][4][2];
#pragma unroll
    for (int a = 0; a < 2; ++a)
#pragma unroll
        for (int b = 0; b < 2; ++b)
#pragma unroll
            for (int m = 0; m < 4; ++m)
#pragma unroll
                for (int n = 0; n < 2; ++n) acc[a][b][m][n] = (f32x4){0.f, 0.f, 0.f, 0.f};
    bf16x8 At[4][2], B0[2][2], B1[2][2];
    const char* cA = S.aptr(cur); const char* cB = S.bptr(cur);
    bool pcur = E.perm(cur);
    unsigned vbc[2];
#pragma unroll
    for (int i = 0; i < 2; ++i) vbc[i] = bvoff(pcur, i);
    if constexpr (GATHER) {
#pragma unroll
        for (int h = 0; h < 2; ++h)
#pragma unroll
            for (int i = 0; i < 2; ++i) goff[h][i] = S.arow(cur, h * HALF + Rr[i]) + (unsigned)Cc[i] * 2u;
    }
#if PG8_SP2
    PG8_STAGE(PG8_SB(0, 0), cB, vbc); PG8_STAGE(PG8_SB(0, 1), cB + hstepB, vbc); PG8_STAGE_A(PG8_SA(0, 0), cA, 0, goff); PG8_STAGE_A(PG8_SA(0, 1), cA, 1, goff);
    if (wr == 1) PG8_BAR;
    PG8_WAIT_V(2); PG8_BAR;
    PG8_STAGE(PG8_SB(1, 0), cB + kstep, vbc); PG8_STAGE_A(PG8_SA(1, 0), cA + kstep, 0, goff); PG8_STAGE(PG8_SB(1, 1), cB + hstepB + kstep, vbc);
    PG8_WAIT_V(6); PG8_BAR;
#else
    PG8_STAGE(PG8_SB(0, 0), cB, vbc); PG8_STAGE_A(PG8_SA(0, 0), cA, 0, goff); PG8_STAGE(PG8_SB(0, 1), cB + hstepB, vbc); PG8_STAGE_A(PG8_SA(0, 1), cA, 1, goff);
    if (wr == 1) PG8_BAR;
    PG8_WAIT_V(4); PG8_BAR;
    PG8_STAGE(PG8_SB(1, 0), cB + kstep, vbc); PG8_STAGE_A(PG8_SA(1, 0), cA + kstep, 0, goff); PG8_STAGE(PG8_SB(1, 1), cB + hstepB + kstep, vbc);
    PG8_WAIT_V(6); PG8_BAR;
#endif
    for (;;) {
        const bool has_next = S.next(ui + 1, nxt);
        const char* nA = has_next ? S.aptr(nxt) : cA; const char* nB = has_next ? S.bptr(nxt) : cB;
        if constexpr (GATHER) {
            if (has_next && wid == 0) { int ln_; asm volatile("v_mbcnt_lo_u32_b32 %0, -1, 0\n\tv_mbcnt_hi_u32_b32 %0, -1, %0" : "=v"(ln_));
                __builtin_amdgcn_global_load_lds((const unsigned*)(S.selrow(nxt) + ln_ * 4), (LAS unsigned*)(lds + SELBUF + ((ui + 1) & 1) * 1024), 16, 0, 0); }
        }
        const bool pnext = has_next ? E.perm(nxt) : pcur;
        for (int t = 0; t < nt; t += 2) {
            const bool last = (t == nt - 2);
#pragma unroll
            for (int i = 0; i < 2; ++i) sbv[i] = vbc[i];
            if (last && pnext != pcur) {
#pragma unroll
                for (int i = 0; i < 2; ++i) sbv[i] = bvoff(pnext, i); }
            if constexpr (GATHER) {
#pragma unroll
                for (int h = 0; h < 2; ++h)
#pragma unroll
                    for (int i = 0; i < 2; ++i) so[h][i] = goff[h][i];
                if (last) {
                    const LAS int* sb = (const LAS int*)(lds + SELBUF + ((ui + 1) & 1) * 1024);
                    int ln_; asm volatile("v_mbcnt_lo_u32_b32 %0, -1, 0\n\tv_mbcnt_hi_u32_b32 %0, -1, %0" : "=v"(ln_));
#pragma unroll
                    for (int i = 0; i < 2; ++i) { int R_, C_; stage_rc((wid * 64 + ln_) * 16 + i * 8192, R_, C_);
#pragma unroll
                        for (int h = 0; h < 2; ++h) { ngoff[h][i] = has_next ? (unsigned)sb[h * HALF + R_] * (unsigned)(2048) + (unsigned)C_ * 2u : goff[h][i]; so[h][i] = ngoff[h][i]; } }
                }
            }
            const char* a1 = cA + (size_t)(t + 1) * kstep;
            const char* a2 = last ? nA : cA + (size_t)(t + 2) * kstep; const char* b2 = last ? nB : cB + (size_t)(t + 2) * kstep;
            const char* a3 = a2 + kstep; const char* b3 = b2 + kstep;
            if constexpr (Epi::HAS_MID) { if (t == nt / 2) E.mid(acc, cur, wr, wc); }
#if PG8_SP2
            const bool rlx = (t == 0) && (ui > 0);
#define PG8_WAIT_R() do { if (rlx) PG8_WAIT_VN(8 + Epi::MIN_VM); else PG8_WAIT_VN(8); } while (0)
            PG8_LDB(B0, 0, 0); PG8_LDB(B1, 0, 1); PG8_SCHED; PG8_LDA(At, 0, 0); if (!rlx) { PG8_STAGE_A(PG8_SA(1, 1), a1, 1, goff); }
            PG8_WAIT_R(); PG8_WAIT_L(0); PG8_BAR; PG8_MMA(0, 0, At, B0); PG8_MMA(0, 1, At, B1); PG8_BAR; PG8_SCHED;
            PG8_LDA(At, 0, 1); PG8_STAGE(PG8_SB(0, 0), b2, sbv); PG8_STAGE(PG8_SB(0, 1), b2 + hstepB, sbv); PG8_STAGE_A(PG8_SA(0, 0), a2, 0, so);
            PG8_WAIT_R(); PG8_WAIT_L(0); PG8_BAR; PG8_MMA(1, 0, At, B0); PG8_MMA(1, 1, At, B1); PG8_BAR; PG8_SCHED;
            PG8_LDB(B0, 1, 0); PG8_LDB(B1, 1, 1); PG8_SCHED; PG8_LDA(At, 1, 0); PG8_STAGE_A(PG8_SA(0, 1), a2, 1, so);
            PG8_WAIT_R(); PG8_WAIT_L(0); PG8_BAR; PG8_MMA(0, 0, At, B0); PG8_MMA(0, 1, At, B1); PG8_BAR; PG8_SCHED;
            PG8_LDA(At, 1, 1); PG8_STAGE(PG8_SB(1, 0), b3, sbv); PG8_STAGE(PG8_SB(1, 1), b3 + hstepB, sbv); PG8_STAGE_A(PG8_SA(1, 0), a3, 0, so);
            if (rlx) asm volatile("s_waitcnt vmcnt(8) ; exact in the first trip too" ::: "memory"); else PG8_WAIT_VN(8);
            PG8_WAIT_L(0); PG8_BAR; PG8_MMA(1, 0, At, B0); PG8_MMA(1, 1, At, B1); PG8_BAR; PG8_SCHED;
#undef PG8_WAIT_R
#else
            PG8_LDB(B0, 0, 0); PG8_SCHED; PG8_LDA(At, 0, 0); PG8_STAGE_A(PG8_SA(1, 1), a1, 1, goff);
            PG8_WAIT_L(8); PG8_BAR; PG8_WAIT_L(0); PG8_MMA(0, 0, At, B0); PG8_BAR; PG8_SCHED;
            PG8_LDB(B1, 0, 1); PG8_STAGE(PG8_SB(0, 0), b2, sbv);
            PG8_BAR; PG8_WAIT_L(0); PG8_MMA(0, 1, At, B1); PG8_BAR;
            PG8_LDA(At, 0, 1); PG8_STAGE_A(PG8_SA(0, 0), a2, 0, so);
            PG8_BAR; PG8_WAIT_L(0); PG8_MMA(1, 0, At, B0); PG8_BAR; PG8_SCHED;
            PG8_STAGE(PG8_SB(0, 1), b2 + hstepB, sbv);
            PG8_WAIT_V(6); PG8_BAR; PG8_MMA(1, 1, At, B1); PG8_BAR;
            PG8_LDB(B0, 1, 0); PG8_SCHED; PG8_LDA(At, 1, 0); PG8_STAGE_A(PG8_SA(0, 1), a2, 1, so);
            PG8_WAIT_L(8); PG8_BAR; PG8_WAIT_L(0); PG8_MMA(0, 0, At, B0); PG8_BAR; PG8_SCHED;
            PG8_LDB(B1, 1, 1); PG8_STAGE(PG8_SB(1, 0), b3, sbv);
            PG8_BAR; PG8_WAIT_L(0); PG8_MMA(0, 1, At, B1); PG8_BAR;
            PG8_LDA(At, 1, 1); PG8_STAGE_A(PG8_SA(1, 0), a3, 0, so);
            PG8_BAR; PG8_WAIT_L(0); PG8_MMA(1, 0, At, B0); PG8_BAR; PG8_SCHED;
            PG8_STAGE(PG8_SB(1, 1), b3 + hstepB, sbv);
            PG8_WAIT_V(6); PG8_BAR; PG8_MMA(1, 1, At, B1); PG8_BAR;
#endif
        }
#if PG8_SP2
        if (has_next) { PG8_STAGE_A(PG8_SA(1, 1), nA + kstep, 1, ngoff); }
        asm volatile("" ::: "memory"); PG8_SCHED;
#endif
        if (wr == 0) PG8_BAR;
        const bool keep = E(acc, cur, wr, wc, fr, fq);
        if (!has_next) break;
        if (!keep) {
#pragma unroll
            for (int a = 0; a < 2; ++a)
#pragma unroll
                for (int b = 0; b < 2; ++b)
#pragma unroll
                    for (int m = 0; m < 4; ++m)
#pragma unroll
                        for (int n = 0; n < 2; ++n) acc[a][b][m][n] = (f32x4){0.f, 0.f, 0.f, 0.f};
        }
        cur = nxt; cA = nA; cB = nB; ++ui; pcur = pnext;
        if (wr == 1) PG8_BAR;
#pragma unroll
        for (int i = 0; i < 2; ++i) vbc[i] = sbv[i];
        if constexpr (GATHER) {
#pragma unroll
            for (int h = 0; h < 2; ++h)
#pragma unroll
                for (int i = 0; i < 2; ++i) goff[h][i] = ngoff[h][i];
        }
    }
    PG8_WAIT_V(0);
    PG8_BAR;
#undef PG8_SA
#undef PG8_SB
#undef PG8_STAGE
#undef PG8_STAGE_A
#undef PG8_LDA
#undef PG8_LDB
#undef PG8_MMA
#undef PG8_WAIT_V
#undef PG8_WAIT_L
#undef PG8_BAR
#undef PG8_SCHED
}
}
using pg8::Unit;

struct Args {
    const float *x, *c, *ctx, *c_ctx, *w_mod, *b_mod, *w_in, *attn_sink, *lb_fw, *lb_bw, *norm_g, *w_bra, *w_brh, *w_out, *w_router, *w_gate, *w_up, *w_down, *ln_g, *ln_b;
    float* out; unsigned char* ws; int ph_lo, ph_hi;
};
struct Frame {
    LAS unsigned char* lds;
    int tid, lane, wave, G, vcu, bx;
    unsigned char* ws;
};
__device__ __forceinline__ Frame phase_frame(const Frame& F0) {
    Frame F = F0; int ln; asm volatile("v_mbcnt_lo_u32_b32 %0, -1, 0\n\tv_mbcnt_hi_u32_b32 %0, -1, %0" : "=v"(ln));
    int wv = F0.wave, gg = F0.G, bb = (int)blockIdx.x; asm volatile("" : "+s"(wv), "+s"(gg), "+s"(bb)); F.wave = wv; F.G = gg; F.bx = bb; F.lane = ln; F.tid = wv * 64 + ln;
    unsigned long long w = (unsigned long long)F0.ws; asm volatile("" : "+s"(w)); F.ws = (unsigned char*)(__attribute__((address_space(1))) unsigned char*)w; return F;
}
__device__ __forceinline__ int mod_group(int row) { return row < NLAT ? (row >> 13) : NB; }

template <int NS>
struct DenseSched {
    const char* A; const char* B; int nM, nN, G, c; size_t a_sub, b_sub;
    __device__ __forceinline__ bool next(int i, Unit& u) const {
        const int ti = (i / NS) * G + c; if (ti >= nM * nN) return false;
        pg8::tile_of(ti, nM, nN, u.pm, u.pn); u.aux = i % NS; return true;
    }
    __device__ __forceinline__ const char* aptr(const Unit& u) const { return A + (size_t)u.pm * 256 * D * 2 + (size_t)u.aux * a_sub; }
    __device__ __forceinline__ const char* bptr(const Unit& u) const { return B + (size_t)u.pn * 256 * D * 2 + (size_t)u.aux * b_sub; }
};

template <int CTRL> __device__ __forceinline__ f32x4 dpp4(const f32x4 v) { return (f32x4){dppf<CTRL>(v[0]), dppf<CTRL>(v[1]), dppf<CTRL>(v[2]), dppf<CTRL>(v[3])}; }
__device__ __forceinline__ f32x4 row16_scan4(f32x4 v) { v += dpp4<0x111>(v); v += dpp4<0x112>(v); v += dpp4<0x114>(v); v += dpp4<0x118>(v); return v; }
__device__ __forceinline__ f32x4 row16_sum4(f32x4 v) { return (f32x4){row16_sum(v[0]), row16_sum(v[1]), row16_sum(v[2]), row16_sum(v[3])}; }
struct EpiIn1 {
    static constexpr bool HAS_MID = false; static constexpr int MIN_VM = 16;
    bf16_t* Z; const float* rope; const float* lb; float* vecs; bf16_t* QS;
    __device__ __forceinline__ bool perm(const Unit& u) const { return u.pn >= 3; }
    template <bool FWD>
    __device__ __forceinline__ void decay_half(f32x4 (&zz)[4][2], const f32x4 (&qraw)[4][2]  , const int dir, const int kc, const Unit& u, int ai, int wr, int wc, int fr, int fq) const {
        u32x2 omf[4][2];
        f32x4 r0[2], s01[2], r2[2], tot[2];
        {
            const f32x4 lbv[2] = {*(const f32x4*)(lb + dir * 512 + kc), *(const f32x4*)(lb + dir * 512 + kc + 4)};
#pragma unroll
            for (int m = 0; m < 4; ++m)
#pragma unroll
                for (int n = 0; n < 2; ++n) {
                    f32x4 z = zz[m][n], o;
#pragma unroll
                    for (int i = 0; i < 4; ++i) {
                        const float e = __builtin_amdgcn_exp2f(z[i] * -1.44269504089f), r = __builtin_amdgcn_rcpf(1.0f + e);
                        const float oml = 1.0f - lbv[n][i];
                        z[i] = __builtin_amdgcn_logf(lbv[n][i] + oml * r);
                        o[i] = oml - oml * r;
                    }
                    omf[m][n] = pack4(o);
                    z = row16_scan4(z); zz[m][n] = z;
                    const f32x4 rs = dpp4<0x15F>(z);
                    if (m == 0) r0[n] = rs; else if (m == 1) s01[n] = r0[n] + rs; else if (m == 2) r2[n] = rs; else tot[n] = (s01[n] + r2[n]) + rs;
                }
        }
        int frl = fr, kcl = kc; asm volatile("" : "+v"(frl), "+v"(kcl));
        const int head = kc >> 7;
        const size_t rowoff = (size_t)(u.pm * 256 + ai * 128 + wr * 64 + frl);
        bf16_t* zp = (bf16_t*)((unsigned char*)Z + ZO_HG + (size_t)((dir * 4 + head) * 2) * ZA_BYTES) + rowoff * 128 + (kcl & 127);
#pragma unroll
        for (int m = 0; m < 4; ++m) {
            u32x2 a0p[2], kmp[2], qsp[2];
#pragma unroll
            for (int n = 0; n < 2; ++n) {
                const f32x4 cfl = zz[m][n];
                const f32x4 cf = m == 0 ? cfl : cfl + (m == 1 ? r0[n] : m == 2 ? s01[n] : s01[n] + r2[n]);
                const f32x4 d = dir ? (s01[n] - cf) + (cfl - dpp4<0x111>(cfl)) : cf - s01[n];
                const f32x4 om = unpack4(omf[m][n]);
                f32x4 a0, km, qs;
#pragma unroll
                for (int i = 0; i < 4; ++i) {
                    const float x = fminf(fmaxf(d[i], -115.415603f), 115.415603f);
                    const float E1 = __builtin_amdgcn_exp2f(x);
                    if constexpr (FWD) { qs[i] = siluf_(qraw[m][n][i]); a0[i] = qs[i] * E1; } else { a0[i] = E1; }
                    km[i] = om[i] * __builtin_amdgcn_exp2f(-x);
                }
                a0p[n] = pack4(a0); kmp[n] = pack4(km); if constexpr (FWD) qsp[n] = pack4(qs);
                __builtin_amdgcn_sched_barrier(0);
            }
            *(u32x4*)(zp + (size_t)(16 * m) * 128) = (u32x4){a0p[0].x, a0p[0].y, a0p[1].x, a0p[1].y}; *(u32x4*)(zp + ZA_BYTES / 2 + (size_t)(16 * m) * 128) = (u32x4){kmp[0].x, kmp[0].y, kmp[1].x, kmp[1].y};
            if constexpr (FWD) *(u32x4*)(QS + (rowoff + 16 * m) * D + 512 + kcl) = (u32x4){qsp[0].x, qsp[0].y, qsp[1].x, qsp[1].y};
        }
        if (frl == 0) {
            float* vp = vecs + ((size_t)(dir * NCHUNK + (u.pm * 4 + ai * 2 + wr)) * 3) * 512 + kcl;
#pragma unroll
            for (int n = 0; n < 2; ++n) {
                f32x4 te, dc, ee;
#pragma unroll
                for (int i = 0; i < 4; ++i) { const float e2 = dir ? tot[n][i] - s01[n][i] : s01[n][i]; te[i] = __builtin_amdgcn_exp2f(tot[n][i] - e2); dc[i] = __builtin_amdgcn_exp2f(tot[n][i]); ee[i] = __builtin_amdgcn_exp2f(e2); }
                *(f32x4*)(vp + 4 * n) = te; *(f32x4*)(vp + 512 + 4 * n) = dc; *(f32x4*)(vp + 1024 + 4 * n) = ee;
            }
        }
    }
    __device__ __forceinline__ bool operator()(f32x4 (&acc)[2][2][4][2], const Unit& u, int wr, int wc, int fr, int fq) const {
        { int ln_; asm volatile("v_mbcnt_lo_u32_b32 %0, -1, 0\n\tv_mbcnt_hi_u32_b32 %0, -1, %0" : "=v"(ln_)); fr = ln_ & 15; fq = ln_ >> 4; }
        const bool latent = u.pm < 256;
        if (u.pn >= 3 && u.pn < 7) {
            const int hj = u.pn - 3, kc = 128 * hj + 32 * wc + 8 * fq;
#pragma unroll
            for (int ai = 0; ai < 2; ++ai) decay_half<true>(acc[ai][1], acc[ai][0], 0, kc, u, ai, wr, wc, fr, fq);
            return false;
        }
        if (u.pn >= 7 && u.pn < 9) {
#pragma unroll
            for (int ai = 0; ai < 2; ++ai)
#pragma unroll
                for (int bj = 0; bj < 2; ++bj) decay_half<false>(acc[ai][bj], acc[ai][bj], 1, 256 * (u.pn - 7) + 128 * bj + 32 * wc + 8 * fq, u, ai, wr, wc, fr, fq);
            return false;
        }
        if (u.pn >= 9) {
#pragma unroll
            for (int bj = 0; bj < 2; ++bj) {
                bf16_t* zp = (bf16_t*)((unsigned char*)Z + ZO_IH + (size_t)(2 * (u.pn - 9) + bj) * ZA_BYTES) + (size_t)(u.pm * 256 + wr * 64 + fr) * 128 + 32 * wc + 8 * fq;
#pragma unroll
                for (int ai = 0; ai < 2; ++ai)
#pragma unroll
                    for (int m = 0; m < 4; ++m) *(u32x4*)(zp + (size_t)(ai * 128 + m * 16) * 128) = pack8(acc[ai][bj][m][0], acc[ai][bj][m][1]);
            }
            return false;
        }
        f32x4 rcs[2][4], rsn[2][4];
        if (latent && u.pn < 3) {
#pragma unroll
            for (int ai = 0; ai < 2; ++ai)
#pragma unroll
                for (int m = 0; m < 4; ++m) {
                    const int t = (u.pm * 256 + ai * 128 + wr * 64 + m * 16 + fr) & (SEQ - 1); const int pos = (wc & 1) ? (t & 63) : (t >> 6);
                    rcs[ai][m] = *(const f32x4*)(rope + pos * 16 + 4 * fq); rsn[ai][m] = *(const f32x4*)(rope + 2048 + pos * 16 + 4 * fq);
                }
            __builtin_amdgcn_sched_barrier(0);
        }
#pragma unroll
        for (int bj = 0; bj < 2; ++bj) {
            const int hidx = 2 * u.pn + bj;
            const int col0 = 128 * hidx + 32 * wc + 4 * fq;
            bf16_t* zp = Z + (size_t)(u.pm * 256 + wr * 64 + fr) * ZQP + col0;
            if (hidx < 5) {
                const float qs = hidx < 4 ? 0.125f * 1.44269504089f : 1.0f;
#pragma unroll
                for (int ai = 0; ai < 2; ++ai)
#pragma unroll
                    for (int m = 0; m < 4; ++m) {
                        f32x4 v0 = acc[ai][bj][m][0], v1 = acc[ai][bj][m][1];
                        if (latent) {
                            const f32x4 cs = rcs[ai][m], sn = rsn[ai][m];
                            const f32x4 o0 = v0 * cs - v1 * sn, o1 = v1 * cs + v0 * sn; v0 = o0; v1 = o1;
                        }
                        bf16_t* p = zp + (size_t)(ai * 128 + m * 16) * ZQP;
                        *(u32x2*)p = pack4(v0 * qs); *(u32x2*)(p + 16) = pack4(v1 * qs);
                    }
            } else {
#pragma unroll
                for (int ai = 0; ai < 2; ++ai)
#pragma unroll
                    for (int m = 0; m < 4; ++m) {
                        bf16_t* p = zp + (size_t)(ai * 128 + m * 16) * ZQP;
                        *(u32x2*)p = pack4(acc[ai][bj][m][0]); *(u32x2*)(p + 16) = pack4(acc[ai][bj][m][1]);
                    }
            }
        }
        return false;
    }
};
struct EpiIn2 {
    bf16_t* GH; unsigned char* ZG;
    static constexpr bool HAS_MID = false; static constexpr int MIN_VM = 16;
    __device__ __forceinline__ bool perm(const Unit&) const { return true; }
    __device__ __forceinline__ bool operator()(f32x4 (&acc)[2][2][4][2], const Unit& u, int wr, int wc, int fr, int fq) const {
        { int ln_; asm volatile("v_mbcnt_lo_u32_b32 %0, -1, 0\n\tv_mbcnt_hi_u32_b32 %0, -1, %0" : "=v"(ln_)); fr = ln_ & 15; fq = ln_ >> 4; }
        const bool gh = u.pn < 2;
        unsigned char* base = ZG + ((size_t)(u.pm * 8 + (u.pn - 2)) * 2) * 65536 + ((size_t)((wr * 4 + wc) * 8) * 64 + (fq * 16 + fr)) * 16;
#pragma unroll
        for (int ai = 0; ai < 2; ++ai)
#pragma unroll
            for (int m = 0; m < 4; ++m) {
                f32x4 e[2][2];
#pragma unroll
                for (int bj = 0; bj < 2; ++bj)
#pragma unroll
                    for (int n = 0; n < 2; ++n)
#pragma unroll
                        for (int i = 0; i < 4; ++i) e[bj][n][i] = __expf(-acc[ai][bj][m][n][i]);
                if (gh) {
                    const int row = u.pm * 256 + ai * 128 + wr * 64 + m * 16 + fr;
#pragma unroll
                    for (int bj = 0; bj < 2; ++bj) {
                        f32x4 v0, v1;
#pragma unroll
                        for (int i = 0; i < 4; ++i) { v0[i] = acc[ai][bj][m][0][i] * __builtin_amdgcn_rcpf(1.0f + e[bj][0][i]); v1[i] = acc[ai][bj][m][1][i] * __builtin_amdgcn_rcpf(1.0f + e[bj][1][i]); }
                        *(u32x4*)(GH + (size_t)row * 512 + u.pn * 256 + bj * 128 + wc * 32 + 8 * fq) = pack8(v0, v1);
                    }
                } else {
                    f32x4 r0, r1, g0, g1;
#pragma unroll
                    for (int i = 0; i < 4; ++i) {
                        g0[i] = __builtin_amdgcn_rcpf(1.0f + e[1][0][i]); r0[i] = (1.0f + e[1][0][i]) * __builtin_amdgcn_rcpf(1.0f + e[0][0][i]);
                        g1[i] = __builtin_amdgcn_rcpf(1.0f + e[1][1][i]); r1[i] = (1.0f + e[1][1][i]) * __builtin_amdgcn_rcpf(1.0f + e[0][1][i]);
                    }
                    *(u32x4*)(base + (size_t)((ai * 4 + m) * 64) * 16) = pack8(r0, r1);
                    *(u32x4*)(base + 65536 + (size_t)((ai * 4 + m) * 64) * 16) = pack8(g0, g1);
                }
                __builtin_amdgcn_sched_barrier(0);
            }
        return false;
    }
};
struct EpiPlain {
    bf16_t* O;
    static constexpr bool HAS_MID = false; static constexpr int MIN_VM = 16;
    __device__ __forceinline__ bool perm(const Unit&) const { return true; }
    __device__ __forceinline__ bool operator()(f32x4 (&acc)[2][2][4][2], const Unit& u, int wr, int wc, int fr, int fq) const {
        { int ln_; asm volatile("v_mbcnt_lo_u32_b32 %0, -1, 0\n\tv_mbcnt_hi_u32_b32 %0, -1, %0" : "=v"(ln_)); fr = ln_ & 15; fq = ln_ >> 4; }
#pragma unroll
        for (int ai = 0; ai < 2; ++ai)
#pragma unroll
            for (int m = 0; m < 4; ++m) {
                const int row = u.pm * 256 + ai * 128 + wr * 64 + m * 16 + fr;
#pragma unroll
                for (int bj = 0; bj < 2; ++bj) {
                    *(u32x4*)(O + (size_t)row * D + u.pn * 256 + bj * 128 + wc * 32 + 8 * fq) = pack8(acc[ai][bj][m][0], acc[ai][bj][m][1]);
                }
            }
        return false;
    }
};
struct EpiBranch {
    static constexpr int MIN_VM = 32;
    static constexpr bool HAS_MID = true;
    const unsigned char* ZG; bf16_t* MB;
    __device__ __forceinline__ bool perm(const Unit&) const { return true; }
    __device__ __forceinline__ void mid(f32x4 (&acc)[2][2][4][2], const Unit& u, int wr, int wc) const {
        int ln_; asm volatile("v_mbcnt_lo_u32_b32 %0, -1, 0\n\tv_mbcnt_hi_u32_b32 %0, -1, %0" : "=v"(ln_));
        u32x4 w[2][8];
#pragma unroll
        for (int bj = 0; bj < 2; ++bj) {
            const unsigned char* base = ZG + ((size_t)(u.pm * 8 + (2 * u.pn + bj)) * 2) * 65536 + ((size_t)((wr * 4 + wc) * 8) * 64 + ln_) * 16;
#pragma unroll
            for (int k = 0; k < 8; ++k) w[bj][k] = *(const u32x4*)(base + (size_t)(k * 64) * 16);
        }
        __builtin_amdgcn_sched_barrier(0);
#pragma unroll
        for (int bj = 0; bj < 2; ++bj)
#pragma unroll
            for (int ai = 0; ai < 2; ++ai)
#pragma unroll
                for (int m = 0; m < 4; ++m) {
                    f32x4 g0, g1; unpack8(w[bj][ai * 4 + m], g0, g1);
                    acc[ai][bj][m][0] *= g0; acc[ai][bj][m][1] *= g1;
                }
        __builtin_amdgcn_sched_barrier(0);
    }
    __device__ __forceinline__ bool operator()(f32x4 (&acc)[2][2][4][2], const Unit& u, int wr, int wc, int fr, int fq) const {
        { int ln_; asm volatile("v_mbcnt_lo_u32_b32 %0, -1, 0\n\tv_mbcnt_hi_u32_b32 %0, -1, %0" : "=v"(ln_)); fr = ln_ & 15; fq = ln_ >> 4; }
        u32x4 w[2][8];
#pragma unroll
        for (int bj = 0; bj < 2; ++bj) {
            const unsigned char* base = ZG + ((size_t)(u.pm * 8 + (2 * u.pn + bj)) * 2 + 1) * 65536 + ((size_t)((wr * 4 + wc) * 8) * 64 + (fq * 16 + fr)) * 16;
#pragma unroll
            for (int k = 0; k < 8; ++k) w[bj][k] = *(const u32x4*)(base + (size_t)(k * 64) * 16);
        }
        __builtin_amdgcn_sched_barrier(0);
#pragma unroll
        for (int bj = 0; bj < 2; ++bj)
#pragma unroll
            for (int ai = 0; ai < 2; ++ai)
#pragma unroll
                for (int m = 0; m < 4; ++m) {
                    f32x4 g0, g1; unpack8(w[bj][ai * 4 + m], g0, g1);
                    const int row = u.pm * 256 + ai * 128 + wr * 64 + m * 16 + fr;
                    *(u32x4*)(MB + (size_t)row * D + u.pn * 256 + bj * 128 + wc * 32 + 8 * fq) = pack8(acc[ai][bj][m][0] * g0, acc[ai][bj][m][1] * g1);
                }
        return false;
    }
};
struct EpiSwiglu {
    bf16_t* H;
    static constexpr bool HAS_MID = false; static constexpr int MIN_VM = 8;
    __device__ __forceinline__ bool perm(const Unit&) const { return true; }
    __device__ __forceinline__ bool operator()(f32x4 (&acc)[2][2][4][2], const Unit& u, int wr, int wc, int fr, int fq) const {
        { int ln_; asm volatile("v_mbcnt_lo_u32_b32 %0, -1, 0\n\tv_mbcnt_hi_u32_b32 %0, -1, %0" : "=v"(ln_)); fr = ln_ & 15; fq = ln_ >> 4; }
#pragma unroll
        for (int ai = 0; ai < 2; ++ai)
#pragma unroll
            for (int m = 0; m < 4; ++m) {
                const int row = u.pm * 256 + ai * 128 + wr * 64 + m * 16 + fr;
                f32x4 h[2];
#pragma unroll
                for (int n = 0; n < 2; ++n) {
                    const f32x4 g = acc[ai][0][m][n], up = acc[ai][1][m][n];
#pragma unroll
                    for (int i = 0; i < 4; ++i) h[n][i] = siluf_(g[i]) * up[i];
                }
                *(u32x4*)(H + (size_t)row * D + u.pn * 128 + wc * 32 + 8 * fq) = pack8(h[0], h[1]);
            }
        return false;
    }
};
struct MoeSched1 {
    const char* XS; const char* W; const int* SEL; int total, G, c;
    __device__ __forceinline__ bool next(int i, Unit& u) const {
        const int L = i * G + c; if (L >= total) return false;
        if (L < 4096) { const int b = L & 7, rt = (L >> 3) & 3, j = (L >> 5) & 7, e = L >> 8; u.pm = (b * NE + e) * 4 + rt; u.pn = j; u.aux = e; }
        else { const int q = L - 4096; u.pn = q & 7; u.aux = q >> 3; u.pm = 512 + u.aux; }
        return true;
    }
    __device__ __forceinline__ const char* aptr(const Unit&) const { return XS; }
    __device__ __forceinline__ unsigned arow(const Unit& u, int r) const { return (unsigned)SEL[u.pm * 256 + r] * (unsigned)(D * 2); }
    __device__ __forceinline__ const int* selrow(const Unit& u) const { return SEL + u.pm * 256; }
    __device__ __forceinline__ const char* bptr(const Unit& u) const { return W + ((size_t)u.aux * 2048 + (size_t)u.pn * 256) * D * 2; }
};
struct MoeSched2 {
    const char* HB; const char* W; int total, G, c;
    __device__ __forceinline__ bool next(int i, Unit& u) const {
        const int L = i * G + c; if (L >= total) return false;
        if (L < 2048) { const int b = L & 7, rt = (L >> 3) & 3, j = (L >> 5) & 3, e = L >> 7; u.pm = (b * NE + e) * 4 + rt; u.pn = j; u.aux = e; }
        else { const int q = L - 2048; u.pn = q & 3; u.aux = q >> 2; u.pm = 512 + u.aux; }
        return true;
    }
    __device__ __forceinline__ const char* aptr(const Unit& u) const { return HB + (size_t)u.pm * 256 * D * 2; }
    __device__ __forceinline__ const char* bptr(const Unit& u) const { return W + ((size_t)u.aux * 1024 + (size_t)u.pn * 256) * D * 2; }
};

__device__ __forceinline__ void transpose_item(const float* W, int srcN, int k0, int n0, bf16_t* WT, int dpitch, int drow0, int dcol0, LAS float* scr, int lane) {
    float wv[32];
#pragma unroll
    for (int i = 0; i < 32; ++i) { const int kk = 2 * i + (lane >> 5); wv[i] = __builtin_nontemporal_load(W + (size_t)(k0 + kk) * srcN + n0 + (lane & 31)); }
    __builtin_amdgcn_sched_barrier(0);
#pragma unroll
    for (int i = 0; i < 32; ++i) { const int kk = 2 * i + (lane >> 5); scr[kk * 33 + (lane & 31)] = wv[i]; }
    asm volatile("s_waitcnt lgkmcnt(0)" ::: "memory");
    const int c = lane & 7;
#pragma unroll
    for (int j = 0; j < 4; ++j) { const int n = (lane >> 3) + 8 * j; const LAS float* s = scr + (8 * c) * 33 + n;
        u32x4 o; o.x = pk2(s[0 * 33], s[1 * 33]); o.y = pk2(s[2 * 33], s[3 * 33]); o.z = pk2(s[4 * 33], s[5 * 33]); o.w = pk2(s[6 * 33], s[7 * 33]);
        *(u32x4*)(WT + (size_t)(drow0 + n) * dpitch + dcol0 + k0 + 8 * c) = o; }
    asm volatile("s_waitcnt lgkmcnt(0)" ::: "memory");
}
constexpr int CV_IN = 16 * (IN_DIM / 32), CV_BR = 8 * 32, CV_OUT = 16 * 32, CV_E = 16 * 32;
constexpr int CV_DENSE = CV_IN + 2 * CV_BR + CV_OUT, CV_GU_END = CV_DENSE + NE * 2 * CV_E, CV_ITEMS = CV_GU_END + NE * CV_E;
__device__ __forceinline__ bf16_t* weights_of(const Frame& F, const Args& a, int l) { return l == 0 ? (bf16_t*)(F.ws + WS_W) : (bf16_t*)((unsigned char*)a.out + W1_OFF); }
__device__ __forceinline__ void convert_weights(const Frame& F, const Args& a, int l, int it_lo, int it_hi, int worker, int nworkers) {
    LAS float* scr = (LAS float*)(F.lds + F.wave * 8448);
    bf16_t* Wb = weights_of(F, a, l);
    bf16_t* WIN = Wb + W_IN / 2; bf16_t* WBR = Wb + W_BR / 2; bf16_t* WOUT = Wb + W_OUT / 2; bf16_t* WGU = Wb + W_GU / 2; bf16_t* WDN = Wb + W_DN / 2;
    constexpr int I_IN = CV_IN, I_BR = CV_BR, I_OUT = CV_OUT, I_E = CV_E;
    const int gw = worker * 8 + F.wave, NGW = nworkers * 8;
    for (int it = it_lo + gw; it < it_hi; it += NGW) {
        int r = it;
        if (r < I_IN) { const int nblk = IN_DIM / 32, kb = r / nblk, nb = r % nblk; const int src = 32 * nb; int d0;
            if (src < 768) d0 = src;
            else if (src < 1280) { const int j = (src - 768) >> 7, c = (src - 768) & 127; d0 = 768 + 256 * j + c; }
            else if (src < 1792) { const int j = (src - 1280) >> 7, c = (src - 1280) & 127; d0 = 768 + 256 * j + 128 + c; }
            else if (src < 2304) d0 = 1792 + (src - 1792);
            else if (src < 2816) d0 = 2304 + (src - 2304);
            else if (src < 3328) d0 = N1 + (src - 2816);
            else if (src < 4352) { const int c = src - 3328; d0 = N1 + 512 + 256 * (c >> 7) + (c & 127); }
            else { const int c = src - 4352; d0 = N1 + 512 + 256 * (c >> 7) + 128 + (c & 127); }
            transpose_item(a.w_in + (size_t)l * D * IN_DIM, IN_DIM, 64 * kb, src, WIN, D, d0, 0, scr, F.lane);
            continue; } r -= I_IN;
        if (r < I_BR) { const int kb = r / 32, nb = r % 32; transpose_item(a.w_bra + (size_t)l * 512 * D, D, 64 * kb, 32 * nb, WBR, D, 32 * nb, 0, scr, F.lane); continue; } r -= I_BR;
        if (r < I_BR) { const int kb = r / 32, nb = r % 32; transpose_item(a.w_brh + (size_t)l * 512 * D, D, 64 * kb, 32 * nb, WBR, D, 32 * nb, 512, scr, F.lane); continue; } r -= I_BR;
        if (r < I_OUT) { const int kb = r / 32, nb = r % 32; transpose_item(a.w_out + (size_t)l * D * D, D, 64 * kb, 32 * nb, WOUT, D, 32 * nb, 0, scr, F.lane); continue; } r -= I_OUT;
        if (r < NE * 2 * I_E) {
            const int e = r / (2 * I_E), q = r % (2 * I_E), which = q / I_E, s = q % I_E, kb = s / 32, nb = s % 32;
            const size_t eoff = ((size_t)l * NE + e) * D * D;
            if (which == 0) transpose_item(a.w_gate + eoff, D, 64 * kb, 32 * nb, WGU + (size_t)e * 2048 * D, D, (nb >> 2) * 256 + (nb & 3) * 32, 0, scr, F.lane);
            else            transpose_item(a.w_up + eoff, D, 64 * kb, 32 * nb, WGU + (size_t)e * 2048 * D, D, (nb >> 2) * 256 + 128 + (nb & 3) * 32, 0, scr, F.lane);
            continue; } r -= NE * 2 * I_E;
        { const int e = r / I_E, s = r % I_E, kb = s / 32, nb = s % 32;
          transpose_item(a.w_down + ((size_t)l * NE + e) * D * D, D, 64 * kb, 32 * nb, WDN + (size_t)e * D * D, D, 32 * nb, 0, scr, F.lane); }
    }
}
__device__ __forceinline__ void convert_in_tail(const Frame& F, const Args& a, int total, int l, int it_lo, int it_hi) {
    const int rem = total % F.G, c = F.bx;
    if (rem == 0) convert_weights(F, a, l, it_lo, it_hi, c, F.G);
    else if (c >= rem) convert_weights(F, a, l, it_lo, it_hi, c - rem, F.G - rem);
}
constexpr int CVS_P0 = CV_DENSE;
constexpr int CVS_A = CVS_P0 + 9000, CVS_B = CVS_A + 6500;
constexpr int CVS_C = CV_DENSE + 4000, CVS_D = CVS_C + 5000;
static_assert(CVS_B < CV_ITEMS && CVS_D < CV_GU_END, "conversion slices");
__device__ __forceinline__ void mod_items(const Frame& F, const Args& a) {
    LAS float* sct = (LAS float*)(F.lds + 69632);
    LAS float* red = (LAS float*)(F.lds);
    if (blockIdx.x < 192) {
        for (int i = F.tid; i < 9 * 1024; i += 512) { const int g = i >> 10, k = i & 1023; const float cv = g < NB ? a.c[g * D + k] : a.c_ctx[k]; sct[k * 12 + g] = siluf_(cv); }
    }
    __syncthreads();
    if (blockIdx.x < 192) {
        const int it = blockIdx.x, l = it / 96, n = (it % 96) * 64 + F.lane;
        const float* W = a.w_mod + (size_t)l * D * 6144 + n;
        float acc[9];
#pragma unroll
        for (int g = 0; g < 9; ++g) acc[g] = 0.f;
        for (int k0 = 128 * F.wave; k0 < 128 * F.wave + 128; k0 += 16) {
            float w[16];
#pragma unroll
            for (int j = 0; j < 16; ++j) w[j] = W[(size_t)(k0 + j) * 6144];
#pragma unroll
            for (int j = 0; j < 16; ++j) {
                const f32x4 s0 = *(const LAS f32x4*)(sct + (k0 + j) * 12), s1 = *(const LAS f32x4*)(sct + (k0 + j) * 12 + 4); const float s8 = sct[(k0 + j) * 12 + 8];
                acc[0] += s0[0] * w[j]; acc[1] += s0[1] * w[j]; acc[2] += s0[2] * w[j]; acc[3] += s0[3] * w[j];
                acc[4] += s1[0] * w[j]; acc[5] += s1[1] * w[j]; acc[6] += s1[2] * w[j]; acc[7] += s1[3] * w[j]; acc[8] += s8 * w[j];
            }
        }
#pragma unroll
        for (int g = 0; g < 9; ++g) red[(F.wave * 9 + g) * 64 + F.lane] = acc[g];
    }
    __syncthreads();
    if (blockIdx.x < 192) {
        const int it = blockIdx.x, l = it / 96;
        float* MOD = (float*)(F.ws + WS_MOD);
        for (int i = F.tid; i < 9 * 64; i += 512) { const int g = i >> 6, ln = i & 63; const int n = (it % 96) * 64 + ln;
            float v = a.b_mod[l * 6144 + n];
#pragma unroll
            for (int w = 0; w < 8; ++w) v += red[(w * 9 + g) * 64 + ln];
            MOD[(size_t)(l * 9 + g) * 6144 + n] = v; }
    }
    __syncthreads();
}
__device__ __forceinline__ void small_tables(const Frame& F, const Args& a) {
    if (blockIdx.x == gridDim.x - 1) {
        float* rope = (float*)(F.ws + WS_ROPE);
        for (int i = F.tid; i < 2048; i += 512) { const int pos = i >> 4, d = i & 15; const float inv = powf(10000.0f, -(float)d / 16.0f); const float ang = (float)pos * inv; rope[i] = cosf(ang); rope[2048 + i] = sinf(ang); }
        float* LB = (float*)(F.ws + WS_LB);
        for (int i = F.tid; i < 1024; i += 512) { const int dir = i >> 9, k = i & 511; const float* src = dir ? a.lb_bw : a.lb_fw;
            const float a0 = src[k], a1 = src[512 + k]; const float mx = fmaxf(a0, a1); const float e0 = expf(a0 - mx), e1 = expf(a1 - mx);
            LB[0 * 1024 + i] = 0.0f; LB[1 * 1024 + i] = e1 / (e0 + e1); }
    }
}
__device__ __forceinline__ void ln_mod_rows(const Frame& F, const Args& a) {
    const float* MOD = (const float*)(F.ws + WS_MOD);
    bf16_t* U = (bf16_t*)(F.ws + WS_U);
    const int gw = F.vcu * 8 + F.wave, NGW = F.G * 8, lane = F.lane;
    f32x4 xr[4][4];
    auto ld = [&](int grp) {
        const int row0 = grp * 4;
        const float* xin = row0 < NLAT ? a.x + (size_t)row0 * D : a.ctx + (size_t)(row0 - NLAT) * D;
#pragma unroll
        for (int s2 = 0; s2 < 2; ++s2)
#pragma unroll
            for (int r = 0; r < 4; ++r) { const int c0 = 512 * s2 + 8 * lane; xr[r][2 * s2] = *(const f32x4*)(xin + (size_t)r * D + c0); xr[r][2 * s2 + 1] = *(const f32x4*)(xin + (size_t)r * D + c0 + 4); }
    };
    if (gw < MROWS / 4) ld(gw);
    for (int grp = gw; grp < MROWS / 4; grp += NGW) {
        const int row0 = grp * 4;
        const float* md = MOD + (size_t)(0 * 9 + mod_group(row0)) * 6144;
        f32x4 v[4][4];
#pragma unroll
        for (int r = 0; r < 4; ++r)
#pragma unroll
            for (int q = 0; q < 4; ++q) v[r][q] = xr[r][q];
        if (grp + NGW < MROWS / 4) ld(grp + NGW);
        float rstd[4];
#pragma unroll
        for (int r = 0; r < 4; ++r) {
            const float mean = wsum((hsum4(v[r][0]) + hsum4(v[r][1])) + (hsum4(v[r][2]) + hsum4(v[r][3]))) * (1.f / D);
#pragma unroll
            for (int q = 0; q < 4; ++q) v[r][q] = v[r][q] - mean;
            rstd[r] = 1.0f / sqrtf(wsum((hsq4(v[r][0]) + hsq4(v[r][1])) + (hsq4(v[r][2]) + hsq4(v[r][3]))) * (1.f / D) + LN_EPS);
        }
#pragma unroll
        for (int s2 = 0; s2 < 2; ++s2) {
            const int c0 = 512 * s2 + 8 * lane;
            const f32x4 sca = *(const f32x4*)(md + 1024 + c0) + 1.0f, scb = *(const f32x4*)(md + 1024 + c0 + 4) + 1.0f, sha = *(const f32x4*)(md + c0), shb = *(const f32x4*)(md + c0 + 4);
#pragma unroll
            for (int r = 0; r < 4; ++r) *(u32x4*)(U + (size_t)(row0 + r) * D + c0) = pack8(v[r][2 * s2] * rstd[r] * sca + sha, v[r][2 * s2 + 1] * rstd[r] * scb + shb);
        }
    }
}

constexpr int AT_PITCH = 144;
__device__ __forceinline__ int crow(int r, int hi) { return (r & 3) + 8 * (r >> 2) + 4 * hi; }
typedef short v4i16_t __attribute__((ext_vector_type(4)));
__device__ __forceinline__ s16x4 tr_read(const LAS unsigned char* p) { return __builtin_bit_cast(s16x4, __builtin_amdgcn_ds_read_tr16_b64_v4i16((LAS v4i16_t*)p)); }

__device__ __forceinline__ void attn_unit(const Frame& F, const bf16_t* Z1, bf16_t* AH, const float* sink, int qrow0, int g, int crow0, int wrow0, int nb) {
    const int tid = F.tid, lane = F.lane, wid = F.wave, r32 = lane & 31, hi = lane >> 5;
    const int hh = wid >> 1, th = wid & 1, head = 4 * g + hh;
    LAS unsigned char* Kt = F.lds; LAS unsigned char* Vt = F.lds + 2 * 64 * AT_PITCH;
    bf16x8 qf[2][4];
#pragma unroll
    for (int qb = 0; qb < 2; ++qb)
#pragma unroll
        for (int s = 0; s < 4; ++s) qf[qb][s] = *(const bf16x8*)(Z1 + (size_t)(qrow0 + 64 * th + 32 * qb + r32) * ZQP + ZC_Q + 64 * head + 16 * s + 8 * hi);
    f32x16 ot[2][2];
#pragma unroll
    for (int a = 0; a < 2; ++a)
#pragma unroll
        for (int b = 0; b < 2; ++b) ot[a][b] = (f32x16){};
    const float sk = sink[head] * 1.44269504089f;
    float mrun[2] = {sk, sk}, lsum[2] = {hi == 0 ? 1.0f : 0.0f, hi == 0 ? 1.0f : 0.0f};
    const int srow = tid >> 3, sch = tid & 7;
    u32x4 kreg, vreg;
    auto tile_row0 = [&](int ti) -> int { if (ti < 4) return crow0 + 64 * ti; if (nb < 0) return -1; const int ts = 128 * nb - 128 + 64 * (ti - 4); return (ts < 0 || ts >= SEQ) ? -1 : wrow0 + ts; };
    auto load_tile = [&](int row0) { const bf16_t* p = Z1 + (size_t)(row0 + srow) * ZQP + 64 * g + 8 * sch; kreg = *(const u32x4*)(p + ZC_K); vreg = *(const u32x4*)(p + ZC_V); };
    int ti = 0; int row0 = tile_row0(0); load_tile(row0);
    int buf = 0;
    while (ti < 10) {
        *(LAS u32x4*)(Kt + buf * 64 * AT_PITCH + srow * AT_PITCH + sch * 16) = kreg;
        *(LAS u32x4*)(Vt + buf * 64 * AT_PITCH + srow * AT_PITCH + sch * 16) = vreg;
        __syncthreads();
        int tn = ti + 1, rown = -1;
        while (tn < 10) { rown = tile_row0(tn); if (rown >= 0) break; ++tn; }
        if (tn < 10) load_tile(rown);
        const bool win = ti >= 4;
        const int w = ti - 4;
        const bool skip = win && ((th == 0 && w == 5) || (th == 1 && w == 0));
        if (!skip) {
            const LAS unsigned char* Kb = Kt + buf * 64 * AT_PITCH; const LAS unsigned char* Vb = Vt + buf * 64 * AT_PITCH;
#pragma unroll
            for (int kb = 0; kb < 2; ++kb) {
                bf16x8 kf[4];
#pragma unroll
                for (int s = 0; s < 4; ++s) kf[s] = *(const LAS bf16x8*)(Kb + (32 * kb + r32) * AT_PITCH + (16 * s + 8 * hi) * 2);
                f32x16 sc[2];
#pragma unroll
                for (int qb = 0; qb < 2; ++qb) { sc[qb] = (f32x16){};
#pragma unroll
                    for (int s = 0; s < 4; ++s) sc[qb] = __builtin_amdgcn_mfma_f32_32x32x16_bf16(kf[s], qf[qb][s], sc[qb], 0, 0, 0); }
                bf16x8 pb[2][2];
#pragma unroll
                for (int qb = 0; qb < 2; ++qb) {
                    if (win && (w == th || w == th + 4)) {
                        const int irel = 64 * th + 32 * qb + r32;
                        const int jrel0 = -128 + 64 * w + 32 * kb;
#pragma unroll
                        for (int r = 0; r < 16; ++r) { const int dj = jrel0 + crow(r, hi) - irel; if (dj > 128 || dj < -128) sc[qb][r] = -INFINITY; }
                    }
                    float mx = sc[qb][0];
#pragma unroll
                    for (int r = 1; r < 16; ++r) mx = fmaxf(mx, sc[qb][r]);
                    { const auto sw = __builtin_amdgcn_permlane32_swap(__float_as_uint(mx), __float_as_uint(mx), false, false); mx = fmaxf(__uint_as_float(sw[0]), __uint_as_float(sw[1])); }
                    const float mnew = fmaxf(mrun[qb], mx);
                    const float fsc = __builtin_amdgcn_exp2f(mrun[qb] - mnew);
                    mrun[qb] = mnew;
                    float p[16];
                    f32x2_t ps2 = {0.f, 0.f};
                    const f32x2_t mn2 = {mnew, mnew};
#pragma unroll
                    for (int r = 0; r < 16; r += 2) { const f32x2_t d = (f32x2_t){sc[qb][r], sc[qb][r + 1]} - mn2; p[r] = __builtin_amdgcn_exp2f(d[0]); p[r + 1] = __builtin_amdgcn_exp2f(d[1]); ps2 += (f32x2_t){p[r], p[r + 1]}; }
                    const float ps = ps2[0] + ps2[1];
                    lsum[qb] = lsum[qb] * fsc + ps;
                    if (__any(fsc != 1.0f)) {
#pragma unroll
                        for (int dbl = 0; dbl < 2; ++dbl)
#pragma unroll
                            for (int r = 0; r < 16; ++r) ot[qb][dbl][r] *= fsc;
                    }
#pragma unroll
                    for (int s2 = 0; s2 < 2; ++s2) { u32x4 wv; wv.x = pk2(p[8 * s2 + 0], p[8 * s2 + 1]); wv.y = pk2(p[8 * s2 + 2], p[8 * s2 + 3]); wv.z = pk2(p[8 * s2 + 4], p[8 * s2 + 5]); wv.w = pk2(p[8 * s2 + 6], p[8 * s2 + 7]);
                        pb[qb][s2] = __builtin_bit_cast(bf16x8, wv); }
                }
#pragma unroll
                for (int dbl = 0; dbl < 2; ++dbl)
#pragma unroll
                    for (int s2 = 0; s2 < 2; ++s2) {
                        const int kv0 = 32 * kb + 16 * s2 + 4 * hi + ((lane & 15) >> 2);
                        const int dcol = 32 * dbl + 16 * ((lane >> 4) & 1) + 4 * (lane & 3);
                        const s16x4 lo = tr_read(Vb + kv0 * AT_PITCH + dcol * 2);
                        const s16x4 hi4 = tr_read(Vb + (kv0 + 8) * AT_PITCH + dcol * 2);
                        const bf16x8 va = (bf16x8){lo[0], lo[1], lo[2], lo[3], hi4[0], hi4[1], hi4[2], hi4[3]};
#pragma unroll
                        for (int qb = 0; qb < 2; ++qb) ot[qb][dbl] = __builtin_amdgcn_mfma_f32_32x32x16_bf16(va, pb[qb][s2], ot[qb][dbl], 0, 0, 0);
                    }
            }
        }
        ti = tn; buf ^= 1;
    }
    __syncthreads();
#pragma unroll
    for (int qb = 0; qb < 2; ++qb) {
        float lt; { const auto sw = __builtin_amdgcn_permlane32_swap(__float_as_uint(lsum[qb]), __float_as_uint(lsum[qb]), false, false); lt = __uint_as_float(sw[0]) + __uint_as_float(sw[1]); }
        const float inv = 1.0f / lt;
        bf16_t* orow = AH + (size_t)(qrow0 + 64 * th + 32 * qb + r32) * D + 64 * head;
#pragma unroll
        for (int dbl = 0; dbl < 2; ++dbl)
#pragma unroll
            for (int gq = 0; gq < 4; ++gq) {
                const f32x4 v = (f32x4){ot[qb][dbl][4 * gq + 0], ot[qb][dbl][4 * gq + 1], ot[qb][dbl][4 * gq + 2], ot[qb][dbl][4 * gq + 3]} * inv;
                *(u32x2*)(orow + 32 * dbl + 8 * gq + 4 * hi) = pack4(v);
            }
    }
}
__device__ __forceinline__ void attn_phase(const Frame& F, const Args& a, int l) {
    asm volatile("s_nop 0");
    const bf16_t* Z1 = (const bf16_t*)(F.ws + WS_Z); bf16_t* AH = (bf16_t*)(F.ws + WS_AH);
    const float* sink = a.attn_sink + l * 8;
    const int total = 1024 + (l == 0 ? 32 : 0);
    for (int u = F.vcu; u < total; u += F.G) {
        if (u < 1024) { const int g = u & 1, nb = (u >> 1) & 63, b = u >> 7; attn_unit(F, Z1, AH, sink, b * SEQ + 128 * nb, g, NLAT + b * CTXL, b * SEQ, nb); }
        else { const int q = u - 1024, g = q & 1, half = (q >> 1) & 1, b = q >> 2; attn_unit(F, Z1, AH, sink, NLAT + b * CTXL + 128 * half, g, NLAT + b * CTXL, 0, -1); }
    }
}

constexpr int HG_P128 = 272, HG_PV = 80;
constexpr int HG_QK = 0, HG_QKSZ = 2 * 64 * HG_P128;
constexpr int HG_VT = 2 * HG_QKSZ, HG_VTSZ = 64 * HG_PV;
constexpr int HG_ST = HG_VT + 2 * HG_VTSZ, HG_STSZ = 32 * HG_P128, HG_END = HG_ST + 2 * HG_STSZ;
static_assert(HG_END <= RING_BYTES, "hgrn LDS");
__device__ __forceinline__ int hg_row(int b, int dir, int c, int t) {
    const int p = 64 * (c < 4 ? c : c - 4) + t;
    if (c < 4) return NLAT + b * CTXL + (dir ? (CTXL - 1 - p) : p);
    return b * SEQ + (dir ? (SEQ - 1 - p) : p);
}
template <int V> struct IntC { static constexpr int value = V; };
__device__ __forceinline__ void hgrn_item(const Frame& F, const bf16_t* Z1, const float* VECS, const bf16_t* QS  , bf16_t* OUT  , int b, int h, int dir, int vq) {
    const int tid = F.tid, lane = F.lane, wid = F.wave;
    LAS unsigned char* L = F.lds;
    const int sr = tid >> 3, sc8 = tid & 7;
    const int tv = tid >> 2, vp = tid & 3;
    const int fr = lane & 15, fq = lane >> 4;
    const int tb = wid < 4 ? (wid >> 1) : 3 - ((wid - 4) >> 1), vb = wid & 1;
    const int NC = 132;
    const size_t zq = (ZO_HG + (size_t)((dir * 4 + h) * 2) * ZA_BYTES) / 2, zk = zq + ZA_BYTES / 2;
    for (int i = tid; i < 2 * HG_STSZ / 4; i += 512) ((LAS unsigned*)(L + HG_ST))[i] = 0u;
    f32x4 Sacc[2]; Sacc[0] = (f32x4){0.f, 0.f, 0.f, 0.f}; Sacc[1] = Sacc[0];
    struct GSet { u32x4 q[2], k[2], v, qx[2]; };
    GSet g0, g1; f32x4 mte, mdc;
    g0.v = (u32x4){0u, 0u, 0u, 0u}; g1.v = g0.v; mte = (f32x4){0.f, 0.f, 0.f, 0.f}; mdc = mte;
    auto hg_load = [&](int c, GSet& g) {
        const int row_ = hg_row(b, dir, c, sr); const bf16_t* p_ = Z1 + (size_t)row_ * 128 + 16 * sc8;
        g.q[0] = *(const u32x4*)(p_ + zq); g.q[1] = *(const u32x4*)(p_ + zq + 8); g.k[0] = *(const u32x4*)(p_ + zk); g.k[1] = *(const u32x4*)(p_ + zk + 8);
        if (dir) { const bf16_t* qp_ = QS + (size_t)row_ * D + 512 + h * 128 + 16 * sc8; g.qx[0] = *(const u32x4*)qp_; g.qx[1] = *(const u32x4*)(qp_ + 8); }
        if (tid < 256) { const int rv_ = hg_row(b, dir, c, tv); g.v = *(const u32x4*)(Z1 + (ZO_IH + (size_t)h * ZA_BYTES) / 2 + (size_t)rv_ * 128 + vq * 32 + 8 * vp); }
    };
    f32x4 pte = (f32x4){0.f, 0.f, 0.f, 0.f}, pdc = pte, pee = pte;
    auto hv_load = [&](int c) { const float* vp_ = VECS + ((size_t)(dir * NCHUNK + (hg_row(b, dir, c, 0) >> 6)) * 3) * 512 + h * 128 + 16 * wid + 4 * fq;
        pte = *(const f32x4*)vp_; pdc = *(const f32x4*)(vp_ + 512); pee = *(const f32x4*)(vp_ + 1024); };
    hv_load(0);
    hg_load(0, g0); hg_load(1, g1);
    __syncthreads();
    auto step = [&](int it, GSet& g, auto parc) {
        constexpr int PAR = decltype(parc)::value;
        const f32x4 eenext = pee, tenext = pte, dcnext = pdc;
        if (it + 1 < NC) hv_load(it + 1);
        if (it < NC) {
            constexpr int pp = PAR;
            LAS unsigned char* QMt = L + HG_QK + pp * HG_QKSZ; LAS unsigned char* KMt = QMt + 64 * HG_P128;
            if (dir) {
#pragma unroll
                for (int j = 0; j < 2; ++j) { f32x4 e0, e1, q0, q1; unpack8(g.q[j], e0, e1); unpack8(g.qx[j], q0, q1); g.q[j] = pack8(e0 * q0, e1 * q1); }
            }
            *(LAS u32x4*)(QMt + sr * HG_P128 + 32 * sc8) = g.q[0]; *(LAS u32x4*)(QMt + sr * HG_P128 + 32 * sc8 + 16) = g.q[1];
            *(LAS u32x4*)(KMt + sr * HG_P128 + 32 * sc8) = g.k[0]; *(LAS u32x4*)(KMt + sr * HG_P128 + 32 * sc8 + 16) = g.k[1];
            if (tid < 256) *(LAS u32x4*)(L + HG_VT + pp * HG_VTSZ + tv * HG_PV + 16 * vp) = g.v;
        }
        const f32x4 cte = mte, cdc = mdc;
        __builtin_amdgcn_sched_barrier(0);
        if (it + 2 < NC) hg_load(it + 2, g);
        __builtin_amdgcn_sched_barrier(0);
        if (it >= 1) {
            const int c = it - 1; constexpr int pm = 1 - PAR;
            const LAS unsigned char* QMt = L + HG_QK + pm * HG_QKSZ; const LAS unsigned char* KMt = QMt + 64 * HG_P128;
            const LAS unsigned char* Vt = L + HG_VT + pm * HG_VTSZ;
            const LAS unsigned char* STr = L + HG_ST + pm * HG_STSZ;
            bf16x8 qbs[4], sas[4], ka[4][2];
#pragma unroll
            for (int s = 0; s < 4; ++s) {
                qbs[s] = *(const LAS bf16x8*)(QMt + (16 * tb + fr) * HG_P128 + (32 * s + 8 * fq) * 2);
                sas[s] = *(const LAS bf16x8*)(STr + (16 * vb + fr) * HG_P128 + (32 * s + 8 * fq) * 2);
                ka[s][0] = *(const LAS bf16x8*)(KMt + fr * HG_P128 + (32 * s + 8 * fq) * 2);
            }
            if (tb >= 1) {
#pragma unroll
                for (int s = 0; s < 4; ++s) ka[s][1] = *(const LAS bf16x8*)(KMt + (16 + fr) * HG_P128 + (32 * s + 8 * fq) * 2);
            }
            __builtin_amdgcn_sched_barrier(0);
            f32x4 sc4[4], ov = (f32x4){0.f, 0.f, 0.f, 0.f}, sv[2];
#pragma unroll
            for (int sb = 0; sb < 4; ++sb) sc4[sb] = (f32x4){0.f, 0.f, 0.f, 0.f};
            sv[0] = (f32x4){0.f, 0.f, 0.f, 0.f}; sv[1] = sv[0];
#pragma unroll
            for (int s = 0; s < 4; ++s) {
                sc4[0] = __builtin_amdgcn_mfma_f32_16x16x32_bf16(ka[s][0], qbs[s], sc4[0], 0, 0, 0);
                ov = __builtin_amdgcn_mfma_f32_16x16x32_bf16(sas[s], qbs[s], ov, 0, 0, 0);
            }
            if (tb >= 1) {
#pragma unroll
                for (int s = 0; s < 4; ++s) sc4[1] = __builtin_amdgcn_mfma_f32_16x16x32_bf16(ka[s][1], qbs[s], sc4[1], 0, 0, 0);
            }
            if (tb >= 2) {
#pragma unroll
                for (int s = 0; s < 4; ++s) ka[s][0] = *(const LAS bf16x8*)(KMt + (32 + fr) * HG_P128 + (32 * s + 8 * fq) * 2);
                if (tb >= 3) {
#pragma unroll
                    for (int s = 0; s < 4; ++s) ka[s][1] = *(const LAS bf16x8*)(KMt + (48 + fr) * HG_P128 + (32 * s + 8 * fq) * 2);
                }
#pragma unroll
                for (int s = 0; s < 4; ++s) sc4[2] = __builtin_amdgcn_mfma_f32_16x16x32_bf16(ka[s][0], qbs[s], sc4[2], 0, 0, 0);
                if (tb >= 3) {
#pragma unroll
                    for (int s = 0; s < 4; ++s) sc4[3] = __builtin_amdgcn_mfma_f32_16x16x32_bf16(ka[s][1], qbs[s], sc4[3], 0, 0, 0);
                }
            }
            bf16x8 va[2], kfr[2], vf[2][2];
#pragma unroll
            for (int p2 = 0; p2 < 2; ++p2) {
                const int vrow = 32 * p2 + 4 * fq + ((lane & 15) >> 2), vcolb = (16 * vb + 4 * (lane & 3)) * 2;
                const s16x4 lo = tr_read(Vt + vrow * HG_PV + vcolb), hi4 = tr_read(Vt + (vrow + 16) * HG_PV + vcolb);
                va[p2] = (bf16x8){lo[0], lo[1], lo[2], lo[3], hi4[0], hi4[1], hi4[2], hi4[3]};
                const int krow = 32 * p2 + 8 * fq + ((lane & 15) >> 2), kcolb = (16 * wid + 4 * (lane & 3)) * 2;
                const s16x4 klo = tr_read(KMt + krow * HG_P128 + kcolb), khi = tr_read(KMt + (krow + 4) * HG_P128 + kcolb);
                kfr[p2] = (bf16x8){klo[0], klo[1], klo[2], klo[3], khi[0], khi[1], khi[2], khi[3]};
#pragma unroll
                for (int v2 = 0; v2 < 2; ++v2) {
                    const int v2colb = (16 * v2 + 4 * (lane & 3)) * 2;
                    const s16x4 l2 = tr_read(Vt + krow * HG_PV + v2colb), h2 = tr_read(Vt + (krow + 4) * HG_PV + v2colb);
                    vf[v2][p2] = (bf16x8){l2[0], l2[1], l2[2], l2[3], h2[0], h2[1], h2[2], h2[3]};
                }
            }
#pragma unroll
            for (int s = 0; s < 2; ++s) { sv[0] = __builtin_amdgcn_mfma_f32_16x16x32_bf16(kfr[s], vf[0][s], sv[0], 0, 0, 0); sv[1] = __builtin_amdgcn_mfma_f32_16x16x32_bf16(kfr[s], vf[1][s], sv[1], 0, 0, 0); }
#pragma unroll
            for (int sb = 0; sb < 4; ++sb) if (tb == sb) {
#pragma unroll
                for (int r = 0; r < 4; ++r) if (4 * fq + r > fr) sc4[sb][r] = 0.f;
            }
            {
                const u32x2 blo = pack4(sc4[0]), bhi = pack4(sc4[1]);
                const bf16x8 ab = __builtin_bit_cast(bf16x8, (u32x4){blo.x, blo.y, bhi.x, bhi.y});
                ov = __builtin_amdgcn_mfma_f32_16x16x32_bf16(va[0], ab, ov, 0, 0, 0);
            }
            if (tb >= 2) {
                const u32x2 blo = pack4(sc4[2]), bhi = pack4(sc4[3]);
                const bf16x8 ab = __builtin_bit_cast(bf16x8, (u32x4){blo.x, blo.y, bhi.x, bhi.y});
                ov = __builtin_amdgcn_mfma_f32_16x16x32_bf16(va[1], ab, ov, 0, 0, 0);
            }
            { const int row = hg_row(b, dir, c, 16 * tb + fr);
              *(u32x2*)(OUT + (size_t)row * 512 + h * 128 + vq * 32 + 16 * vb + 4 * fq) = pack4(ov); }
            Sacc[0] = Sacc[0] * cdc + sv[0] * cte; Sacc[1] = Sacc[1] * cdc + sv[1] * cte;
            if (it < NC) {
#pragma unroll
                for (int v2 = 0; v2 < 2; ++v2) *(LAS u32x2*)(L + HG_ST + PAR * HG_STSZ + (16 * v2 + fr) * HG_P128 + (16 * wid + 4 * fq) * 2) = pack4(Sacc[v2] * eenext);
            }
        }
        mte = tenext; mdc = dcnext;
        asm volatile("s_waitcnt lgkmcnt(0)" ::: "memory"); __builtin_amdgcn_s_barrier(); asm volatile("" ::: "memory");
    };
    for (int it = 0; it <= NC; it += 2) { step(it, g0, IntC<0>{}); if (it + 1 <= NC) step(it + 1, g1, IntC<1>{}); }
}
__device__ __forceinline__ void hgrn_phase(const Frame& F) {
    const bf16_t* Z1 = (const bf16_t*)(F.ws + WS_Z);
    bf16_t* OFW = (bf16_t*)(F.ws + WS_O); bf16_t* OBW = OFW + (size_t)MROWS * 512;
    for (int it = F.vcu; it < 256; it += F.G) {
        const int vq = it & 3, dir = (it >> 2) & 1, h = (it >> 3) & 3, b = it >> 5;
        hgrn_item(F, Z1, (const float*)(F.ws + WS_VECS), (const bf16_t*)(F.ws + WS_AH), dir ? OBW : OFW, b, h, dir, vq);
        __syncthreads();
    }
}
__device__ __forceinline__ void readout_phase(const Frame& F, const Args& a, int l, int M) {
    const bf16_t* OFW = (const bf16_t*)(F.ws + WS_O); const bf16_t* OBW = OFW + (size_t)MROWS * 512;
    const bf16_t* Z2 = (const bf16_t*)(F.ws + WS_Z); bf16_t* AH = (bf16_t*)(F.ws + WS_AH);
    const float* ng = a.norm_g + l * 512;
    const int gw = F.vcu * 8 + F.wave, NGW = F.G * 8, lane = F.lane;
    const f32x4 g0 = *(const f32x4*)(ng + 8 * lane), g1 = *(const f32x4*)(ng + 8 * lane + 4);
    u32x4 ra[4], rb[4], rs4[4];
    auto ld = [&](int grp) {
#pragma unroll
        for (int r = 0; r < 4; ++r) { const size_t off = (size_t)(grp * 4 + r) * 512 + 8 * lane; ra[r] = *(const u32x4*)(OFW + off); rb[r] = *(const u32x4*)(OBW + off); rs4[r] = *(const u32x4*)(Z2 + off); }
    };
    if (gw < M / 4) ld(gw);
    for (int grp = gw; grp < M / 4; grp += NGW) {
        f32x4 oa[4], ob[4], sa[4], sb[4];
#pragma unroll
        for (int r = 0; r < 4; ++r) { f32x4 x0, x1, y0, y1; unpack8(ra[r], x0, x1); unpack8(rb[r], y0, y1); oa[r] = x0 + y0; ob[r] = x1 + y1; unpack8(rs4[r], sa[r], sb[r]); }
        if (grp + NGW < M / 4) ld(grp + NGW);
#pragma unroll
        for (int r = 0; r < 4; ++r) {
            const float ss = row16_sum(hsq4(oa[r]) + hsq4(ob[r]));
            const float rs = 1.0f / sqrtf(ss * (1.0f / 128.0f) + LN_EPS);
            *(u32x4*)(AH + (size_t)(grp * 4 + r) * D + 512 + 8 * lane) = pack8(oa[r] * rs * g0 * sa[r], ob[r] * rs * g1 * sb[r]);
        }
    }
}

__device__ __forceinline__ void row_pass1(const Frame& F, const Args& a, int l, int M) {
    LAS float* wrT = (LAS float*)F.lds;
    constexpr int WRP = D + 4;
    const float* wr = a.w_router + (size_t)l * D * NE;
    for (int i = F.tid; i < D * NE; i += 512) { const int d = i >> 4, e = i & 15; wrT[e * WRP + d] = wr[i]; }
    __syncthreads();
    const float* MOD = (const float*)(F.ws + WS_MOD);
    const bf16_t* Y = (const bf16_t*)(F.ws + WS_AH);
    bf16_t* U2 = (bf16_t*)(F.ws + WS_U);
    float* XC = (float*)(F.ws + WS_XC);
    float* AFF = (float*)(F.ws + WS_AFF); float* AFFT = (float*)(F.ws + WS_AFFT);
    const float* lng = a.ln_g + (size_t)(l * 2 + 0) * D; const float* lnb = a.ln_b + (size_t)(l * 2 + 0) * D;
    const int gw = F.vcu * 8 + F.wave, NGW = F.G * 8, lane = F.lane;
    u32x4 xr[4][4];
    const bool xbf = l == 1;
    bf16_t* X1 = (bf16_t*)(F.ws + WS_O);
    auto rp1_load = [&](int grp) {
        const int row0 = grp * 4; const bool lat = row0 < NLAT;
        if (lat && xbf) {
            const bf16_t* xin = (const bf16_t*)a.out + (size_t)row0 * D;
#pragma unroll
            for (int s2 = 0; s2 < 2; ++s2)
#pragma unroll
                for (int r = 0; r < 4; ++r) xr[r][2 * s2] = *(const u32x4*)(xin + (size_t)r * D + 512 * s2 + 8 * lane);
        } else {
            const float* xin = lat ? a.x + (size_t)row0 * D : (l == 0 ? a.ctx + (size_t)(row0 - NLAT) * D : XC + (size_t)(row0 - NLAT) * D);
#pragma unroll
            for (int s2 = 0; s2 < 2; ++s2)
#pragma unroll
                for (int r = 0; r < 4; ++r) {
                    const int c0 = 512 * s2 + 8 * lane;
                    xr[r][2 * s2] = *(const u32x4*)(xin + (size_t)r * D + c0); xr[r][2 * s2 + 1] = *(const u32x4*)(xin + (size_t)r * D + c0 + 4);
                }
        }
    };
    if (gw < M / 4) rp1_load(gw);
    for (int grp = gw; grp < M / 4; grp += NGW) {
        const int row0 = grp * 4; const bool lat = row0 < NLAT;
        float* xo = XC + (size_t)(lat ? 0 : row0 - NLAT) * D;
        const float* md = MOD + (size_t)(l * 9 + mod_group(row0)) * 6144;
        f32x4 v[4][4];
#pragma unroll
        for (int s2 = 0; s2 < 2; ++s2) {
            const int c0 = 512 * s2 + 8 * lane;
            const f32x4 ga = *(const f32x4*)(md + 2048 + c0), gb = *(const f32x4*)(md + 2048 + c0 + 4);
#pragma unroll
            for (int r = 0; r < 4; ++r) {
                f32x4 ya, yb; unpack8(*(const u32x4*)(Y + (size_t)(row0 + r) * D + c0), ya, yb);
                f32x4 xa, xb; if (lat && xbf) unpack8(xr[r][2 * s2], xa, xb); else { xa = __builtin_bit_cast(f32x4, xr[r][2 * s2]); xb = __builtin_bit_cast(f32x4, xr[r][2 * s2 + 1]); }
                v[r][2 * s2] = xa * ALPHA + ga * ya; v[r][2 * s2 + 1] = xb * ALPHA + gb * yb;
            }
        }
        if (grp + NGW < M / 4) rp1_load(grp + NGW);
        float rstd[4];
#pragma unroll
        for (int r = 0; r < 4; ++r) {
            const float mean = wsum((hsum4(v[r][0]) + hsum4(v[r][1])) + (hsum4(v[r][2]) + hsum4(v[r][3]))) * (1.f / D);
#pragma unroll
            for (int q = 0; q < 4; ++q) v[r][q] = v[r][q] - mean;
            rstd[r] = 1.0f / sqrtf(wsum((hsq4(v[r][0]) + hsq4(v[r][1])) + (hsq4(v[r][2]) + hsq4(v[r][3]))) * (1.f / D) + LN_EPS);
        }
#pragma unroll
        for (int q = 0; q < 4; ++q) {
            const int c0 = 512 * (q >> 1) + 8 * lane + 4 * (q & 1);
            const f32x4 g = *(const f32x4*)(lng + c0), bb = *(const f32x4*)(lnb + c0);
#pragma unroll
            for (int r = 0; r < 4; ++r) { v[r][q] = v[r][q] * rstd[r] * g + bb; if (!lat) *(f32x4*)(xo + (size_t)r * D + c0) = v[r][q]; }
        }
        if (lat) {
#pragma unroll
            for (int s2 = 0; s2 < 2; ++s2)
#pragma unroll
                for (int r = 0; r < 4; ++r) *(u32x4*)(X1 + (size_t)(row0 + r) * D + 512 * s2 + 8 * lane) = pack8(v[r][2 * s2], v[r][2 * s2 + 1]);
        }
#pragma unroll
        for (int r = 0; r < 4; ++r) {
            const float mean = wsum((hsum4(v[r][0]) + hsum4(v[r][1])) + (hsum4(v[r][2]) + hsum4(v[r][3]))) * (1.f / D);
#pragma unroll
            for (int q = 0; q < 4; ++q) v[r][q] = v[r][q] - mean;
            rstd[r] = 1.0f / sqrtf(wsum((hsq4(v[r][0]) + hsq4(v[r][1])) + (hsq4(v[r][2]) + hsq4(v[r][3]))) * (1.f / D) + LN_EPS);
        }
#pragma unroll
        for (int s2 = 0; s2 < 2; ++s2) {
            const int c0 = 512 * s2 + 8 * lane;
            const f32x4 sca = *(const f32x4*)(md + 4096 + c0) + 1.0f, scb = *(const f32x4*)(md + 4096 + c0 + 4) + 1.0f, sha = *(const f32x4*)(md + 3072 + c0), shb = *(const f32x4*)(md + 3072 + c0 + 4);
#pragma unroll
            for (int r = 0; r < 4; ++r) {
                v[r][2 * s2] = v[r][2 * s2] * rstd[r] * sca + sha; v[r][2 * s2 + 1] = v[r][2 * s2 + 1] * rstd[r] * scb + shb;
                *(u32x4*)(U2 + (size_t)(row0 + r) * D + c0) = pack8(v[r][2 * s2], v[r][2 * s2 + 1]);
            }
        }
        float p[64];
#pragma unroll
        for (int e = 0; e < 16; ++e) {
            f32x4 pa[4];
#pragma unroll
            for (int r = 0; r < 4; ++r) pa[r] = (f32x4){0.f, 0.f, 0.f, 0.f};
#pragma unroll
            for (int q = 0; q < 4; ++q) {
                const f32x4 w4 = *(const LAS f32x4*)(wrT + e * WRP + 512 * (q >> 1) + 8 * lane + 4 * (q & 1));
#pragma unroll
                for (int r = 0; r < 4; ++r) pa[r] = __builtin_elementwise_fma(v[r][q], w4, pa[r]);
            }
#pragma unroll
            for (int r = 0; r < 4; ++r) p[r * 16 + e] = hsum4(pa[r]);
            asm volatile("" ::: "memory");
        }
#pragma unroll
        for (int i = 0; i < 32; ++i) { const auto sw = __builtin_amdgcn_permlane32_swap(__float_as_uint(p[i]), __float_as_uint(p[i + 32]), false, false); p[i] = __uint_as_float(sw[0]) + __uint_as_float(sw[1]); }
#define BFLY_(N, MK) { const bool hi_ = (lane & MK) != 0; _Pragma("unroll") for (int i = 0; i < N / 2; ++i) { const float send = hi_ ? p[i] : p[i + N / 2]; const float keep = hi_ ? p[i + N / 2] : p[i]; p[i] = keep + shx(send, MK, lane); } }
        BFLY_(32, 16) BFLY_(16, 8) BFLY_(8, 4) BFLY_(4, 2) BFLY_(2, 1)
#undef BFLY_
        const float lg = p[0];
        const float mx = row16_max(lg);
        const float ex = expf(lg - mx);
        const float mine = ex / row16_sum(ex);
        const int r = lane >> 4, e = lane & 15, row = row0 + r;
        AFF[(size_t)row0 * 16 + lane] = mine;
        if (lat) AFFT[((size_t)(row >> 13) * 16 + e) * SEQ + (row & (SEQ - 1))] = mine;
        else { const int rc = row - NLAT; AFFT[(size_t)NB * 16 * SEQ + ((size_t)(rc >> 8) * 16 + e) * CTXL + (rc & (CTXL - 1))] = mine; }
    }
}
__device__ __forceinline__ void topk_phase(const Frame& F, int l) {
    LAS unsigned* vals = (LAS unsigned*)F.lds;
    LAS unsigned* hist = (LAS unsigned*)(F.lds + 32768);
    LAS unsigned* wtot = (LAS unsigned*)(F.lds + 32768 + 1024);
    LAS unsigned* ctl = (LAS unsigned*)(F.lds + 32768 + 1024 + 64);
    const float* AFFT = (const float*)(F.ws + WS_AFFT);
    int* SEL = (int*)(F.ws + WS_SEL); int* INV = (int*)(F.ws + WS_INV);
    const int total = 128 + (l == 0 ? 128 : 0);
    for (int u = F.vcu; u < total; u += F.G) {
        const bool lat = u < 128; const int q = lat ? u : u - 128, b = q >> 4, e = q & 15;
        const int n = lat ? SEQ : CTXL, cap = lat ? CAP : CAPC;
        const float* src = lat ? AFFT + (size_t)q * SEQ : AFFT + (size_t)NB * 16 * SEQ + (size_t)q * CTXL;
        for (int i = F.tid; i < n; i += 512) vals[i] = __float_as_uint(src[i]);
        if (F.tid == 0) { ctl[0] = 0u; ctl[1] = (unsigned)cap; }
        __syncthreads();
        unsigned mask = 0u;
        for (int pass = 0; pass < 4; ++pass) {
            const int shift = 24 - 8 * pass;
            if (F.tid < 256) hist[F.tid] = 0u;
            __syncthreads();
            const unsigned prefix = ctl[0];
            for (int i = F.tid; i < n; i += 512) { const unsigned v = vals[i]; if ((v & mask) == prefix) __hip_atomic_fetch_add(&hist[(v >> shift) & 255u], 1u, __ATOMIC_RELAXED, __HIP_MEMORY_SCOPE_WORKGROUP); }
            __syncthreads();
            if (F.wave == 0) {
                const unsigned kk = ctl[1];
                const u32x4 h4 = *(const LAS u32x4*)(hist + 4 * F.lane);
                const unsigned sl = (h4.x + h4.y) + (h4.z + h4.w);
                unsigned inc = sl;
#pragma unroll
                for (int o = 1; o < 64; o <<= 1) { const unsigned x = shup_u(inc, o, F.lane); if (F.lane >= o) inc += x; }
                const unsigned tot = (unsigned)__builtin_amdgcn_readlane((int)inc, 63);
                const bool reach = tot - (inc - sl) >= kk;
                const unsigned long long bm = __ballot(reach);
                const int ls = bm ? 63 - __builtin_clzll(bm) : 0;
                unsigned cum = tot - (unsigned)__builtin_amdgcn_readlane((int)inc, ls);
                const unsigned c3 = (unsigned)__builtin_amdgcn_readlane((int)h4.w, ls), c2 = (unsigned)__builtin_amdgcn_readlane((int)h4.z, ls), c1 = (unsigned)__builtin_amdgcn_readlane((int)h4.y, ls);
                int bin = 4 * ls + 3;
                if (cum + c3 < kk) { cum += c3; bin = 4 * ls + 2; if (cum + c2 < kk) { cum += c2; bin = 4 * ls + 1; if (cum + c1 < kk) { cum += c1; bin = 4 * ls; } } }
                if (F.lane == 0) { ctl[0] = prefix | ((unsigned)bin << shift); ctl[1] = kk - cum; }
            }
            mask |= 255u << shift;
            __syncthreads();
        }
        const unsigned T = ctl[0], keq = ctl[1];
        const int per = n >= 512 ? n / 512 : 1; const int base = F.tid * per; const bool active = base < n;
        unsigned ngt = 0u, neq = 0u;
        if (active) for (int i = 0; i < per; ++i) { const unsigned v = vals[base + i]; ngt += v > T; neq += v == T; }
        unsigned pk = ngt | (neq << 16), inc = pk;
#pragma unroll
        for (int o = 1; o < 64; o <<= 1) { const unsigned x = shup_u(inc, o, F.lane); if (F.lane >= o) inc += x; }
        if (F.lane == 63) wtot[F.wave] = inc;
        __syncthreads();
        unsigned wpre = 0u;
        for (int w = 0; w < F.wave; ++w) wpre += wtot[w];
        const unsigned excl = wpre + inc - pk;
        unsigned cgt = excl & 0xffffu, ceq = excl >> 16;
        if (active) for (int i = 0; i < per; ++i) {
            const int t = base + i; const unsigned v = vals[t];
            bool take = false; unsigned slot = 0u;
            if (v > T) { take = true; slot = cgt + (ceq < keq ? ceq : keq); ++cgt; }
            else if (v == T) { if (ceq < keq) { take = true; slot = cgt + ceq; } ++ceq; }
            const int row = lat ? b * SEQ + t : NLAT + b * CTXL + t;
            INV[(size_t)row * 16 + e] = take ? (int)slot : -1;
            if (take) { const int xr = lat ? (b * NE + e) * CAP + (int)slot : NB * NE * CAP + (e * NB + b) * CAPC + (int)slot; SEL[xr] = row; }
        }
        __syncthreads();
    }
}
__device__ __forceinline__ void gather_phase(const Frame& F, int l) {
    const int* SEL = (const int*)(F.ws + WS_SEL);
    const bf16_t* U2 = (const bf16_t*)(F.ws + WS_U); bf16_t* XS = (bf16_t*)(F.ws + WS_Z);
    const int total = NB * NE * CAP + (l == 0 ? NB * NE * CAPC : 0);
    const int gw = F.vcu * 8 + F.wave, NGW = F.G * 8;
    for (int r = gw; r < total; r += NGW) {
        const int src = SEL[r];
        const u32x4 a0 = *(const u32x4*)(U2 + (size_t)src * D + 8 * F.lane), a1 = *(const u32x4*)(U2 + (size_t)src * D + 512 + 8 * F.lane);
        *(u32x4*)(XS + (size_t)r * D + 8 * F.lane) = a0; *(u32x4*)(XS + (size_t)r * D + 512 + 8 * F.lane) = a1;
    }
}
__device__ __forceinline__ void row_pass2(const Frame& F, const Args& a, int l, int M) {
    const float* MOD = (const float*)(F.ws + WS_MOD);
    const bf16_t* YE = (const bf16_t*)(F.ws + WS_Z);
    bf16_t* U = (bf16_t*)(F.ws + WS_U);
    float* XC = (float*)(F.ws + WS_XC);
    const float* AFF = (const float*)(F.ws + WS_AFF); const int* INV = (const int*)(F.ws + WS_INV);
    const float* lng = a.ln_g + (size_t)(l * 2 + 1) * D; const float* lnb = a.ln_b + (size_t)(l * 2 + 1) * D;
    const int gw = F.vcu * 8 + F.wave, NGW = F.G * 8, lane = F.lane;
    u32x4 xr[4][4]; int inv_n = -1; float af_n = 0.f;
    const bf16_t* X1 = (const bf16_t*)(F.ws + WS_O);
    auto rp2_load = [&](int grp) {
        const int row0 = grp * 4; const bool lat = row0 < NLAT;
        inv_n = INV[(size_t)row0 * 16 + lane]; af_n = AFF[(size_t)row0 * 16 + lane];
        if (lat) {
#pragma unroll
            for (int s2 = 0; s2 < 2; ++s2)
#pragma unroll
                for (int r = 0; r < 4; ++r) xr[r][2 * s2] = *(const u32x4*)(X1 + (size_t)(row0 + r) * D + 512 * s2 + 8 * lane);
        } else {
            const float* xin = XC + (size_t)(row0 - NLAT) * D;
#pragma unroll
            for (int q = 0; q < 4; ++q)
#pragma unroll
                for (int r = 0; r < 4; ++r) xr[r][q] = *(const u32x4*)(xin + (size_t)r * D + 512 * (q >> 1) + 8 * lane + 4 * (q & 1));
        }
    };
    if (gw < M / 4) rp2_load(gw);
    for (int grp = gw; grp < M / 4; grp += NGW) {
        const int row0 = grp * 4; const bool lat = row0 < NLAT;
        float* xio = lat ? a.out + (size_t)row0 * D : XC + (size_t)(row0 - NLAT) * D;
        const bool obf = lat && l == 0;
        const int g9 = mod_group(row0);
        const float* md = MOD + (size_t)(l * 9 + g9) * 6144;
        const int inv = inv_n; const float af = af_n;
        const unsigned long long selm = __ballot(inv >= 0);
        unsigned sel_lo = (unsigned)selm, sel_hi = (unsigned)(selm >> 32); asm volatile("" : "+s"(sel_lo), "+s"(sel_hi));
        const int b = lat ? (row0 >> 13) : ((row0 - NLAT) >> 8);
        f32x4 v[4][4];
        unsigned mk[4];
#pragma unroll
        for (int r = 0; r < 4; ++r) {
#pragma unroll
            for (int q = 0; q < 4; ++q) v[r][q] = (f32x4){0.f, 0.f, 0.f, 0.f};
            mk[r] = ((r < 2 ? sel_lo : sel_hi) >> (16 * (r & 1))) & 0xffffu;
        }
        while ((mk[0] | mk[1]) | (mk[2] | mk[3])) {
            u32x4 y0[4], y1[4]; float w[4];
#pragma unroll
            for (int r = 0; r < 4; ++r) {
                w[r] = 0.f;
                if (mk[r]) {
                    const int e = __builtin_ctz(mk[r]); mk[r] &= mk[r] - 1u;
                    const int slot = __builtin_amdgcn_readlane(inv, 16 * r + e); w[r] = rdlane(af, 16 * r + e);
                    const size_t yr = lat ? (size_t)(b * NE + e) * CAP + slot : (size_t)NB * NE * CAP + (size_t)(e * NB + b) * CAPC + slot;
                    y0[r] = *(const u32x4*)(YE + yr * D + 8 * lane); y1[r] = *(const u32x4*)(YE + yr * D + 512 + 8 * lane);
                } else { y0[r] = (u32x4){0u, 0u, 0u, 0u}; y1[r] = y0[r]; }
            }
#pragma unroll
            for (int r = 0; r < 4; ++r) {
                f32x4 ya, yb; unpack8(y0[r], ya, yb); v[r][0] += ya * w[r]; v[r][1] += yb * w[r]; unpack8(y1[r], ya, yb); v[r][2] += ya * w[r]; v[r][3] += yb * w[r];
            }
        }
#pragma unroll
        for (int q = 0; q < 4; ++q) {
            const int c0 = 512 * (q >> 1) + 8 * lane + 4 * (q & 1);
            const f32x4 g2 = *(const f32x4*)(md + 5120 + c0);
#pragma unroll
            for (int r = 0; r < 4; ++r) {
                f32x4 xv;
                if (lat) { f32x4 xa, xb; unpack8(xr[r][q & 2], xa, xb); xv = (q & 1) ? xb : xa; } else xv = __builtin_bit_cast(f32x4, xr[r][q]);
                v[r][q] = xv * ALPHA + g2 * v[r][q];
            }
        }
        if (grp + NGW < M / 4) rp2_load(grp + NGW);
        float rstd[4];
#pragma unroll
        for (int r = 0; r < 4; ++r) {
            const float mean = wsum((hsum4(v[r][0]) + hsum4(v[r][1])) + (hsum4(v[r][2]) + hsum4(v[r][3]))) * (1.f / D);
#pragma unroll
            for (int q = 0; q < 4; ++q) v[r][q] = v[r][q] - mean;
            rstd[r] = 1.0f / sqrtf(wsum((hsq4(v[r][0]) + hsq4(v[r][1])) + (hsq4(v[r][2]) + hsq4(v[r][3]))) * (1.f / D) + LN_EPS);
        }
#pragma unroll
        for (int q = 0; q < 4; ++q) {
            const int c0 = 512 * (q >> 1) + 8 * lane + 4 * (q & 1);
            const f32x4 g = *(const f32x4*)(lng + c0), bb = *(const f32x4*)(lnb + c0);
#pragma unroll
            for (int r = 0; r < 4; ++r) { v[r][q] = v[r][q] * rstd[r] * g + bb; if (!obf) *(f32x4*)(xio + (size_t)r * D + c0) = v[r][q]; }
        }
        if (obf) {
            bf16_t* X2 = (bf16_t*)a.out;
#pragma unroll
            for (int s2 = 0; s2 < 2; ++s2)
#pragma unroll
                for (int r = 0; r < 4; ++r) *(u32x4*)(X2 + (size_t)(row0 + r) * D + 512 * s2 + 8 * lane) = pack8(v[r][2 * s2], v[r][2 * s2 + 1]);
        }
        if (l == 0) {
            const float* md1 = MOD + (size_t)(1 * 9 + g9) * 6144;
#pragma unroll
            for (int r = 0; r < 4; ++r) {
                const float mean = wsum((hsum4(v[r][0]) + hsum4(v[r][1])) + (hsum4(v[r][2]) + hsum4(v[r][3]))) * (1.f / D);
#pragma unroll
                for (int q = 0; q < 4; ++q) v[r][q] = v[r][q] - mean;
                rstd[r] = 1.0f / sqrtf(wsum((hsq4(v[r][0]) + hsq4(v[r][1])) + (hsq4(v[r][2]) + hsq4(v[r][3]))) * (1.f / D) + LN_EPS);
            }
#pragma unroll
            for (int s2 = 0; s2 < 2; ++s2) {
                const int c0 = 512 * s2 + 8 * lane;
                const f32x4 sca = *(const f32x4*)(md1 + 1024 + c0) + 1.0f, scb = *(const f32x4*)(md1 + 1024 + c0 + 4) + 1.0f, sha = *(const f32x4*)(md1 + c0), shb = *(const f32x4*)(md1 + c0 + 4);
#pragma unroll
                for (int r = 0; r < 4; ++r) *(u32x4*)(U + (size_t)(row0 + r) * D + c0) = pack8(v[r][2 * s2] * rstd[r] * sca + sha, v[r][2 * s2 + 1] * rstd[r] * scb + shb);
            }
        }
    }
}

constexpr int NPH_LAYER = 13, NPHASES = 2 + 2 * NPH_LAYER;
__global__ void __launch_bounds__(512, 2) fwd_kernel(Args args) {
    extern __shared__ __attribute__((aligned(16))) unsigned char lds_raw[];
    Frame F0;
    F0.lds = (LAS unsigned char*)lds_raw;
    F0.tid = threadIdx.x; F0.lane = F0.tid & 63; F0.wave = __builtin_amdgcn_readfirstlane(F0.tid >> 6);
    F0.G = gridDim.x; { const int bx = blockIdx.x; F0.vcu = (F0.G % 8 == 0) ? (bx % 8) * (F0.G / 8) + bx / 8 : bx; }
    F0.ws = args.ws;
    volatile LAS unsigned* MISC = (volatile LAS unsigned*)(F0.lds + MISC_OFF);
    if (F0.tid < 64) MISC[F0.tid] = 0u;
    __syncthreads();
    unsigned* ctl = (unsigned*)(F0.ws + WS_CTL);
    XcdBarrier bar; bar.bar = ctl + CW_BAR; bar.x = 0; bar.st = nullptr;
    const int lo = args.ph_lo, hi = args.ph_hi;
    if (hi - lo > 1) bar = xcd_barrier_post(ctl + CW_BAR, MISC + 8);
#ifndef PH_MASK
#define PH_MASK 0xffff
#endif
#define PHON(j) (((PH_MASK) >> (j)) & 1)
#ifndef PH_REP
#define PH_REP 0
#endif
#define REPS(j) for (int rep_ = 0; rep_ <= (((PH_REP) >> (j)) & 1); ++rep_)
#define IN(k) (lo <= (k) && (k) < hi)
#define SEAM(k) do { if (IN(k) && IN((k) + 1)) xcd_barrier(bar); } while (0)
    if (PHON(13) && IN(0)) { const Frame F = phase_frame(F0); mod_items(F, args); small_tables(F, args); convert_weights(F, args, 0, 0, CVS_P0, F.bx, F.G); }
    SEAM(0);
    if (PHON(14) && IN(1)) { const Frame F = phase_frame(F0); ln_mod_rows(F, args); }
    SEAM(1);
    for (int l = 0; l < 2; ++l) {
        const int pb = 2 + NPH_LAYER * l;
        const int M = l == 0 ? MROWS : NLAT;
        REPS(0) if (PHON(0) && IN(pb + 0)) { const Frame F = phase_frame(F0); bf16_t* Wb = weights_of(F, args, l);
            DenseSched<1> S{(const char*)(F.ws + WS_U), (const char*)(Wb + W_IN / 2), MROWS / 256, N1 / 256, F.G, F.bx, 0, 0};
            EpiIn1 E{(bf16_t*)(F.ws + WS_Z), (const float*)(F.ws + WS_ROPE), (const float*)(F.ws + WS_LB) + l * 1024, (float*)(F.ws + WS_VECS), (bf16_t*)(F.ws + WS_AH)};
            pg8::gemm_phase(F.lds, F.tid, D, D, D, S, E);
            { const Frame F2 = phase_frame(F0);
              if (l == 0) convert_in_tail(F2, args, (MROWS / 256) * (N1 / 256), 0, CVS_P0, CVS_A); else convert_in_tail(F2, args, (MROWS / 256) * (N1 / 256), 1, CV_GU_END, CV_ITEMS); }
        }
        SEAM(pb + 0);
        REPS(2) if (PHON(2) && IN(pb + 1)) { const Frame F = phase_frame(F0); bf16_t* Wb = weights_of(F, args, l); hgrn_phase(F); }
        if (IN(pb + 1) && IN(pb + 2)) __syncthreads();
        REPS(1) if (PHON(1) && IN(pb + 2)) { const Frame F = phase_frame(F0); bf16_t* Wb = weights_of(F, args, l); attn_phase(F, args, l); }
        SEAM(pb + 2);
        REPS(3) if (PHON(3) && IN(pb + 3)) { const Frame F = phase_frame(F0); bf16_t* Wb = weights_of(F, args, l);
            DenseSched<1> S{(const char*)(F.ws + WS_U), (const char*)(Wb + W_IN / 2 + (size_t)N1 * D), M / 256, N2 / 256, F.G, F.bx, 0, 0};
            EpiIn2 E{(bf16_t*)(F.ws + WS_Z), F.ws + WS_ZG};
            pg8::gemm_phase(F.lds, F.tid, D, D, D, S, E);
            { const Frame F2 = phase_frame(F0);
              if (l == 0) convert_in_tail(F2, args, (M / 256) * (N2 / 256), 0, CVS_A, CVS_B); }
        }
        SEAM(pb + 3);
        REPS(4) if (PHON(4) && IN(pb + 4)) { const Frame F = phase_frame(F0); bf16_t* Wb = weights_of(F, args, l); readout_phase(F, args, l, M); }
        SEAM(pb + 4);
        REPS(5) if (PHON(5) && IN(pb + 5)) { const Frame F = phase_frame(F0); bf16_t* Wb = weights_of(F, args, l);
            DenseSched<1> S{(const char*)(F.ws + WS_AH), (const char*)(Wb + W_BR / 2), M / 256, D / 256, F.G, F.bx, 0, 0};
            EpiBranch E{F.ws + WS_ZG, (bf16_t*)(F.ws + WS_O)};
            pg8::gemm_phase(F.lds, F.tid, D, D, D, S, E);
            { const Frame F2 = phase_frame(F0);
              if (l == 0) convert_in_tail(F2, args, (M / 256) * (D / 256), 0, CVS_B, CV_ITEMS); }
        }
        SEAM(pb + 5);
        REPS(6) if (PHON(6) && IN(pb + 6)) { const Frame F = phase_frame(F0); bf16_t* Wb = weights_of(F, args, l);
            DenseSched<1> S{(const char*)(F.ws + WS_O), (const char*)(Wb + W_OUT / 2), M / 256, D / 256, F.G, F.bx, 0, 0};
            EpiPlain E{(bf16_t*)(F.ws + WS_AH)};
            pg8::gemm_phase(F.lds, F.tid, D, D, D, S, E);
            { const Frame F2 = phase_frame(F0);
              if (l == 0) convert_in_tail(F2, args, (M / 256) * (D / 256), 1, 0, CVS_C); }
        }
        SEAM(pb + 6);
        REPS(7) if (PHON(7) && IN(pb + 7)) { const Frame F = phase_frame(F0); bf16_t* Wb = weights_of(F, args, l); row_pass1(F, args, l, M); }
        SEAM(pb + 7);
        REPS(8) if (PHON(8) && IN(pb + 8)) { const Frame F = phase_frame(F0); bf16_t* Wb = weights_of(F, args, l); topk_phase(F, l); }
        SEAM(pb + 8);
        REPS(10) if (PHON(10) && IN(pb + 10)) { const Frame F = phase_frame(F0); bf16_t* Wb = weights_of(F, args, l);
            MoeSched1 S{(const char*)(F.ws + WS_U), (const char*)(Wb + W_GU / 2), (const int*)(F.ws + WS_SEL), 4096 + (l == 0 ? 128 : 0), F.G, F.bx};
            EpiSwiglu E{(bf16_t*)(F.ws + WS_HB)};
            pg8::gemm_phase<true>(F.lds, F.tid, D, D, D, S, E);
            { const Frame F2 = phase_frame(F0);
              if (l == 0) convert_in_tail(F2, args, 4096 + 128, 1, CVS_C, CVS_D); }
        }
        SEAM(pb + 10);
        REPS(11) if (PHON(11) && IN(pb + 11)) { const Frame F = phase_frame(F0); bf16_t* Wb = weights_of(F, args, l);
            MoeSched2 S{(const char*)(F.ws + WS_HB), (const char*)(Wb + W_DN / 2), 2048 + (l == 0 ? 64 : 0), F.G, F.bx};
            EpiPlain E{(bf16_t*)(F.ws + WS_Z)};
            pg8::gemm_phase(F.lds, F.tid, D, D, D, S, E);
            { const Frame F2 = phase_frame(F0);
              if (l == 0) convert_in_tail(F2, args, 2048 + 64, 1, CVS_D, CV_GU_END); }
        }
        SEAM(pb + 11);
        REPS(12) if (PHON(12) && IN(pb + 12)) { const Frame F = phase_frame(F0); bf16_t* Wb = weights_of(F, args, l); row_pass2(F, args, l, M); }
        if (l == 0) SEAM(pb + 12);
    }
#undef IN
#undef SEAM
}

extern "C" void kernel_launch(void* const* d_in, const int* in_sizes, int n_in, void* d_out, int out_size, void* d_ws, size_t ws_size, hipStream_t stream) {
    static int grid = 0;
    if (grid == 0) {
        if (n_in != 20 || out_size != NLAT * D || ws_size < WS_END) { fprintf(stderr, "kernel_launch: unexpected shapes (n_in %d out %d ws %zu)\n", n_in, out_size, ws_size); grid = -1; return; }
        int dev = 0, cus = 0, per_cu = 0;
        if (hipGetDevice(&dev) != hipSuccess || hipDeviceGetAttribute(&cus, hipDeviceAttributeMultiprocessorCount, dev) != hipSuccess) { grid = -1; return; }
        if (hipFuncSetAttribute((const void*)fwd_kernel, hipFuncAttributeMaxDynamicSharedMemorySize, LDS_BYTES) != hipSuccess) { fprintf(stderr, "kernel_launch: hipFuncSetAttribute failed\n"); grid = -1; return; }
        if (hipOccupancyMaxActiveBlocksPerMultiprocessor(&per_cu, (const void*)fwd_kernel, 512, LDS_BYTES) != hipSuccess || per_cu < 1) fprintf(stderr, "kernel_launch: occupancy query reports %d\n", per_cu);
        (void)hipGetLastError();
        grid = cus;
    }
    if (grid < 0) return;
    (void)hipMemsetAsync((char*)d_ws + WS_CTL, 0, CTL_ZERO_BYTES, stream);
    Args a{};
    a.x = (const float*)d_in[0]; a.c = (const float*)d_in[1]; a.ctx = (const float*)d_in[2]; a.c_ctx = (const float*)d_in[3]; a.w_mod = (const float*)d_in[4]; a.b_mod = (const float*)d_in[5];
    a.w_in = (const float*)d_in[6]; a.attn_sink = (const float*)d_in[7]; a.lb_fw = (const float*)d_in[8]; a.lb_bw = (const float*)d_in[9]; a.norm_g = (const float*)d_in[10];
    a.w_bra = (const float*)d_in[11]; a.w_brh = (const float*)d_in[12]; a.w_out = (const float*)d_in[13]; a.w_router = (const float*)d_in[14]; a.w_gate = (const float*)d_in[15];
    a.w_up = (const float*)d_in[16]; a.w_down = (const float*)d_in[17]; a.ln_g = (const float*)d_in[18]; a.ln_b = (const float*)d_in[19];
    a.out = (float*)d_out; a.ws = (unsigned char*)d_ws;
#if MK_MULTI
    for (int p = 0; p < NPHASES; ++p) { a.ph_lo = p; a.ph_hi = p + 1; hipLaunchKernelGGL(fwd_kernel, dim3(grid), dim3(512), LDS_BYTES, stream, a); }
#else
    a.ph_lo = 0; a.ph_hi = NPHASES;
    hipLaunchKernelGGL(fwd_kernel, dim3(grid), dim3(512), LDS_BYTES, stream, a);
#endif
}
```

```cpp
#include <hip/hip_runtime.h>
#include <cstdint>
#include <cstdio>

#ifndef MK_MULTI
#define MK_MULTI 0
#endif
#ifndef PG8_SP2
#define PG8_SP2 1
#endif

#define LAS __attribute__((address_space(3)))
typedef unsigned short bf16_t;
typedef short bf16x8 __attribute__((ext_vector_type(8)));
typedef short s16x4 __attribute__((ext_vector_type(4)));
typedef float f32x4 __attribute__((ext_vector_type(4)));
typedef float f32x16 __attribute__((ext_vector_type(16)));
typedef unsigned u32x4 __attribute__((ext_vector_type(4)));
typedef unsigned u32x2 __attribute__((ext_vector_type(2)));

constexpr int D = 1024, NB = 8, SEQ = 8192, CTXL = 256;
constexpr int NLAT = NB * SEQ, NCTX = NB * CTXL, MROWS = NLAT + NCTX;
constexpr int IN_DIM = 5376, N1 = 2816, N2 = 2560;
constexpr int NE = 16, CAP = 1024, CAPC = 32;
constexpr int XSROWS = NB * NE * CAP + NB * NE * CAPC;
constexpr float LN_EPS = 1e-6f;
constexpr float ALPHA = 1.41421356237309515f;

constexpr int ZC_Q = 0, ZC_K = 512, ZC_V = 640, ZC_QM = 768, ZC_KM = 1280, ZC_IH = 2816;
constexpr int NCHUNK = MROWS / 64;
constexpr size_t ZO_HG = (size_t)MROWS * 768 * 2, ZA_BYTES = (size_t)MROWS * 128 * 2, ZO_IH = ZO_HG + 16 * ZA_BYTES;
constexpr int ZQP = 768;

constexpr size_t MiB = 1u << 20;
constexpr size_t WS_CTL = 0, CTL_ZERO_BYTES = 32 * 1024;
constexpr size_t WS_MOD = 1 * MiB;
constexpr size_t WS_ROPE = WS_MOD + 512 * 1024;
constexpr size_t WS_LB = WS_ROPE + 16384;
constexpr size_t WS_XC = 2 * MiB;
constexpr size_t WS_AFF = 18 * MiB;
constexpr size_t WS_INV = 23 * MiB;
constexpr size_t WS_AFFT = 28 * MiB;
constexpr size_t WS_SEL = 32 * MiB + 256 * 1024;
constexpr size_t WS_VECS = 18 * MiB;
constexpr size_t WS_W = 33 * MiB + 512 * 1024;
constexpr size_t W_IN = 0, W_BR = W_IN + (size_t)(N1 + N2) * D * 2, W_OUT = W_BR + (size_t)D * D * 2, W_GU = W_OUT + (size_t)D * D * 2,
                 W_DN = W_GU + (size_t)NE * 2048 * D * 2, W_END = W_DN + (size_t)NE * D * D * 2;
constexpr size_t WS_U = 145 * MiB;
constexpr size_t WS_Z = 277 * MiB;
constexpr size_t WS_ZG = WS_Z + 68 * MiB;
constexpr size_t WS_AH = 706 * MiB;
constexpr size_t WS_O = 838 * MiB;
constexpr size_t WS_HB = 541 * MiB;
constexpr size_t WS_END = 970 * MiB;
constexpr size_t W1_OFF = 128 * MiB;
static_assert(WS_W + W_END <= WS_U && WS_SEL + (size_t)XSROWS * 4 <= WS_W && WS_VECS + (size_t)2 * NCHUNK * 3 * 512 * 4 <= WS_SEL, "weights fit");
static_assert(WS_U + (size_t)MROWS * D * 2 <= WS_Z, "U fits");
static_assert(WS_Z + ZO_IH + 4 * ZA_BYTES <= WS_AH && WS_Z + (size_t)MROWS * 512 * 2 <= WS_ZG && WS_ZG + (size_t)(MROWS / 256) * 8 * 2 * 65536 <= WS_AH, "Z1 / Z2 fit");
static_assert(WS_AH + (size_t)MROWS * D * 2 <= WS_O, "AH fits");
static_assert(WS_O + (size_t)MROWS * D * 2 <= WS_END, "O fits");
static_assert(WS_Z + (size_t)XSROWS * D * 2 <= WS_HB && WS_HB + (size_t)XSROWS * D * 2 <= WS_O, "XS/HB fit");

constexpr int CW_BAR = 4096;

constexpr int RING_BYTES = 131072;
constexpr int MISC_OFF = RING_BYTES;
constexpr int LDS_BYTES = 147456;

__device__ __forceinline__ unsigned f2bf(float f) { unsigned u = __float_as_uint(f); return (u + 0x7fffu + ((u >> 16) & 1u)) >> 16; }
typedef float f32x2_t __attribute__((ext_vector_type(2))); typedef __bf16 bf16x2_t __attribute__((ext_vector_type(2)));
__device__ __forceinline__ unsigned pk2(float lo, float hi) { const f32x2_t v = {lo, hi}; const bf16x2_t b = __builtin_convertvector(v, bf16x2_t); return __builtin_bit_cast(unsigned, b); }
__device__ __forceinline__ float bflo(unsigned w) { return __uint_as_float(w << 16); }
__device__ __forceinline__ float bfhi(unsigned w) { return __uint_as_float(w & 0xffff0000u); }
__device__ __forceinline__ float shx(float v, int m, int lane) { return __int_as_float(__builtin_amdgcn_ds_bpermute((lane ^ m) << 2, __float_as_int(v))); }
__device__ __forceinline__ float shup(float v, int d, int lane) { return __int_as_float(__builtin_amdgcn_ds_bpermute((lane - d) << 2, __float_as_int(v))); }
__device__ __forceinline__ unsigned shup_u(unsigned v, int d, int lane) { return (unsigned)__builtin_amdgcn_ds_bpermute((lane - d) << 2, (int)v); }
__device__ __forceinline__ float shidx(float v, int src) { return __int_as_float(__builtin_amdgcn_ds_bpermute(src << 2, __float_as_int(v))); }
__device__ __forceinline__ int shidx_i(int v, int src) { return __builtin_amdgcn_ds_bpermute(src << 2, v); }
__device__ __forceinline__ float wave_sum(float v, int lane) {
#pragma unroll
    for (int o = 1; o < 64; o <<= 1) v += shx(v, o, lane);
    return v;
}

template <int CTRL> __device__ __forceinline__ float dppf(float v) { return __int_as_float(__builtin_amdgcn_update_dpp(0, __float_as_int(v), CTRL, 0xF, 0xF, true)); }
__device__ __forceinline__ float row16_sum(float v) { v += dppf<0xB1>(v); v += dppf<0x4E>(v); v += dppf<0x141>(v); v += dppf<0x140>(v); return v; }
__device__ __forceinline__ float row16_max(float v) { v = fmaxf(v, dppf<0xB1>(v)); v = fmaxf(v, dppf<0x4E>(v)); v = fmaxf(v, dppf<0x141>(v)); v = fmaxf(v, dppf<0x140>(v)); return v; }
template <int CTRL, int RM> __device__ __forceinline__ float dppz(float v) { return __int_as_float(__builtin_amdgcn_update_dpp(0, __float_as_int(v), CTRL, RM, 0xF, false)); }
__device__ __forceinline__ float wave_scan(float v) {
    v += dppz<0x111, 0xF>(v); v += dppz<0x112, 0xF>(v); v += dppz<0x114, 0xF>(v); v += dppz<0x118, 0xF>(v); v += dppz<0x142, 0xA>(v); v += dppz<0x143, 0xC>(v); return v; }
__device__ __forceinline__ float rdlane(float v, int l) { return __int_as_float(__builtin_amdgcn_readlane(__float_as_int(v), l)); }
__device__ __forceinline__ float wsum(float v) { v = row16_sum(v); return (rdlane(v, 0) + rdlane(v, 16)) + (rdlane(v, 32) + rdlane(v, 48)); }
__device__ __forceinline__ void unpack8(const u32x4 w, f32x4& a, f32x4& b) { a = (f32x4){bflo(w.x), bfhi(w.x), bflo(w.y), bfhi(w.y)}; b = (f32x4){bflo(w.z), bfhi(w.z), bflo(w.w), bfhi(w.w)}; }
__device__ __forceinline__ u32x4 pack8(const f32x4 a, const f32x4 b) { u32x4 w; w.x = pk2(a[0], a[1]); w.y = pk2(a[2], a[3]); w.z = pk2(b[0], b[1]); w.w = pk2(b[2], b[3]); return w; }
__device__ __forceinline__ float hsum4(const f32x4 v) { return (v[0] + v[1]) + (v[2] + v[3]); }
__device__ __forceinline__ float hsq4(const f32x4 v) { return (v[0] * v[0] + v[1] * v[1]) + (v[2] * v[2] + v[3] * v[3]); }
__device__ __forceinline__ float sigmoidf_(float z) { return __builtin_amdgcn_rcpf(1.0f + __expf(-z)); }
__device__ __forceinline__ float siluf_(float z) { return z * __builtin_amdgcn_rcpf(1.0f + __expf(-z)); }
__device__ __forceinline__ u32x2 pack4(const f32x4 v) { u32x2 w; w.x = pk2(v[0], v[1]); w.y = pk2(v[2], v[3]); return w; }
__device__ __forceinline__ f32x4 unpack4(const u32x2 w) { return (f32x4){bflo(w.x), bfhi(w.x), bflo(w.y), bfhi(w.y)}; }

#define XB_TMO      128
#define XB_XCNT(j)  (256  + 64 * (j))
#define XB_XSUB(j)  (1280 + 64 * (j))
#define XB_XGEN(j)  (2304 + 64 * (j))
#define XB_TOP      3328
#define XB_TOPGEN   3392
#define XCD_BAR_WORDS 3456
#define XB_SPIN_CAP (1u << 18)
__device__ __forceinline__ unsigned xb_ld(unsigned* p)              { return __hip_atomic_load(p, __ATOMIC_RELAXED, __HIP_MEMORY_SCOPE_AGENT); }
__device__ __forceinline__ unsigned xb_add(unsigned* p, unsigned v) { return __hip_atomic_fetch_add(p, v, __ATOMIC_RELAXED, __HIP_MEMORY_SCOPE_AGENT); }
__device__ __forceinline__ unsigned xb_xcc_id() { return (unsigned)__builtin_amdgcn_s_getreg((3 << 11) | 20) & 0xFu; }
#define XB_SPIN(cond, bar) do { unsigned _sp = 0; while (cond) { __builtin_amdgcn_s_sleep(1); \
    if ((++_sp & 255u) == 0u) { if (xb_ld(&(bar)[XB_TMO])) break; if (_sp > XB_SPIN_CAP) { atomicAdd(&(bar)[XB_TMO], 1u); break; } } } } while (0)
struct XcdBarrier { unsigned* bar; unsigned x; volatile LAS unsigned* st; };
__device__ __forceinline__ XcdBarrier xcd_barrier_post(unsigned* bar, volatile LAS unsigned* st) {
    XcdBarrier b; b.bar = bar; b.x = xb_xcc_id(); b.st = st;
    if (threadIdx.x == 0) (void)xb_add(&bar[XB_XCNT(b.x)], 1u);
    return b;
}
__device__ __forceinline__ void xcd_barrier_complete(unsigned* bar, unsigned x, unsigned& nloc, unsigned& nx) {
    const unsigned G = gridDim.x * gridDim.y * gridDim.z;
    unsigned sum, cnt, mine, sp = 0u;
    for (;;) {
        sum = 0u; cnt = 0u; mine = 0u;
#pragma unroll
        for (unsigned j = 0; j < 16; ++j) { const unsigned c = xb_ld(&bar[XB_XCNT(j)]); sum += c; cnt += (c > 0u) ? 1u : 0u; mine = (j == x) ? c : mine; }
        if (sum == G) break;
        __builtin_amdgcn_s_sleep(1);
        if ((++sp & 255u) == 0u) { if (xb_ld(&bar[XB_TMO])) break; if (sp > XB_SPIN_CAP) { atomicAdd(&bar[XB_TMO], 1u); break; } }
    }
    nloc = mine > 0u ? mine : 1u; nx = cnt > 0u ? cnt : 1u;
}
__device__ __forceinline__ void xcd_barrier(const XcdBarrier& b) {
    asm volatile("s_waitcnt vmcnt(0)" ::: "memory");
    __syncthreads();
    if (threadIdx.x == 0) {
        unsigned* bar = b.bar;
        __builtin_amdgcn_s_waitcnt(0);
        unsigned nloc = b.st[0], nx = b.st[1];
        if (nloc == 0u) { xcd_barrier_complete(bar, b.x, nloc, nx); b.st[0] = nloc; b.st[1] = nx; }
        const unsigned old = xb_add(&bar[XB_XSUB(b.x)], 1u);
        const unsigned gen = old / nloc;
        if (old + 1u == (gen + 1u) * nloc) {
            __builtin_amdgcn_fence(__ATOMIC_RELEASE, "agent");
            asm volatile("s_waitcnt vmcnt(0)" ::: "memory");
            const unsigned og = xb_add(&bar[XB_TOP], 1u);
            const unsigned tg = og / nx;
            if (og + 1u == (tg + 1u) * nx) xb_add(&bar[XB_TOPGEN], 1u);
            else XB_SPIN(xb_ld(&bar[XB_TOPGEN]) == tg, bar);
            xb_add(&bar[XB_XGEN(b.x)], 1u);
            __builtin_amdgcn_fence(__ATOMIC_ACQUIRE, "agent");
            asm volatile("s_waitcnt vmcnt(0)" ::: "memory");
        } else {
            XB_SPIN(xb_ld(&bar[XB_XGEN(b.x)]) == gen, bar);
            __builtin_amdgcn_fence(__ATOMIC_ACQUIRE, "agent");
            asm volatile("s_waitcnt vmcnt(0)" ::: "memory");
        }
    }
    __syncthreads();
}

namespace pg8 {
constexpr int BM = 256, BK = 64, HALF = 128, HTB = HALF * BK * 2, STAGE_BYTES = 8 * HTB, NXCD = 8, WGM = 8;
constexpr int SELBUF = STAGE_BYTES + 1024;
__host__ __device__ __forceinline__ int lds_byte(int r, int c) { const int st = (r >> 4) * 2 + (c >> 5), rr = r & 15, cc = c & 31, ob = rr * 64 + cc * 2; return st * 1024 + (ob ^ (((ob >> 9) & 1) << 5)); }
__host__ __device__ __forceinline__ int perm32(int rho) { const int n = rho >> 4, i = rho & 15; return 8 * (i >> 2) + 4 * n + (i & 3); }
__host__ __device__ __forceinline__ void stage_rc(int b, int& R, int& C) { const int st = b / 1024, sb = b % 1024, swz = sb ^ (((sb >> 9) & 1) << 5); R = (st >> 1) * 16 + swz / 64; C = (st & 1) * 32 + (swz % 64) / 2; }
struct Unit { int pm, pn, aux; };
__device__ __forceinline__ void tile_of(int wgid0, int nM, int nN, int& pm, int& pn) {
    const int nwg = nM * nN; int wgid = wgid0;
    { const int q = nwg / NXCD, r = nwg % NXCD, xcd = wgid % NXCD, off = wgid / NXCD; wgid = (xcd < r ? xcd * (q + 1) : r * (q + 1) + (xcd - r) * q) + off; }
    const int nig = WGM * nN, gid = wgid / nig, fm = gid * WGM, gsz = (nM - fm) < WGM ? (nM - fm) : WGM;
    pm = fm + ((wgid % nig) % gsz); pn = (wgid % nig) / gsz;
}
template <bool GATHER = false, class Epi, class Sched>
__device__ __forceinline__ void gemm_phase(LAS unsigned char* lds, const int tid, const int K, const int lda, const int ldb, const Sched& S, const Epi& E) {
    const int wid = __builtin_amdgcn_readfirstlane(tid >> 6), lane = tid & 63, wr = wid >> 2, wc = wid & 3, fr = lane & 15, fq = lane >> 4;
    const int nt = K / BK;
    unsigned voffA[2]; int Rr[2], Cc[2];
    unsigned sbv[2];
#pragma unroll
    for (int i = 0; i < 2; ++i) { int R, C; stage_rc(tid * 16 + i * 8192, R, C); Rr[i] = R; Cc[i] = C; voffA[i] = (unsigned)(R * lda + C) * 2u; sbv[i] = 0u; }
    auto bvoff = [&](bool perm, int i) -> unsigned { int ln_; asm volatile("v_mbcnt_lo_u32_b32 %0, -1, 0\n\tv_mbcnt_hi_u32_b32 %0, -1, %0" : "=v"(ln_)); int R, C; stage_rc((wid * 64 + ln_) * 16 + i * 8192, R, C);
        const int Rp = perm ? ((R & ~31) + perm32(R & 31)) : R; return (unsigned)(Rp * ldb + C) * 2u; };
    unsigned goff[2][2], ngoff[2][2], so[2][2];
#pragma unroll
    for (int h = 0; h < 2; ++h)
#pragma unroll
        for (int i = 0; i < 2; ++i) { goff[h][i] = 0u; ngoff[h][i] = 0u; so[h][i] = 0u; }
    const size_t kstep = (size_t)(BK * 2);
    const size_t hstepA = (size_t)HALF * lda * 2, hstepB = (size_t)HALF * ldb * 2;
    const unsigned ldsw = (unsigned)wid * 1024u;
    const int aoff = lds_byte(wr * 64 + fr, fq * 8), boff = lds_byte(wc * 32 + fr, fq * 8);
#define PG8_SA(b, h) (((b) * 2 + (h)) * HTB)
#define PG8_SB(b, h) ((4 + (b) * 2 + (h)) * HTB)
#define PG8_STAGE(bufoff, gbase, voff) do { _Pragma("unroll") for (int _i = 0; _i < 2; ++_i) \
        __builtin_amdgcn_global_load_lds((const unsigned*)((const char*)(gbase) + (voff)[_i]), (LAS unsigned*)(lds + (bufoff) + ldsw + _i * 8192), 16, 0, 0); } while (0)
#define PG8_STAGE_A(bufoff, gbase, h, VO) do { if constexpr (GATHER) { PG8_STAGE(bufoff, gbase, VO[h]); } else { PG8_STAGE(bufoff, (gbase) + (h) * hstepA, voffA); } } while (0)
#define PG8_LDA(dst, b, h) do { _Pragma("unroll") for (int m = 0; m < 4; ++m) _Pragma("unroll") for (int k = 0; k < 2; ++k) dst[m][k] = *(const LAS bf16x8*)(lds + PG8_SA(b, h) + aoff + m * 2048 + k * 1024); } while (0)
#define PG8_LDB(dst, b, h) do { _Pragma("unroll") for (int n = 0; n < 2; ++n) _Pragma("unroll") for (int k = 0; k < 2; ++k) dst[n][k] = *(const LAS bf16x8*)(lds + PG8_SB(b, h) + boff + n * 2048 + k * 1024); } while (0)
#define PG8_MMA(ai, bj, At, Bt) do { __builtin_amdgcn_s_setprio(1); _Pragma("unroll") for (int m = 0; m < 4; ++m) _Pragma("unroll") for (int n = 0; n < 2; ++n) _Pragma("unroll") for (int k = 0; k < 2; ++k) \
        acc[ai][bj][m][n] = __builtin_amdgcn_mfma_f32_16x16x32_bf16(Bt[n][k], At[m][k], acc[ai][bj][m][n], 0, 0, 0); __builtin_amdgcn_s_setprio(0); } while (0)
#define PG8_WAIT_V(n) asm volatile("s_waitcnt vmcnt(" #n ")" ::: "memory")
#define PG8_WAIT_VN(N) asm volatile("s_waitcnt vmcnt(%0)" :: "n"(N) : "memory")
#define PG8_WAIT_L(n) asm volatile("s_waitcnt lgkmcnt(" #n ")" ::: "memory")
#define PG8_BAR __builtin_amdgcn_s_barrier()
#define PG8_SCHED __builtin_amdgcn_sched_barrier(0)
    Unit cur, nxt; int ui = 0;
    if (!S.next(0, cur)) return;
    f32x4 acc[2][2][4][2];
#pragma unroll
    for (int a = 0; a < 2; ++a)
#pragma unroll
        for (int b = 0; b < 2; ++b)
#pragma unroll
            for (int m = 0; m < 4; ++m)
#pragma unroll
                for (int n = 0; n < 2; ++n) acc[a][b][m][n] = (f32x4){0.f, 0.f, 0.f, 0.f};
    bf16x8 At[4][2], B0[2][2], B1[2][2];
    const char* cA = S.aptr(cur); const char* cB = S.bptr(cur);
    bool pcur = E.perm(cur);
    unsigned vbc[2];
#pragma unroll
    for (int i = 0; i < 2; ++i) vbc[i] = bvoff(pcur, i);
    if constexpr (GATHER) {
#pragma unroll
        for (int h = 0; h < 2; ++h)
#pragma unroll
            for (int i = 0; i < 2; ++i) goff[h][i] = S.arow(cur, h * HALF + Rr[i]) + (unsigned)Cc[i] * 2u;
    }
#if PG8_SP2
    PG8_STAGE(PG8_SB(0, 0), cB, vbc); PG8_STAGE(PG8_SB(0, 1), cB + hstepB, vbc); PG8_STAGE_A(PG8_SA(0, 0), cA, 0, goff); PG8_STAGE_A(PG8_SA(0, 1), cA, 1, goff);
    if (wr == 1) PG8_BAR;
    PG8_WAIT_V(2); PG8_BAR;
    PG8_STAGE(PG8_SB(1, 0), cB + kstep, vbc); PG8_STAGE_A(PG8_SA(1, 0), cA + kstep, 0, goff); PG8_STAGE(PG8_SB(1, 1), cB + hstepB + kstep, vbc);
    PG8_WAIT_V(6); PG8_BAR;
#else
    PG8_STAGE(PG8_SB(0, 0), cB, vbc); PG8_STAGE_A(PG8_SA(0, 0), cA, 0, goff); PG8_STAGE(PG8_SB(0, 1), cB + hstepB, vbc); PG8_STAGE_A(PG8_SA(0, 1), cA, 1, goff);
    if (wr == 1) PG8_BAR;
    PG8_WAIT_V(4); PG8_BAR;
    PG8_STAGE(PG8_SB(1, 0), cB + kstep, vbc); PG8_STAGE_A(PG8_SA(1, 0), cA + kstep, 0, goff); PG8_STAGE(PG8_SB(1, 1), cB + hstepB + kstep, vbc);
    PG8_WAIT_V(6); PG8_BAR;
#endif
    for (;;) {
        const bool has_next = S.next(ui + 1, nxt);
        const char* nA = has_next ? S.aptr(nxt) : cA; const char* nB = has_next ? S.bptr(nxt) : cB;
        if constexpr (GATHER) {
            if (has_next && wid == 0) { int ln_; asm volatile("v_mbcnt_lo_u32_b32 %0, -1, 0\n\tv_mbcnt_hi_u32_b32 %0, -1, %0" : "=v"(ln_));
                __builtin_amdgcn_global_load_lds((const unsigned*)(S.selrow(nxt) + ln_ * 4), (LAS unsigned*)(lds + SELBUF + ((ui + 1) & 1) * 1024), 16, 0, 0); }
        }
        const bool pnext = has_next ? E.perm(nxt) : pcur;
        for (int t = 0; t < nt; t += 2) {
            const bool last = (t == nt - 2);
#pragma unroll
            for (int i = 0; i < 2; ++i) sbv[i] = vbc[i];
            if (last && pnext != pcur) {
#pragma unroll
                for (int i = 0; i < 2; ++i) sbv[i] = bvoff(pnext, i); }
            if constexpr (GATHER) {
#pragma unroll
                for (int h = 0; h < 2; ++h)
#pragma unroll
                    for (int i = 0; i < 2; ++i) so[h][i] = goff[h][i];
                if (last) {
                    const LAS int* sb = (const LAS int*)(lds + SELBUF + ((ui + 1) & 1) * 1024);
                    int ln_; asm volatile("v_mbcnt_lo_u32_b32 %0, -1, 0\n\tv_mbcnt_hi_u32_b32 %0, -1, %0" : "=v"(ln_));
#pragma unroll
                    for (int i = 0; i < 2; ++i) { int R_, C_; stage_rc((wid * 64 + ln_) * 16 + i * 8192, R_, C_);
#pragma unroll
                        for (int h = 0; h < 2; ++h) { ngoff[h][i] = has_next ? (unsigned)sb[h * HALF + R_] * (unsigned)(2048) + (unsigned)C_ * 2u : goff[h][i]; so[h][i] = ngoff[h][i]; } }
                }
            }
            const char* a1 = cA + (size_t)(t + 1) * kstep;
            const char* a2 = last ? nA : cA + (size_t)(t + 2) * kstep; const char* b2 = last ? nB : cB + (size_t)(t + 2) * kstep;
            const char* a3 = a2 + kstep; const char* b3 = b2 + kstep;
            if constexpr (Epi::HAS_MID) { if (t == nt / 2) E.mid(acc, cur, wr, wc); }
#if PG8_SP2
            const bool rlx = (t == 0) && (ui > 0);
#define PG8_WAIT_R() do { if (rlx) PG8_WAIT_VN(8 + Epi::MIN_VM); else PG8_WAIT_VN(8); } while (0)
            PG8_LDB(B0, 0, 0); PG8_LDB(B1, 0, 1); PG8_SCHED; PG8_LDA(At, 0, 0); if (!rlx) { PG8_STAGE_A(PG8_SA(1, 1), a1, 1, goff); }
            PG8_WAIT_R(); PG8_WAIT_L(0); PG8_BAR; PG8_MMA(0, 0, At, B0); PG8_MMA(0, 1, At, B1); PG8_BAR; PG8_SCHED;
            PG8_LDA(At, 0, 1); PG8_STAGE(PG8_SB(0, 0), b2, sbv); PG8_STAGE(PG8_SB(0, 1), b2 + hstepB, sbv); PG8_STAGE_A(PG8_SA(0, 0), a2, 0, so);
            PG8_WAIT_R(); PG8_WAIT_L(0); PG8_BAR; PG8_MMA(1, 0, At, B0); PG8_MMA(1, 1, At, B1); PG8_BAR; PG8_SCHED;
            PG8_LDB(B0, 1, 0); PG8_LDB(B1, 1, 1); PG8_SCHED; PG8_LDA(At, 1, 0); PG8_STAGE_A(PG8_SA(0, 1), a2, 1, so);
            PG8_WAIT_R(); PG8_WAIT_L(0); PG8_BAR; PG8_MMA(0, 0, At, B0); PG8_MMA(0, 1, At, B1); PG8_BAR; PG8_SCHED;
            PG8_LDA(At, 1, 1); PG8_STAGE(PG8_SB(1, 0), b3, sbv); PG8_STAGE(PG8_SB(1, 1), b3 + hstepB, sbv); PG8_STAGE_A(PG8_SA(1, 0), a3, 0, so);
            if (rlx) asm volatile("s_waitcnt vmcnt(8) ; exact in the first trip too" ::: "memory"); else PG8_WAIT_VN(8);
            PG8_WAIT_L(0); PG8_BAR; PG8_MMA(1, 0, At, B0); PG8_MMA(1, 1, At, B1); PG8_BAR; PG8_SCHED;
#undef PG8_WAIT_R
#else
            PG8_LDB(B0, 0, 0); PG8_SCHED; PG8_LDA(At, 0, 0); PG8_STAGE_A(PG8_SA(1, 1), a1, 1, goff);
            PG8_WAIT_L(8); PG8_BAR; PG8_WAIT_L(0); PG8_MMA(0, 0, At, B0); PG8_BAR; PG8_SCHED;
            PG8_LDB(B1, 0, 1); PG8_STAGE(PG8_SB(0, 0), b2, sbv);
            PG8_BAR; PG8_WAIT_L(0); PG8_MMA(0, 1, At, B1); PG8_BAR;
            PG8_LDA(At, 0, 1); PG8_STAGE_A(PG8_SA(0, 0), a2, 0, so);
            PG8_BAR; PG8_WAIT_L(0); PG8_MMA(1, 0, At, B0); PG8_BAR; PG8_SCHED;
            PG8_STAGE(PG8_SB(0, 1), b2 + hstepB, sbv);
            PG8_WAIT_V(6); PG8_BAR; PG8_MMA(1, 1, At, B1); PG8_BAR;
            PG8_LDB(B0, 1, 0); PG8_SCHED; PG8_LDA(At, 1, 0); PG8_STAGE_A(PG8_SA(0, 1), a2, 1, so);
            PG8_WAIT_L(8); PG8_BAR; PG8_WAIT_L(0); PG8_MMA(0, 0, At, B0); PG8_BAR; PG8_SCHED;
            PG8_LDB(B1, 1, 1); PG8_STAGE(PG8_SB(1, 0), b3, sbv);
            PG8_BAR; PG8_WAIT_L(0); PG8_MMA(0, 1, At, B1); PG8_BAR;
            PG8_LDA(At, 1, 1); PG8_STAGE_A(PG8_SA(1, 0), a3, 0, so);
            PG8_BAR; PG8_WAIT_L(0); PG8_MMA(1, 0, At, B0); PG8_BAR; PG8_SCHED;
            PG8_STAGE(PG8_SB(1, 1), b3 + hstepB, sbv);
            PG8_WAIT_V(6); PG8_BAR; PG8_MMA(1, 1, At, B1); PG8_BAR;
#endif
        }
#if PG8_SP2
        if (has_next) { PG8_STAGE_A(PG8_SA(1, 1), nA + kstep, 1, ngoff); }
        asm volatile("" ::: "memory"); PG8_SCHED;
#endif
        if (wr == 0) PG8_BAR;
        const bool keep = E(acc, cur, wr, wc, fr, fq);
        if (!has_next) break;
        if (!keep) {
#pragma unroll
            for (int a = 0; a < 2; ++a)
#pragma unroll
                for (int b = 0; b < 2; ++b)
#pragma unroll
                    for (int m = 0; m < 4; ++m)
#pragma unroll
                        for (int n = 0; n < 2; ++n) acc[a][b][m][n] = (f32x4){0.f, 0.f, 0.f, 0.f};
        }
        cur = nxt; cA = nA; cB = nB; ++ui; pcur = pnext;
        if (wr == 1) PG8_BAR;
#pragma unroll
        for (int i = 0; i < 2; ++i) vbc[i] = sbv[i];
        if constexpr (GATHER) {
#pragma unroll
            for (int h = 0; h < 2; ++h)
#pragma unroll
                for (int i = 0; i < 2; ++i) goff[h][i] = ngoff[h][i];
        }
    }
    PG8_WAIT_V(0);
    PG8_BAR;
#undef PG8_SA
#undef PG8_SB
#undef PG8_STAGE
#undef PG8_STAGE_A
#undef PG8_LDA
#undef PG8_LDB
#undef PG8_MMA
#undef PG8_WAIT_V
#undef PG8_WAIT_L
#undef PG8_BAR
#undef PG8_SCHED
}
}
using pg8::Unit;

struct Args {
    const float *x, *c, *ctx, *c_ctx, *w_mod, *b_mod, *w_in, *attn_sink, *lb_fw, *lb_bw, *norm_g, *w_bra, *w_brh, *w_out, *w_router, *w_gate, *w_up, *w_down, *ln_g, *ln_b;
    float* out; unsigned char* ws; int ph_lo, ph_hi;
};
struct Frame {
    LAS unsigned char* lds;
    int tid, lane, wave, G, vcu, bx;
    unsigned char* ws;
};
__device__ __forceinline__ Frame phase_frame(const Frame& F0) {
    Frame F = F0; int ln; asm volatile("v_mbcnt_lo_u32_b32 %0, -1, 0\n\tv_mbcnt_hi_u32_b32 %0, -1, %0" : "=v"(ln));
    int wv = F0.wave, gg = F0.G, bb = (int)blockIdx.x; asm volatile("" : "+s"(wv), "+s"(gg), "+s"(bb)); F.wave = wv; F.G = gg; F.bx = bb; F.lane = ln; F.tid = wv * 64 + ln;
    unsigned long long w = (unsigned long long)F0.ws; asm volatile("" : "+s"(w)); F.ws = (unsigned char*)(__attribute__((address_space(1))) unsigned char*)w; return F;
}
__device__ __forceinline__ int mod_group(int row) { return row < NLAT ? (row >> 13) : NB; }

template <int NS>
struct DenseSched {
    const char* A; const char* B; int nM, nN, G, c; size_t a_sub, b_sub;
    __device__ __forceinline__ bool next(int i, Unit& u) const {
        const int ti = (i / NS) * G + c; if (ti >= nM * nN) return false;
        pg8::tile_of(ti, nM, nN, u.pm, u.pn); u.aux = i % NS; return true;
    }
    __device__ __forceinline__ const char* aptr(const Unit& u) const { return A + (size_t)u.pm * 256 * D * 2 + (size_t)u.aux * a_sub; }
    __device__ __forceinline__ const char* bptr(const Unit& u) const { return B + (size_t)u.pn * 256 * D * 2 + (size_t)u.aux * b_sub; }
};

template <int CTRL> __device__ __forceinline__ f32x4 dpp4(const f32x4 v) { return (f32x4){dppf<CTRL>(v[0]), dppf<CTRL>(v[1]), dppf<CTRL>(v[2]), dppf<CTRL>(v[3])}; }
__device__ __forceinline__ f32x4 row16_scan4(f32x4 v) { v += dpp4<0x111>(v); v += dpp4<0x112>(v); v += dpp4<0x114>(v); v += dpp4<0x118>(v); return v; }
__device__ __forceinline__ f32x4 row16_sum4(f32x4 v) { return (f32x4){row16_sum(v[0]), row16_sum(v[1]), row16_sum(v[2]), row16_sum(v[3])}; }
struct EpiIn1 {
    static constexpr bool HAS_MID = false; static constexpr int MIN_VM = 16;
    bf16_t* Z; const float* rope; const float* lb; float* vecs; bf16_t* QS;
    __device__ __forceinline__ bool perm(const Unit& u) const { return u.pn >= 3; }
    template <bool FWD>
    __device__ __forceinline__ void decay_half(f32x4 (&zz)[4][2], const f32x4 (&qraw)[4][2]  , const int dir, const int kc, const Unit& u, int ai, int wr, int wc, int fr, int fq) const {
        u32x2 omf[4][2];
        f32x4 r0[2], s01[2], r2[2], tot[2];
        {
            const f32x4 lbv[2] = {*(const f32x4*)(lb + dir * 512 + kc), *(const f32x4*)(lb + dir * 512 + kc + 4)};
#pragma unroll
            for (int m = 0; m < 4; ++m)
#pragma unroll
                for (int n = 0; n < 2; ++n) {
                    f32x4 z = zz[m][n], o;
#pragma unroll
                    for (int i = 0; i < 4; ++i) {
                        const float e = __builtin_amdgcn_exp2f(z[i] * -1.44269504089f), r = __builtin_amdgcn_rcpf(1.0f + e);
                        const float oml = 1.0f - lbv[n][i];
                        z[i] = __builtin_amdgcn_logf(lbv[n][i] + oml * r);
                        o[i] = oml - oml * r;
                    }
                    omf[m][n] = pack4(o);
                    z = row16_scan4(z); zz[m][n] = z;
                    const f32x4 rs = dpp4<0x15F>(z);
                    if (m == 0) r0[n] = rs; else if (m == 1) s01[n] = r0[n] + rs; else if (m == 2) r2[n] = rs; else tot[n] = (s01[n] + r2[n]) + rs;
                }
        }
        int frl = fr, kcl = kc; asm volatile("" : "+v"(frl), "+v"(kcl));
        const int head = kc >> 7;
        const size_t rowoff = (size_t)(u.pm * 256 + ai * 128 + wr * 64 + frl);
        bf16_t* zp = (bf16_t*)((unsigned char*)Z + ZO_HG + (size_t)((dir * 4 + head) * 2) * ZA_BYTES) + rowoff * 128 + (kcl & 127);
#pragma unroll
        for (int m = 0; m < 4; ++m) {
            u32x2 a0p[2], kmp[2], qsp[2];
#pragma unroll
            for (int n = 0; n < 2; ++n) {
                const f32x4 cfl = zz[m][n];
                const f32x4 cf = m == 0 ? cfl : cfl + (m == 1 ? r0[n] : m == 2 ? s01[n] : s01[n] + r2[n]);
                const f32x4 d = dir ? (s01[n] - cf) + (cfl - dpp4<0x111>(cfl)) : cf - s01[n];
                const f32x4 om = unpack4(omf[m][n]);
                f32x4 a0, km, qs;
#pragma unroll
                for (int i = 0; i < 4; ++i) {
                    const float x = fminf(fmaxf(d[i], -115.415603f), 115.415603f);
                    const float E1 = __builtin_amdgcn_exp2f(x);
                    if constexpr (FWD) { qs[i] = siluf_(qraw[m][n][i]); a0[i] = qs[i] * E1; } else { a0[i] = E1; }
                    km[i] = om[i] * __builtin_amdgcn_exp2f(-x);
                }
                a0p[n] = pack4(a0); kmp[n] = pack4(km); if constexpr (FWD) qsp[n] = pack4(qs);
                __builtin_amdgcn_sched_barrier(0);
            }
            *(u32x4*)(zp + (size_t)(16 * m) * 128) = (u32x4){a0p[0].x, a0p[0].y, a0p[1].x, a0p[1].y}; *(u32x4*)(zp + ZA_BYTES / 2 + (size_t)(16 * m) * 128) = (u32x4){kmp[0].x, kmp[0].y, kmp[1].x, kmp[1].y};
            if constexpr (FWD) *(u32x4*)(QS + (rowoff + 16 * m) * D + 512 + kcl) = (u32x4){qsp[0].x, qsp[0].y, qsp[1].x, qsp[1].y};
        }
        if (frl == 0) {
            float* vp = vecs + ((size_t)(dir * NCHUNK + (u.pm * 4 + ai * 2 + wr)) * 3) * 512 + kcl;
#pragma unroll
            for (int n = 0; n < 2; ++n) {
                f32x4 te, dc, ee;
#pragma unroll
                for (int i = 0; i < 4; ++i) { const float e2 = dir ? tot[n][i] - s01[n][i] : s01[n][i]; te[i] = __builtin_amdgcn_exp2f(tot[n][i] - e2); dc[i] = __builtin_amdgcn_exp2f(tot[n][i]); ee[i] = __builtin_amdgcn_exp2f(e2); }
                *(f32x4*)(vp + 4 * n) = te; *(f32x4*)(vp + 512 + 4 * n) = dc; *(f32x4*)(vp + 1024 + 4 * n) = ee;
            }
        }
    }
    __device__ __forceinline__ bool operator()(f32x4 (&acc)[2][2][4][2], const Unit& u, int wr, int wc, int fr, int fq) const {
        { int ln_; asm volatile("v_mbcnt_lo_u32_b32 %0, -1, 0\n\tv_mbcnt_hi_u32_b32 %0, -1, %0" : "=v"(ln_)); fr = ln_ & 15; fq = ln_ >> 4; }
        const bool latent = u.pm < 256;
        if (u.pn >= 3 && u.pn < 7) {
            const int hj = u.pn - 3, kc = 128 * hj + 32 * wc + 8 * fq;
#pragma unroll
            for (int ai = 0; ai < 2; ++ai) decay_half<true>(acc[ai][1], acc[ai][0], 0, kc, u, ai, wr, wc, fr, fq);
            return false;
        }
        if (u.pn >= 7 && u.pn < 9) {
#pragma unroll
            for (int ai = 0; ai < 2; ++ai)
#pragma unroll
                for (int bj = 0; bj < 2; ++bj) decay_half<false>(acc[ai][bj], acc[ai][bj], 1, 256 * (u.pn - 7) + 128 * bj + 32 * wc + 8 * fq, u, ai, wr, wc, fr, fq);
            return false;
        }
        if (u.pn >= 9) {
#pragma unroll
            for (int bj = 0; bj < 2; ++bj) {
                bf16_t* zp = (bf16_t*)((unsigned char*)Z + ZO_IH + (size_t)(2 * (u.pn - 9) + bj) * ZA_BYTES) + (size_t)(u.pm * 256 + wr * 64 + fr) * 128 + 32 * wc + 8 * fq;
#pragma unroll
                for (int ai = 0; ai < 2; ++ai)
#pragma unroll
                    for (int m = 0; m < 4; ++m) *(u32x4*)(zp + (size_t)(ai * 128 + m * 16) * 128) = pack8(acc[ai][bj][m][0], acc[ai][bj][m][1]);
            }
            return false;
        }
        f32x4 rcs[2][4], rsn[2][4];
        if (latent && u.pn < 3) {
#pragma unroll
            for (int ai = 0; ai < 2; ++ai)
#pragma unroll
                for (int m = 0; m < 4; ++m) {
                    const int t = (u.pm * 256 + ai * 128 + wr * 64 + m * 16 + fr) & (SEQ - 1); const int pos = (wc & 1) ? (t & 63) : (t >> 6);
                    rcs[ai][m] = *(const f32x4*)(rope + pos * 16 + 4 * fq); rsn[ai][m] = *(const f32x4*)(rope + 2048 + pos * 16 + 4 * fq);
                }
            __builtin_amdgcn_sched_barrier(0);
        }
#pragma unroll
        for (int bj = 0; bj < 2; ++bj) {
            const int hidx = 2 * u.pn + bj;
            const int col0 = 128 * hidx + 32 * wc + 4 * fq;
            bf16_t* zp = Z + (size_t)(u.pm * 256 + wr * 64 + fr) * ZQP + col0;
            if (hidx < 5) {
                const float qs = hidx < 4 ? 0.125f * 1.44269504089f : 1.0f;
#pragma unroll
                for (int ai = 0; ai < 2; ++ai)
#pragma unroll
                    for (int m = 0; m < 4; ++m) {
                        f32x4 v0 = acc[ai][bj][m][0], v1 = acc[ai][bj][m][1];
                        if (latent) {
                            const f32x4 cs = rcs[ai][m], sn = rsn[ai][m];
                            const f32x4 o0 = v0 * cs - v1 * sn, o1 = v1 * cs + v0 * sn; v0 = o0; v1 = o1;
                        }
                        bf16_t* p = zp + (size_t)(ai * 128 + m * 16) * ZQP;
                        *(u32x2*)p = pack4(v0 * qs); *(u32x2*)(p + 16) = pack4(v1 * qs);
                    }
            } else {
#pragma unroll
                for (int ai = 0; ai < 2; ++ai)
#pragma unroll
                    for (int m = 0; m < 4; ++m) {
                        bf16_t* p = zp + (size_t)(ai * 128 + m * 16) * ZQP;
                        *(u32x2*)p = pack4(acc[ai][bj][m][0]); *(u32x2*)(p + 16) = pack4(acc[ai][bj][m][1]);
                    }
            }
        }
        return false;
    }
};
struct EpiIn2 {
    bf16_t* GH; unsigned char* ZG;
    static constexpr bool HAS_MID = false; static constexpr int MIN_VM = 16;
    __device__ __forceinline__ bool perm(const Unit&) const { return true; }
    __device__ __forceinline__ bool operator()(f32x4 (&acc)[2][2][4][2], const Unit& u, int wr, int wc, int fr, int fq) const {
        { int ln_; asm volatile("v_mbcnt_lo_u32_b32 %0, -1, 0\n\tv_mbcnt_hi_u32_b32 %0, -1, %0" : "=v"(ln_)); fr = ln_ & 15; fq = ln_ >> 4; }
        const bool gh = u.pn < 2;
        unsigned char* base = ZG + ((size_t)(u.pm * 8 + (u.pn - 2)) * 2) * 65536 + ((size_t)((wr * 4 + wc) * 8) * 64 + (fq * 16 + fr)) * 16;
#pragma unroll
        for (int ai = 0; ai < 2; ++ai)
#pragma unroll
            for (int m = 0; m < 4; ++m) {
                f32x4 e[2][2];
#pragma unroll
                for (int bj = 0; bj < 2; ++bj)
#pragma unroll
                    for (int n = 0; n < 2; ++n)
#pragma unroll
                        for (int i = 0; i < 4; ++i) e[bj][n][i] = __expf(-acc[ai][bj][m][n][i]);
                if (gh) {
                    const int row = u.pm * 256 + ai * 128 + wr * 64 + m * 16 + fr;
#pragma unroll
                    for (int bj = 0; bj < 2; ++bj) {
                        f32x4 v0, v1;
#pragma unroll
                        for (int i = 0; i < 4; ++i) { v0[i] = acc[ai][bj][m][0][i] * __builtin_amdgcn_rcpf(1.0f + e[bj][0][i]); v1[i] = acc[ai][bj][m][1][i] * __builtin_amdgcn_rcpf(1.0f + e[bj][1][i]); }
                        *(u32x4*)(GH + (size_t)row * 512 + u.pn * 256 + bj * 128 + wc * 32 + 8 * fq) = pack8(v0, v1);
                    }
                } else {
                    f32x4 r0, r1, g0, g1;
#pragma unroll
                    for (int i = 0; i < 4; ++i) {
                        g0[i] = __builtin_amdgcn_rcpf(1.0f + e[1][0][i]); r0[i] = (1.0f + e[1][0][i]) * __builtin_amdgcn_rcpf(1.0f + e[0][0][i]);
                        g1[i] = __builtin_amdgcn_rcpf(1.0f + e[1][1][i]); r1[i] = (1.0f + e[1][1][i]) * __builtin_amdgcn_rcpf(1.0f + e[0][1][i]);
                    }
                    *(u32x4*)(base + (size_t)((ai * 4 + m) * 64) * 16) = pack8(r0, r1);
                    *(u32x4*)(base + 65536 + (size_t)((ai * 4 + m) * 64) * 16) = pack8(g0, g1);
                }
                __builtin_amdgcn_sched_barrier(0);
            }
        return false;
    }
};
struct EpiPlain {
    bf16_t* O;
    static constexpr bool HAS_MID = false; static constexpr int MIN_VM = 16;
    __device__ __forceinline__ bool perm(const Unit&) const { return true; }
    __device__ __forceinline__ bool operator()(f32x4 (&acc)[2][2][4][2], const Unit& u, int wr, int wc, int fr, int fq) const {
        { int ln_; asm volatile("v_mbcnt_lo_u32_b32 %0, -1, 0\n\tv_mbcnt_hi_u32_b32 %0, -1, %0" : "=v"(ln_)); fr = ln_ & 15; fq = ln_ >> 4; }
#pragma unroll
        for (int ai = 0; ai < 2; ++ai)
#pragma unroll
            for (int m = 0; m < 4; ++m) {
                const int row = u.pm * 256 + ai * 128 + wr * 64 + m * 16 + fr;
#pragma unroll
                for (int bj = 0; bj < 2; ++bj) {
                    *(u32x4*)(O + (size_t)row * D + u.pn * 256 + bj * 128 + wc * 32 + 8 * fq) = pack8(acc[ai][bj][m][0], acc[ai][bj][m][1]);
                }
            }
        return false;
    }
};
struct EpiBranch {
    static constexpr int MIN_VM = 32;
    static constexpr bool HAS_MID = true;
    const unsigned char* ZG; bf16_t* MB;
    __device__ __forceinline__ bool perm(const Unit&) const { return true; }
    __device__ __forceinline__ void mid(f32x4 (&acc)[2][2][4][2], const Unit& u, int wr, int wc) const {
        int ln_; asm volatile("v_mbcnt_lo_u32_b32 %0, -1, 0\n\tv_mbcnt_hi_u32_b32 %0, -1, %0" : "=v"(ln_));
        u32x4 w[2][8];
#pragma unroll
        for (int bj = 0; bj < 2; ++bj) {
            const unsigned char* base = ZG + ((size_t)(u.pm * 8 + (2 * u.pn + bj)) * 2) * 65536 + ((size_t)((wr * 4 + wc) * 8) * 64 + ln_) * 16;
#pragma unroll
            for (int k = 0; k < 8; ++k) w[bj][k] = *(const u32x4*)(base + (size_t)(k * 64) * 16);
        }
        __builtin_amdgcn_sched_barrier(0);
#pragma unroll
        for (int bj = 0; bj < 2; ++bj)
#pragma unroll
            for (int ai = 0; ai < 2; ++ai)
#pragma unroll
                for (int m = 0; m < 4; ++m) {
                    f32x4 g0, g1; unpack8(w[bj][ai * 4 + m], g0, g1);
                    acc[ai][bj][m][0] *= g0; acc[ai][bj][m][1] *= g1;
                }
        __builtin_amdgcn_sched_barrier(0);
    }
    __device__ __forceinline__ bool operator()(f32x4 (&acc)[2][2][4][2], const Unit& u, int wr, int wc, int fr, int fq) const {
        { int ln_; asm volatile("v_mbcnt_lo_u32_b32 %0, -1, 0\n\tv_mbcnt_hi_u32_b32 %0, -1, %0" : "=v"(ln_)); fr = ln_ & 15; fq = ln_ >> 4; }
        u32x4 w[2][8];
#pragma unroll
        for (int bj = 0; bj < 2; ++bj) {
            const unsigned char* base = ZG + ((size_t)(u.pm * 8 + (2 * u.pn + bj)) * 2 + 1) * 65536 + ((size_t)((wr * 4 + wc) * 8) * 64 + (fq * 16 + fr)) * 16;
#pragma unroll
            for (int k = 0; k < 8; ++k) w[bj][k] = *(const u32x4*)(base + (size_t)(k * 64) * 16);
        }
        __builtin_amdgcn_sched_barrier(0);
#pragma unroll
        for (int bj = 0; bj < 2; ++bj)
#pragma unroll
            for (int ai = 0; ai < 2; ++ai)
#pragma unroll
                for (int m = 0; m < 4; ++m) {
                    f32x4 g0, g1; unpack8(w[bj][ai * 4 + m], g0, g1);
                    const int row = u.pm * 256 + ai * 128 + wr * 64 + m * 16 + fr;
                    *(u32x4*)(MB + (size_t)row * D + u.pn * 256 + bj * 128 + wc * 32 + 8 * fq) = pack8(acc[ai][bj][m][0] * g0, acc[ai][bj][m][1] * g1);
                }
        return false;
    }
};
struct EpiSwiglu {
    bf16_t* H;
    static constexpr bool HAS_MID = false; static constexpr int MIN_VM = 8;
    __device__ __forceinline__ bool perm(const Unit&) const { return true; }
    __device__ __forceinline__ bool operator()(f32x4 (&acc)[2][2][4][2], const Unit& u, int wr, int wc, int fr, int fq) const {
        { int ln_; asm volatile("v_mbcnt_lo_u32_b32 %0, -1, 0\n\tv_mbcnt_hi_u32_b32 %0, -1, %0" : "=v"(ln_)); fr = ln_ & 15; fq = ln_ >> 4; }
#pragma unroll
        for (int ai = 0; ai < 2; ++ai)
#pragma unroll
            for (int m = 0; m < 4; ++m) {
                const int row = u.pm * 256 + ai * 128 + wr * 64 + m * 16 + fr;
                f32x4 h[2];
#pragma unroll
                for (int n = 0; n < 2; ++n) {
                    const f32x4 g = acc[ai][0][m][n], up = acc[ai][1][m][n];
#pragma unroll
                    for (int i = 0; i < 4; ++i) h[n][i] = siluf_(g[i]) * up[i];
                }
                *(u32x4*)(H + (size_t)row * D + u.pn * 128 + wc * 32 + 8 * fq) = pack8(h[0], h[1]);
            }
        return false;
    }
};
struct MoeSched1 {
    const char* XS; const char* W; const int* SEL; int total, G, c;
    __device__ __forceinline__ bool next(int i, Unit& u) const {
        const int L = i * G + c; if (L >= total) return false;
        if (L < 4096) { const int b = L & 7, rt = (L >> 3) & 3, j = (L >> 5) & 7, e = L >> 8; u.pm = (b * NE + e) * 4 + rt; u.pn = j; u.aux = e; }
        else { const int q = L - 4096; u.pn = q & 7; u.aux = q >> 3; u.pm = 512 + u.aux; }
        return true;
    }
    __device__ __forceinline__ const char* aptr(const Unit&) const { return XS; }
    __device__ __forceinline__ unsigned arow(const Unit& u, int r) const { return (unsigned)SEL[u.pm * 256 + r] * (unsigned)(D * 2); }
    __device__ __forceinline__ const int* selrow(const Unit& u) const { return SEL + u.pm * 256; }
    __device__ __forceinline__ const char* bptr(const Unit& u) const { return W + ((size_t)u.aux * 2048 + (size_t)u.pn * 256) * D * 2; }
};
struct MoeSched2 {
    const char* HB; const char* W; int total, G, c;
    __device__ __forceinline__ bool next(int i, Unit& u) const {
        const int L = i * G + c; if (L >= total) return false;
        if (L < 2048) { const int b = L & 7, rt = (L >> 3) & 3, j = (L >> 5) & 3, e = L >> 7; u.pm = (b * NE + e) * 4 + rt; u.pn = j; u.aux = e; }
        else { const int q = L - 2048; u.pn = q & 3; u.aux = q >> 2; u.pm = 512 + u.aux; }
        return true;
    }
    __device__ __forceinline__ const char* aptr(const Unit& u) const { return HB + (size_t)u.pm * 256 * D * 2; }
    __device__ __forceinline__ const char* bptr(const Unit& u) const { return W + ((size_t)u.aux * 1024 + (size_t)u.pn * 256) * D * 2; }
};

__device__ __forceinline__ void transpose_item(const float* W, int srcN, int k0, int n0, bf16_t* WT, int dpitch, int drow0, int dcol0, LAS float* scr, int lane) {
    float wv[32];
#pragma unroll
    for (int i = 0; i < 32; ++i) { const int kk = 2 * i + (lane >> 5); wv[i] = __builtin_nontemporal_load(W + (size_t)(k0 + kk) * srcN + n0 + (lane & 31)); }
    __builtin_amdgcn_sched_barrier(0);
#pragma unroll
    for (int i = 0; i < 32; ++i) { const int kk = 2 * i + (lane >> 5); scr[kk * 33 + (lane & 31)] = wv[i]; }
    asm volatile("s_waitcnt lgkmcnt(0)" ::: "memory");
    const int c = lane & 7;
#pragma unroll
    for (int j = 0; j < 4; ++j) { const int n = (lane >> 3) + 8 * j; const LAS float* s = scr + (8 * c) * 33 + n;
        u32x4 o; o.x = pk2(s[0 * 33], s[1 * 33]); o.y = pk2(s[2 * 33], s[3 * 33]); o.z = pk2(s[4 * 33], s[5 * 33]); o.w = pk2(s[6 * 33], s[7 * 33]);
        *(u32x4*)(WT + (size_t)(drow0 + n) * dpitch + dcol0 + k0 + 8 * c) = o; }
    asm volatile("s_waitcnt lgkmcnt(0)" ::: "memory");
}
constexpr int CV_IN = 16 * (IN_DIM / 32), CV_BR = 8 * 32, CV_OUT = 16 * 32, CV_E = 16 * 32;
constexpr int CV_DENSE = CV_IN + 2 * CV_BR + CV_OUT, CV_GU_END = CV_DENSE + NE * 2 * CV_E, CV_ITEMS = CV_GU_END + NE * CV_E;
__device__ __forceinline__ bf16_t* weights_of(const Frame& F, const Args& a, int l) { return l == 0 ? (bf16_t*)(F.ws + WS_W) : (bf16_t*)((unsigned char*)a.out + W1_OFF); }
__device__ __forceinline__ void convert_weights(const Frame& F, const Args& a, int l, int it_lo, int it_hi, int worker, int nworkers) {
    LAS float* scr = (LAS float*)(F.lds + F.wave * 8448);
    bf16_t* Wb = weights_of(F, a, l);
    bf16_t* WIN = Wb + W_IN / 2; bf16_t* WBR = Wb + W_BR / 2; bf16_t* WOUT = Wb + W_OUT / 2; bf16_t* WGU = Wb + W_GU / 2; bf16_t* WDN = Wb + W_DN / 2;
    constexpr int I_IN = CV_IN, I_BR = CV_BR, I_OUT = CV_OUT, I_E = CV_E;
    const int gw = worker * 8 + F.wave, NGW = nworkers * 8;
    for (int it = it_lo + gw; it < it_hi; it += NGW) {
        int r = it;
        if (r < I_IN) { const int nblk = IN_DIM / 32, kb = r / nblk, nb = r % nblk; const int src = 32 * nb; int d0;
            if (src < 768) d0 = src;
            else if (src < 1280) { const int j = (src - 768) >> 7, c = (src - 768) & 127; d0 = 768 + 256 * j + c; }
            else if (src < 1792) { const int j = (src - 1280) >> 7, c = (src - 1280) & 127; d0 = 768 + 256 * j + 128 + c; }
            else if (src < 2304) d0 = 1792 + (src - 1792);
            else if (src < 2816) d0 = 2304 + (src - 2304);
            else if (src < 3328) d0 = N1 + (src - 2816);
            else if (src < 4352) { const int c = src - 3328; d0 = N1 + 512 + 256 * (c >> 7) + (c & 127); }
            else { const int c = src - 4352; d0 = N1 + 512 + 256 * (c >> 7) + 128 + (c & 127); }
            transpose_item(a.w_in + (size_t)l * D * IN_DIM, IN_DIM, 64 * kb, src, WIN, D, d0, 0, scr, F.lane);
            continue; } r -= I_IN;
        if (r < I_BR) { const int kb = r / 32, nb = r % 32; transpose_item(a.w_bra + (size_t)l * 512 * D, D, 64 * kb, 32 * nb, WBR, D, 32 * nb, 0, scr, F.lane); continue; } r -= I_BR;
        if (r < I_BR) { const int kb = r / 32, nb = r % 32; transpose_item(a.w_brh + (size_t)l * 512 * D, D, 64 * kb, 32 * nb, WBR, D, 32 * nb, 512, scr, F.lane); continue; } r -= I_BR;
        if (r < I_OUT) { const int kb = r / 32, nb = r % 32; transpose_item(a.w_out + (size_t)l * D * D, D, 64 * kb, 32 * nb, WOUT, D, 32 * nb, 0, scr, F.lane); continue; } r -= I_OUT;
        if (r < NE * 2 * I_E) {
            const int e = r / (2 * I_E), q = r % (2 * I_E), which = q / I_E, s = q % I_E, kb = s / 32, nb = s % 32;
            const size_t eoff = ((size_t)l * NE + e) * D * D;
            if (which == 0) transpose_item(a.w_gate + eoff, D, 64 * kb, 32 * nb, WGU + (size_t)e * 2048 * D, D, (nb >> 2) * 256 + (nb & 3) * 32, 0, scr, F.lane);
            else            transpose_item(a.w_up + eoff, D, 64 * kb, 32 * nb, WGU + (size_t)e * 2048 * D, D, (nb >> 2) * 256 + 128 + (nb & 3) * 32, 0, scr, F.lane);
            continue; } r -= NE * 2 * I_E;
        { const int e = r / I_E, s = r % I_E, kb = s / 32, nb = s % 32;
          transpose_item(a.w_down + ((size_t)l * NE + e) * D * D, D, 64 * kb, 32 * nb, WDN + (size_t)e * D * D, D, 32 * nb, 0, scr, F.lane); }
    }
}
__device__ __forceinline__ void convert_in_tail(const Frame& F, const Args& a, int total, int l, int it_lo, int it_hi) {
    const int rem = total % F.G, c = F.bx;
    if (rem == 0) convert_weights(F, a, l, it_lo, it_hi, c, F.G);
    else if (c >= rem) convert_weights(F, a, l, it_lo, it_hi, c - rem, F.G - rem);
}
constexpr int CVS_P0 = CV_DENSE;
constexpr int CVS_A = CVS_P0 + 9000, CVS_B = CVS_A + 6500;
constexpr int CVS_C = CV_DENSE + 4000, CVS_D = CVS_C + 5000;
static_assert(CVS_B < CV_ITEMS && CVS_D < CV_GU_END, "conversion slices");
__device__ __forceinline__ void mod_items(const Frame& F, const Args& a) {
    LAS float* sct = (LAS float*)(F.lds + 69632);
    LAS float* red = (LAS float*)(F.lds);
    if (blockIdx.x < 192) {
        float cv[18];
#pragma unroll
        for (int j = 0; j < 18; ++j) { const int i = F.tid + 512 * j, g = i >> 10, k = i & 1023; cv[j] = g < NB ? a.c[g * D + k] : a.c_ctx[k]; }
#pragma unroll
        for (int j = 0; j < 18; ++j) { const int i = F.tid + 512 * j, g = i >> 10, k = i & 1023; sct[k * 12 + g] = siluf_(cv[j]); }
    }
    __syncthreads();
    if (blockIdx.x < 192) {
        const int it = blockIdx.x, l = it / 96, n = (it % 96) * 64 + F.lane;
        const float* W = a.w_mod + (size_t)l * D * 6144 + n;
        float acc[9];
#pragma unroll
        for (int g = 0; g < 9; ++g) acc[g] = 0.f;
        for (int k0 = 128 * F.wave; k0 < 128 * F.wave + 128; k0 += 16) {
            float w[16];
#pragma unroll
            for (int j = 0; j < 16; ++j) w[j] = W[(size_t)(k0 + j) * 6144];
#pragma unroll
            for (int j = 0; j < 16; ++j) {
                const f32x4 s0 = *(const LAS f32x4*)(sct + (k0 + j) * 12), s1 = *(const LAS f32x4*)(sct + (k0 + j) * 12 + 4); const float s8 = sct[(k0 + j) * 12 + 8];
                acc[0] += s0[0] * w[j]; acc[1] += s0[1] * w[j]; acc[2] += s0[2] * w[j]; acc[3] += s0[3] * w[j];
                acc[4] += s1[0] * w[j]; acc[5] += s1[1] * w[j]; acc[6] += s1[2] * w[j]; acc[7] += s1[3] * w[j]; acc[8] += s8 * w[j];
            }
        }
#pragma unroll
        for (int g = 0; g < 9; ++g) red[(F.wave * 9 + g) * 64 + F.lane] = acc[g];
    }
    __syncthreads();
    if (blockIdx.x < 192) {
        const int it = blockIdx.x, l = it / 96;
        float* MOD = (float*)(F.ws + WS_MOD);
        for (int i = F.tid; i < 9 * 64; i += 512) { const int g = i >> 6, ln = i & 63; const int n = (it % 96) * 64 + ln;
            float v = a.b_mod[l * 6144 + n];
#pragma unroll
            for (int w = 0; w < 8; ++w) v += red[(w * 9 + g) * 64 + ln];
            MOD[(size_t)(l * 9 + g) * 6144 + n] = v; }
    }
    __syncthreads();
}
__device__ __forceinline__ void small_tables(const Frame& F, const Args& a) {
    if (blockIdx.x == gridDim.x - 1) {
        float* rope = (float*)(F.ws + WS_ROPE);
        for (int i = F.tid; i < 2048; i += 512) { const int pos = i >> 4, d = i & 15; const float inv = powf(10000.0f, -(float)d / 16.0f); const float ang = (float)pos * inv; rope[i] = cosf(ang); rope[2048 + i] = sinf(ang); }
        float* LB = (float*)(F.ws + WS_LB);
        for (int i = F.tid; i < 1024; i += 512) { const int dir = i >> 9, k = i & 511; const float* src = dir ? a.lb_bw : a.lb_fw;
            const float a0 = src[k], a1 = src[512 + k]; const float mx = fmaxf(a0, a1); const float e0 = expf(a0 - mx), e1 = expf(a1 - mx);
            LB[0 * 1024 + i] = 0.0f; LB[1 * 1024 + i] = e1 / (e0 + e1); }
    }
}
__device__ __forceinline__ void ln_mod_rows(const Frame& F, const Args& a) {
    const float* MOD = (const float*)(F.ws + WS_MOD);
    bf16_t* U = (bf16_t*)(F.ws + WS_U);
    const int gw = F.vcu * 8 + F.wave, NGW = F.G * 8, lane = F.lane;
    f32x4 xr[4][4];
    auto ld = [&](int grp) {
        const int row0 = grp * 4;
        const float* xin = row0 < NLAT ? a.x + (size_t)row0 * D : a.ctx + (size_t)(row0 - NLAT) * D;
#pragma unroll
        for (int s2 = 0; s2 < 2; ++s2)
#pragma unroll
            for (int r = 0; r < 4; ++r) { const int c0 = 512 * s2 + 8 * lane; xr[r][2 * s2] = *(const f32x4*)(xin + (size_t)r * D + c0); xr[r][2 * s2 + 1] = *(const f32x4*)(xin + (size_t)r * D + c0 + 4); }
    };
    if (gw < MROWS / 4) ld(gw);
    for (int grp = gw; grp < MROWS / 4; grp += NGW) {
        const int row0 = grp * 4;
        const float* md = MOD + (size_t)(0 * 9 + mod_group(row0)) * 6144;
        f32x4 v[4][4];
#pragma unroll
        for (int r = 0; r < 4; ++r)
#pragma unroll
            for (int q = 0; q < 4; ++q) v[r][q] = xr[r][q];
        if (grp + NGW < MROWS / 4) ld(grp + NGW);
        float rstd[4];
#pragma unroll
        for (int r = 0; r < 4; ++r) {
            const float mean = wsum((hsum4(v[r][0]) + hsum4(v[r][1])) + (hsum4(v[r][2]) + hsum4(v[r][3]))) * (1.f / D);
#pragma unroll
            for (int q = 0; q < 4; ++q) v[r][q] = v[r][q] - mean;
            rstd[r] = __builtin_amdgcn_rsqf(wsum((hsq4(v[r][0]) + hsq4(v[r][1])) + (hsq4(v[r][2]) + hsq4(v[r][3]))) * (1.f / D) + LN_EPS);
        }
#pragma unroll
        for (int s2 = 0; s2 < 2; ++s2) {
            const int c0 = 512 * s2 + 8 * lane;
            const f32x4 sca = *(const f32x4*)(md + 1024 + c0) + 1.0f, scb = *(const f32x4*)(md + 1024 + c0 + 4) + 1.0f, sha = *(const f32x4*)(md + c0), shb = *(const f32x4*)(md + c0 + 4);
#pragma unroll
            for (int r = 0; r < 4; ++r) *(u32x4*)(U + (size_t)(row0 + r) * D + c0) = pack8(v[r][2 * s2] * rstd[r] * sca + sha, v[r][2 * s2 + 1] * rstd[r] * scb + shb);
        }
    }
}

constexpr int AT_PITCH = 144;
__device__ __forceinline__ int crow(int r, int hi) { return (r & 3) + 8 * (r >> 2) + 4 * hi; }
typedef short v4i16_t __attribute__((ext_vector_type(4)));
__device__ __forceinline__ s16x4 tr_read(const LAS unsigned char* p) { return __builtin_bit_cast(s16x4, __builtin_amdgcn_ds_read_tr16_b64_v4i16((LAS v4i16_t*)p)); }

__device__ __forceinline__ void attn_unit(const Frame& F, const bf16_t* Z1, bf16_t* AH, const float* sink, int qrow0, int g, int crow0, int wrow0, int nb) {
    const int tid = F.tid, lane = F.lane, wid = F.wave, r32 = lane & 31, hi = lane >> 5;
    const int hh = wid >> 1, th = wid & 1, head = 4 * g + hh;
    LAS unsigned char* Kt = F.lds; LAS unsigned char* Vt = F.lds + 2 * 64 * AT_PITCH;
    bf16x8 qf[2][4];
#pragma unroll
    for (int qb = 0; qb < 2; ++qb)
#pragma unroll
        for (int s = 0; s < 4; ++s) qf[qb][s] = *(const bf16x8*)(Z1 + (size_t)(qrow0 + 64 * th + 32 * qb + r32) * ZQP + ZC_Q + 64 * head + 16 * s + 8 * hi);
    f32x16 ot[2][2];
#pragma unroll
    for (int a = 0; a < 2; ++a)
#pragma unroll
        for (int b = 0; b < 2; ++b) ot[a][b] = (f32x16){};
    const float sk = sink[head] * 1.44269504089f;
    float mrun[2] = {sk, sk}, lsum[2] = {hi == 0 ? 1.0f : 0.0f, hi == 0 ? 1.0f : 0.0f};
    const int srow = tid >> 3, sch = tid & 7;
    u32x4 kreg, vreg;
    auto tile_row0 = [&](int ti) -> int { if (ti < 4) return crow0 + 64 * ti; if (nb < 0) return -1; const int ts = 128 * nb - 128 + 64 * (ti - 4); return (ts < 0 || ts >= SEQ) ? -1 : wrow0 + ts; };
    auto load_tile = [&](int row0) { const bf16_t* p = Z1 + (size_t)(row0 + srow) * ZQP + 64 * g + 8 * sch; kreg = *(const u32x4*)(p + ZC_K); vreg = *(const u32x4*)(p + ZC_V); };
    int ti = 0; int row0 = tile_row0(0); load_tile(row0);
    int buf = 0;
    while (ti < 10) {
        *(LAS u32x4*)(Kt + buf * 64 * AT_PITCH + srow * AT_PITCH + sch * 16) = kreg;
        *(LAS u32x4*)(Vt + buf * 64 * AT_PITCH + srow * AT_PITCH + sch * 16) = vreg;
        __syncthreads();
        int tn = ti + 1, rown = -1;
        while (tn < 10) { rown = tile_row0(tn); if (rown >= 0) break; ++tn; }
        if (tn < 10) load_tile(rown);
        const bool win = ti >= 4;
        const int w = ti - 4;
        const bool skip = win && ((th == 0 && w == 5) || (th == 1 && w == 0));
        if (!skip) {
            const LAS unsigned char* Kb = Kt + buf * 64 * AT_PITCH; const LAS unsigned char* Vb = Vt + buf * 64 * AT_PITCH;
#pragma unroll
            for (int kb = 0; kb < 2; ++kb) {
                bf16x8 kf[4];
#pragma unroll
                for (int s = 0; s < 4; ++s) kf[s] = *(const LAS bf16x8*)(Kb + (32 * kb + r32) * AT_PITCH + (16 * s + 8 * hi) * 2);
                f32x16 sc[2];
#pragma unroll
                for (int qb = 0; qb < 2; ++qb) { sc[qb] = (f32x16){};
#pragma unroll
                    for (int s = 0; s < 4; ++s) sc[qb] = __builtin_amdgcn_mfma_f32_32x32x16_bf16(kf[s], qf[qb][s], sc[qb], 0, 0, 0); }
                bf16x8 pb[2][2];
#pragma unroll
                for (int qb = 0; qb < 2; ++qb) {
                    if (win && (w == th || w == th + 4)) {
                        const int irel = 64 * th + 32 * qb + r32;
                        const int jrel0 = -128 + 64 * w + 32 * kb;
#pragma unroll
                        for (int r = 0; r < 16; ++r) { const int dj = jrel0 + crow(r, hi) - irel; if (dj > 128 || dj < -128) sc[qb][r] = -INFINITY; }
                    }
                    float mx = sc[qb][0];
#pragma unroll
                    for (int r = 1; r < 16; ++r) mx = fmaxf(mx, sc[qb][r]);
                    { const auto sw = __builtin_amdgcn_permlane32_swap(__float_as_uint(mx), __float_as_uint(mx), false, false); mx = fmaxf(__uint_as_float(sw[0]), __uint_as_float(sw[1])); }
                    const float mnew = fmaxf(mrun[qb], mx);
                    const float fsc = __builtin_amdgcn_exp2f(mrun[qb] - mnew);
                    mrun[qb] = mnew;
                    float p[16];
                    f32x2_t ps2 = {0.f, 0.f};
                    const f32x2_t mn2 = {mnew, mnew};
#pragma unroll
                    for (int r = 0; r < 16; r += 2) { const f32x2_t d = (f32x2_t){sc[qb][r], sc[qb][r + 1]} - mn2; p[r] = __builtin_amdgcn_exp2f(d[0]); p[r + 1] = __builtin_amdgcn_exp2f(d[1]); ps2 += (f32x2_t){p[r], p[r + 1]}; }
                    const float ps = ps2[0] + ps2[1];
                    lsum[qb] = lsum[qb] * fsc + ps;
                    if (__any(fsc != 1.0f)) {
#pragma unroll
                        for (int dbl = 0; dbl < 2; ++dbl)
#pragma unroll
                            for (int r = 0; r < 16; ++r) ot[qb][dbl][r] *= fsc;
                    }
#pragma unroll
                    for (int s2 = 0; s2 < 2; ++s2) { u32x4 wv; wv.x = pk2(p[8 * s2 + 0], p[8 * s2 + 1]); wv.y = pk2(p[8 * s2 + 2], p[8 * s2 + 3]); wv.z = pk2(p[8 * s2 + 4], p[8 * s2 + 5]); wv.w = pk2(p[8 * s2 + 6], p[8 * s2 + 7]);
                        pb[qb][s2] = __builtin_bit_cast(bf16x8, wv); }
                }
#pragma unroll
                for (int dbl = 0; dbl < 2; ++dbl)
#pragma unroll
                    for (int s2 = 0; s2 < 2; ++s2) {
                        const int kv0 = 32 * kb + 16 * s2 + 4 * hi + ((lane & 15) >> 2);
                        const int dcol = 32 * dbl + 16 * ((lane >> 4) & 1) + 4 * (lane & 3);
                        const s16x4 lo = tr_read(Vb + kv0 * AT_PITCH + dcol * 2);
                        const s16x4 hi4 = tr_read(Vb + (kv0 + 8) * AT_PITCH + dcol * 2);
                        const bf16x8 va = (bf16x8){lo[0], lo[1], lo[2], lo[3], hi4[0], hi4[1], hi4[2], hi4[3]};
#pragma unroll
                        for (int qb = 0; qb < 2; ++qb) ot[qb][dbl] = __builtin_amdgcn_mfma_f32_32x32x16_bf16(va, pb[qb][s2], ot[qb][dbl], 0, 0, 0);
                    }
            }
        }
        ti = tn; buf ^= 1;
    }
    __syncthreads();
#pragma unroll
    for (int qb = 0; qb < 2; ++qb) {
        float lt; { const auto sw = __builtin_amdgcn_permlane32_swap(__float_as_uint(lsum[qb]), __float_as_uint(lsum[qb]), false, false); lt = __uint_as_float(sw[0]) + __uint_as_float(sw[1]); }
        const float inv = __builtin_amdgcn_rcpf(lt);
        bf16_t* orow = AH + (size_t)(qrow0 + 64 * th + 32 * qb + r32) * D + 64 * head;
#pragma unroll
        for (int dbl = 0; dbl < 2; ++dbl)
#pragma unroll
            for (int gq = 0; gq < 4; ++gq) {
                const f32x4 v = (f32x4){ot[qb][dbl][4 * gq + 0], ot[qb][dbl][4 * gq + 1], ot[qb][dbl][4 * gq + 2], ot[qb][dbl][4 * gq + 3]} * inv;
                *(u32x2*)(orow + 32 * dbl + 8 * gq + 4 * hi) = pack4(v);
            }
    }
}
__device__ __forceinline__ void attn_phase(const Frame& F, const Args& a, int l) {
    asm volatile("s_nop 0");
    const bf16_t* Z1 = (const bf16_t*)(F.ws + WS_Z); bf16_t* AH = (bf16_t*)(F.ws + WS_AH);
    const float* sink = a.attn_sink + l * 8;
    for (int u = F.vcu; u < 1024; u += F.G) { const int g = u & 1, nb = (u >> 1) & 63, b = u >> 7; attn_unit(F, Z1, AH, sink, b * SEQ + 128 * nb, g, NLAT + b * CTXL, b * SEQ, nb); }
    if (l == 0) {
        const int vc = F.vcu;
        const int first = F.G == 256 ? ((((vc >> 2) & 1) == 0 && vc < 64) ? (vc >> 3) * 4 + (vc & 3) : 32) : vc, step = F.G == 256 ? 32 : F.G;
        for (int q = first; q < 32; q += step) { const int g = q & 1, half = (q >> 1) & 1, b = q >> 2; attn_unit(F, Z1, AH, sink, NLAT + b * CTXL + 128 * half, g, NLAT + b * CTXL, 0, -1); }
    }
}

constexpr int HG_P128 = 272, HG_PV = 80;
constexpr int HG_QK = 0, HG_QKSZ = 2 * 64 * HG_P128;
constexpr int HG_VT = 2 * HG_QKSZ, HG_VTSZ = 64 * HG_PV;
constexpr int HG_ST = HG_VT + 2 * HG_VTSZ, HG_STSZ = 32 * HG_P128, HG_END = HG_ST + 2 * HG_STSZ;
static_assert(HG_END <= RING_BYTES, "hgrn LDS");
__device__ __forceinline__ int hg_row(int b, int dir, int c, int t) {
    const int p = 64 * (c < 4 ? c : c - 4) + t;
    if (c < 4) return NLAT + b * CTXL + (dir ? (CTXL - 1 - p) : p);
    return b * SEQ + (dir ? (SEQ - 1 - p) : p);
}
template <int V> struct IntC { static constexpr int value = V; };
__device__ __forceinline__ void hgrn_item(const Frame& F, const bf16_t* Z1, const float* VECS, const bf16_t* QS  , bf16_t* OUT  , int b, int h, int dir, int vq) {
    const int tid = F.tid, lane = F.lane, wid = F.wave;
    LAS unsigned char* L = F.lds;
    const int sr = tid >> 3, sc8 = tid & 7;
    const int tv = tid >> 2, vp = tid & 3;
    const int fr = lane & 15, fq = lane >> 4;
    const int tb = wid < 4 ? (wid >> 1) : 3 - ((wid - 4) >> 1), vb = wid & 1;
    const int NC = 132;
    unsigned cmask[4][2];
#pragma unroll
    for (int sb = 0; sb < 4; ++sb)
#pragma unroll
        for (int dw = 0; dw < 2; ++dw) {
            const bool k0 = sb < tb || (sb == tb && 4 * fq + 2 * dw <= fr), k1 = sb < tb || (sb == tb && 4 * fq + 2 * dw + 1 <= fr);
            cmask[sb][dw] = (k0 ? 0xffffu : 0u) | (k1 ? 0xffff0000u : 0u);
        }
    const size_t zq = (ZO_HG + (size_t)((dir * 4 + h) * 2) * ZA_BYTES) / 2, zk = zq + ZA_BYTES / 2;
    for (int i = tid; i < 2 * HG_STSZ / 4; i += 512) ((LAS unsigned*)(L + HG_ST))[i] = 0u;
    f32x4 Sacc[2]; Sacc[0] = (f32x4){0.f, 0.f, 0.f, 0.f}; Sacc[1] = Sacc[0];
    struct GSet { u32x4 q[2], k[2], v, qx[2]; };
    GSet g0, g1; f32x4 mte, mdc;
    g0.v = (u32x4){0u, 0u, 0u, 0u}; g1.v = g0.v; mte = (f32x4){0.f, 0.f, 0.f, 0.f}; mdc = mte;
    auto hg_load = [&](int c, GSet& g) {
        const int row_ = hg_row(b, dir, c, sr); const bf16_t* p_ = Z1 + (size_t)row_ * 128 + 16 * sc8;
        g.q[0] = *(const u32x4*)(p_ + zq); g.q[1] = *(const u32x4*)(p_ + zq + 8); g.k[0] = *(const u32x4*)(p_ + zk); g.k[1] = *(const u32x4*)(p_ + zk + 8);
        if (dir) { const bf16_t* qp_ = QS + (size_t)row_ * D + 512 + h * 128 + 16 * sc8; g.qx[0] = *(const u32x4*)qp_; g.qx[1] = *(const u32x4*)(qp_ + 8); }
        if (tid < 256) { const int rv_ = hg_row(b, dir, c, tv); g.v = *(const u32x4*)(Z1 + (ZO_IH + (size_t)h * ZA_BYTES) / 2 + (size_t)rv_ * 128 + vq * 32 + 8 * vp); }
    };
    f32x4 pte = (f32x4){0.f, 0.f, 0.f, 0.f}, pdc = pte, pee = pte;
    auto hv_load = [&](int c) { const float* vp_ = VECS + ((size_t)(dir * NCHUNK + (hg_row(b, dir, c, 0) >> 6)) * 3) * 512 + h * 128 + 16 * wid + 4 * fq;
        pte = *(const f32x4*)vp_; pdc = *(const f32x4*)(vp_ + 512); pee = *(const f32x4*)(vp_ + 1024); };
    hv_load(0);
    hg_load(0, g0); hg_load(1, g1);
    __syncthreads();
    auto step = [&](int it, GSet& g, auto parc) {
        constexpr int PAR = decltype(parc)::value;
        const f32x4 eenext = pee, tenext = pte, dcnext = pdc;
        if (it + 1 < NC) hv_load(it + 1);
        if (it < NC) {
            constexpr int pp = PAR;
            LAS unsigned char* QMt = L + HG_QK + pp * HG_QKSZ; LAS unsigned char* KMt = QMt + 64 * HG_P128;
            if (dir) {
#pragma unroll
                for (int j = 0; j < 2; ++j) { f32x4 e0, e1, q0, q1; unpack8(g.q[j], e0, e1); unpack8(g.qx[j], q0, q1); g.q[j] = pack8(e0 * q0, e1 * q1); }
            }
            *(LAS u32x4*)(QMt + sr * HG_P128 + 32 * sc8) = g.q[0]; *(LAS u32x4*)(QMt + sr * HG_P128 + 32 * sc8 + 16) = g.q[1];
            *(LAS u32x4*)(KMt + sr * HG_P128 + 32 * sc8) = g.k[0]; *(LAS u32x4*)(KMt + sr * HG_P128 + 32 * sc8 + 16) = g.k[1];
            if (tid < 256) *(LAS u32x4*)(L + HG_VT + pp * HG_VTSZ + tv * HG_PV + 16 * vp) = g.v;
        }
        const f32x4 cte = mte, cdc = mdc;
        __builtin_amdgcn_sched_barrier(0);
        if (it + 2 < NC) hg_load(it + 2, g);
        __builtin_amdgcn_sched_barrier(0);
        if (it >= 1) {
            const int c = it - 1; constexpr int pm = 1 - PAR;
            const LAS unsigned char* QMt = L + HG_QK + pm * HG_QKSZ; const LAS unsigned char* KMt = QMt + 64 * HG_P128;
            const LAS unsigned char* Vt = L + HG_VT + pm * HG_VTSZ;
            const LAS unsigned char* STr = L + HG_ST + pm * HG_STSZ;
            bf16x8 qbs[4], sas[4], ka[4][2];
#pragma unroll
            for (int s = 0; s < 4; ++s) {
                qbs[s] = *(const LAS bf16x8*)(QMt + (16 * tb + fr) * HG_P128 + (32 * s + 8 * fq) * 2);
                sas[s] = *(const LAS bf16x8*)(STr + (16 * vb + fr) * HG_P128 + (32 * s + 8 * fq) * 2);
                ka[s][0] = *(const LAS bf16x8*)(KMt + fr * HG_P128 + (32 * s + 8 * fq) * 2);
            }
            if (tb >= 1) {
#pragma unroll
                for (int s = 0; s < 4; ++s) ka[s][1] = *(const LAS bf16x8*)(KMt + (16 + fr) * HG_P128 + (32 * s + 8 * fq) * 2);
            }
            __builtin_amdgcn_sched_barrier(0);
            f32x4 sc4[4], ov = (f32x4){0.f, 0.f, 0.f, 0.f}, sv[2];
#pragma unroll
            for (int sb = 0; sb < 4; ++sb) sc4[sb] = (f32x4){0.f, 0.f, 0.f, 0.f};
            sv[0] = (f32x4){0.f, 0.f, 0.f, 0.f}; sv[1] = sv[0];
#pragma unroll
            for (int s = 0; s < 4; ++s) {
                sc4[0] = __builtin_amdgcn_mfma_f32_16x16x32_bf16(ka[s][0], qbs[s], sc4[0], 0, 0, 0);
                ov = __builtin_amdgcn_mfma_f32_16x16x32_bf16(sas[s], qbs[s], ov, 0, 0, 0);
            }
            if (tb >= 1) {
#pragma unroll
                for (int s = 0; s < 4; ++s) sc4[1] = __builtin_amdgcn_mfma_f32_16x16x32_bf16(ka[s][1], qbs[s], sc4[1], 0, 0, 0);
            }
            if (tb >= 2) {
#pragma unroll
                for (int s = 0; s < 4; ++s) ka[s][0] = *(const LAS bf16x8*)(KMt + (32 + fr) * HG_P128 + (32 * s + 8 * fq) * 2);
                if (tb >= 3) {
#pragma unroll
                    for (int s = 0; s < 4; ++s) ka[s][1] = *(const LAS bf16x8*)(KMt + (48 + fr) * HG_P128 + (32 * s + 8 * fq) * 2);
                }
#pragma unroll
                for (int s = 0; s < 4; ++s) sc4[2] = __builtin_amdgcn_mfma_f32_16x16x32_bf16(ka[s][0], qbs[s], sc4[2], 0, 0, 0);
                if (tb >= 3) {
#pragma unroll
                    for (int s = 0; s < 4; ++s) sc4[3] = __builtin_amdgcn_mfma_f32_16x16x32_bf16(ka[s][1], qbs[s], sc4[3], 0, 0, 0);
                }
            }
            bf16x8 va[2], kfr[2], vf[2][2];
#pragma unroll
            for (int p2 = 0; p2 < 2; ++p2) {
                const int vrow = 32 * p2 + 4 * fq + ((lane & 15) >> 2), vcolb = (16 * vb + 4 * (lane & 3)) * 2;
                const s16x4 lo = tr_read(Vt + vrow * HG_PV + vcolb), hi4 = tr_read(Vt + (vrow + 16) * HG_PV + vcolb);
                va[p2] = (bf16x8){lo[0], lo[1], lo[2], lo[3], hi4[0], hi4[1], hi4[2], hi4[3]};
                const int krow = 32 * p2 + 8 * fq + ((lane & 15) >> 2), kcolb = (16 * wid + 4 * (lane & 3)) * 2;
                const s16x4 klo = tr_read(KMt + krow * HG_P128 + kcolb), khi = tr_read(KMt + (krow + 4) * HG_P128 + kcolb);
                kfr[p2] = (bf16x8){klo[0], klo[1], klo[2], klo[3], khi[0], khi[1], khi[2], khi[3]};
#pragma unroll
                for (int v2 = 0; v2 < 2; ++v2) {
                    const int v2colb = (16 * v2 + 4 * (lane & 3)) * 2;
                    const s16x4 l2 = tr_read(Vt + krow * HG_PV + v2colb), h2 = tr_read(Vt + (krow + 4) * HG_PV + v2colb);
                    vf[v2][p2] = (bf16x8){l2[0], l2[1], l2[2], l2[3], h2[0], h2[1], h2[2], h2[3]};
                }
            }
#pragma unroll
            for (int s = 0; s < 2; ++s) { sv[0] = __builtin_amdgcn_mfma_f32_16x16x32_bf16(kfr[s], vf[0][s], sv[0], 0, 0, 0); sv[1] = __builtin_amdgcn_mfma_f32_16x16x32_bf16(kfr[s], vf[1][s], sv[1], 0, 0, 0); }
            {
                const u32x2 blo = pack4(sc4[0]), bhi = pack4(sc4[1]);
                const bf16x8 ab = __builtin_bit_cast(bf16x8, (u32x4){blo.x & cmask[0][0], blo.y & cmask[0][1], bhi.x & cmask[1][0], bhi.y & cmask[1][1]});
                ov = __builtin_amdgcn_mfma_f32_16x16x32_bf16(va[0], ab, ov, 0, 0, 0);
            }
            if (tb >= 2) {
                const u32x2 blo = pack4(sc4[2]), bhi = pack4(sc4[3]);
                const bf16x8 ab = __builtin_bit_cast(bf16x8, (u32x4){blo.x & cmask[2][0], blo.y & cmask[2][1], bhi.x & cmask[3][0], bhi.y & cmask[3][1]});
                ov = __builtin_amdgcn_mfma_f32_16x16x32_bf16(va[1], ab, ov, 0, 0, 0);
            }
            { const int row = hg_row(b, dir, c, 16 * tb + fr);
              *(u32x2*)(OUT + (size_t)row * 512 + h * 128 + vq * 32 + 16 * vb + 4 * fq) = pack4(ov); }
            Sacc[0] = Sacc[0] * cdc + sv[0] * cte; Sacc[1] = Sacc[1] * cdc + sv[1] * cte;
            if (it < NC) {
#pragma unroll
                for (int v2 = 0; v2 < 2; ++v2) *(LAS u32x2*)(L + HG_ST + PAR * HG_STSZ + (16 * v2 + fr) * HG_P128 + (16 * wid + 4 * fq) * 2) = pack4(Sacc[v2] * eenext);
            }
        }
        mte = tenext; mdc = dcnext;
        asm volatile("s_waitcnt lgkmcnt(0)" ::: "memory"); __builtin_amdgcn_s_barrier(); asm volatile("" ::: "memory");
    };
    for (int it = 0; it <= NC; it += 2) { step(it, g0, IntC<0>{}); if (it + 1 <= NC) step(it + 1, g1, IntC<1>{}); }
}
__device__ __forceinline__ void hgrn_phase(const Frame& F) {
    const bf16_t* Z1 = (const bf16_t*)(F.ws + WS_Z);
    bf16_t* OFW = (bf16_t*)(F.ws + WS_O); bf16_t* OBW = OFW + (size_t)MROWS * 512;
    for (int it = F.vcu; it < 256; it += F.G) {
        const int vq = it & 3, dir = (it >> 2) & 1, h = (it >> 3) & 3, b = it >> 5;
        hgrn_item(F, Z1, (const float*)(F.ws + WS_VECS), (const bf16_t*)(F.ws + WS_AH), dir ? OBW : OFW, b, h, dir, vq);
        __syncthreads();
    }
}
__device__ __forceinline__ void readout_phase(const Frame& F, const Args& a, int l, int M) {
    const bf16_t* OFW = (const bf16_t*)(F.ws + WS_O); const bf16_t* OBW = OFW + (size_t)MROWS * 512;
    const bf16_t* Z2 = (const bf16_t*)(F.ws + WS_Z); bf16_t* AH = (bf16_t*)(F.ws + WS_AH);
    const float* ng = a.norm_g + l * 512;
    const int gw = F.vcu * 8 + F.wave, NGW = F.G * 8, lane = F.lane;
    const f32x4 g0 = *(const f32x4*)(ng + 8 * lane), g1 = *(const f32x4*)(ng + 8 * lane + 4);
    u32x4 ra[4], rb[4], rs4[4];
    auto ld = [&](int grp) {
#pragma unroll
        for (int r = 0; r < 4; ++r) { const size_t off = (size_t)(grp * 4 + r) * 512 + 8 * lane; ra[r] = *(const u32x4*)(OFW + off); rb[r] = *(const u32x4*)(OBW + off); rs4[r] = *(const u32x4*)(Z2 + off); }
    };
    if (gw < M / 4) ld(gw);
    for (int grp = gw; grp < M / 4; grp += NGW) {
        f32x4 oa[4], ob[4], sa[4], sb[4];
#pragma unroll
        for (int r = 0; r < 4; ++r) { f32x4 x0, x1, y0, y1; unpack8(ra[r], x0, x1); unpack8(rb[r], y0, y1); oa[r] = x0 + y0; ob[r] = x1 + y1; unpack8(rs4[r], sa[r], sb[r]); }
        if (grp + NGW < M / 4) ld(grp + NGW);
#pragma unroll
        for (int r = 0; r < 4; ++r) {
            const float ss = row16_sum(hsq4(oa[r]) + hsq4(ob[r]));
            const float rs = __builtin_amdgcn_rsqf(ss * (1.0f / 128.0f) + LN_EPS);
            *(u32x4*)(AH + (size_t)(grp * 4 + r) * D + 512 + 8 * lane) = pack8(oa[r] * rs * g0 * sa[r], ob[r] * rs * g1 * sb[r]);
        }
    }
}

__device__ __forceinline__ void row_pass1(const Frame& F, const Args& a, int l, int M) {
    LAS float* wrT = (LAS float*)F.lds;
    constexpr int WRP = D + 4;
    const float* wr = a.w_router + (size_t)l * D * NE;
    {
        float w32[32];
#pragma unroll
        for (int j = 0; j < 32; ++j) w32[j] = wr[F.tid + 512 * j];
#pragma unroll
        for (int j = 0; j < 32; ++j) { const int i = F.tid + 512 * j, d = i >> 4, e = i & 15; wrT[e * WRP + d] = w32[j]; }
    }
    __syncthreads();
    const float* MOD = (const float*)(F.ws + WS_MOD);
    const bf16_t* Y = (const bf16_t*)(F.ws + WS_AH);
    bf16_t* U2 = (bf16_t*)(F.ws + WS_U);
    float* XC = (float*)(F.ws + WS_XC);
    float* AFF = (float*)(F.ws + WS_AFF); float* AFFT = (float*)(F.ws + WS_AFFT);
    const float* lng = a.ln_g + (size_t)(l * 2 + 0) * D; const float* lnb = a.ln_b + (size_t)(l * 2 + 0) * D;
    const int gw = F.vcu * 8 + F.wave, NGW = F.G * 8, lane = F.lane;
    u32x4 xr[4][4];
    const bool xbf = l == 1;
    bf16_t* X1 = (bf16_t*)(F.ws + WS_O);
    auto rp1_load = [&](int grp) {
        const int row0 = grp * 4; const bool lat = row0 < NLAT;
        if (lat && xbf) {
            const bf16_t* xin = (const bf16_t*)a.out + (size_t)row0 * D;
#pragma unroll
            for (int s2 = 0; s2 < 2; ++s2)
#pragma unroll
                for (int r = 0; r < 4; ++r) { xr[r][2 * s2] = *(const u32x4*)(xin + (size_t)r * D + 512 * s2 + 8 * lane); xr[r][2 * s2 + 1] = (u32x4){0u, 0u, 0u, 0u}; }
        } else {
            const float* xin = lat ? a.x + (size_t)row0 * D : (l == 0 ? a.ctx + (size_t)(row0 - NLAT) * D : XC + (size_t)(row0 - NLAT) * D);
#pragma unroll
            for (int s2 = 0; s2 < 2; ++s2)
#pragma unroll
                for (int r = 0; r < 4; ++r) {
                    const int c0 = 512 * s2 + 8 * lane;
                    xr[r][2 * s2] = *(const u32x4*)(xin + (size_t)r * D + c0); xr[r][2 * s2 + 1] = *(const u32x4*)(xin + (size_t)r * D + c0 + 4);
                }
        }
    };
    if (gw < M / 4) rp1_load(gw);
    for (int grp = gw; grp < M / 4; grp += NGW) {
        const int row0 = grp * 4; const bool lat = row0 < NLAT;
        float* xo = XC + (size_t)(lat ? 0 : row0 - NLAT) * D;
        const float* md = MOD + (size_t)(l * 9 + mod_group(row0)) * 6144;
        f32x4 v[4][4];
#pragma unroll
        for (int s2 = 0; s2 < 2; ++s2) {
            const int c0 = 512 * s2 + 8 * lane;
            const f32x4 ga = *(const f32x4*)(md + 2048 + c0), gb = *(const f32x4*)(md + 2048 + c0 + 4);
#pragma unroll
            for (int r = 0; r < 4; ++r) {
                f32x4 ya, yb; unpack8(*(const u32x4*)(Y + (size_t)(row0 + r) * D + c0), ya, yb);
                f32x4 xa, xb; if (lat && xbf) unpack8(xr[r][2 * s2], xa, xb); else { xa = __builtin_bit_cast(f32x4, xr[r][2 * s2]); xb = __builtin_bit_cast(f32x4, xr[r][2 * s2 + 1]); }
                v[r][2 * s2] = xa * ALPHA + ga * ya; v[r][2 * s2 + 1] = xb * ALPHA + gb * yb;
            }
        }
        float rstd[4];
#pragma unroll
        for (int r = 0; r < 4; ++r) {
            const float mean = wsum((hsum4(v[r][0]) + hsum4(v[r][1])) + (hsum4(v[r][2]) + hsum4(v[r][3]))) * (1.f / D);
#pragma unroll
            for (int q = 0; q < 4; ++q) v[r][q] = v[r][q] - mean;
            rstd[r] = __builtin_amdgcn_rsqf(wsum((hsq4(v[r][0]) + hsq4(v[r][1])) + (hsq4(v[r][2]) + hsq4(v[r][3]))) * (1.f / D) + LN_EPS);
        }
        f32x4 pg[4], pb[4], psc[4], psh[4];
#pragma unroll
        for (int q = 0; q < 4; ++q) {
            const int c0 = 512 * (q >> 1) + 8 * lane + 4 * (q & 1);
            pg[q] = *(const f32x4*)(lng + c0); pb[q] = *(const f32x4*)(lnb + c0); psc[q] = *(const f32x4*)(md + 4096 + c0); psh[q] = *(const f32x4*)(md + 3072 + c0);
        }
#pragma unroll
        for (int q = 0; q < 4; ++q) {
            const int c0 = 512 * (q >> 1) + 8 * lane + 4 * (q & 1);
#pragma unroll
            for (int r = 0; r < 4; ++r) { v[r][q] = v[r][q] * rstd[r] * pg[q] + pb[q]; if (!lat) *(f32x4*)(xo + (size_t)r * D + c0) = v[r][q]; }
        }
        if (lat) {
#pragma unroll
            for (int s2 = 0; s2 < 2; ++s2)
#pragma unroll
                for (int r = 0; r < 4; ++r) *(u32x4*)(X1 + (size_t)(row0 + r) * D + 512 * s2 + 8 * lane) = pack8(v[r][2 * s2], v[r][2 * s2 + 1]);
        }
#pragma unroll
        for (int r = 0; r < 4; ++r) {
            const float mean = wsum((hsum4(v[r][0]) + hsum4(v[r][1])) + (hsum4(v[r][2]) + hsum4(v[r][3]))) * (1.f / D);
#pragma unroll
            for (int q = 0; q < 4; ++q) v[r][q] = v[r][q] - mean;
            rstd[r] = __builtin_amdgcn_rsqf(wsum((hsq4(v[r][0]) + hsq4(v[r][1])) + (hsq4(v[r][2]) + hsq4(v[r][3]))) * (1.f / D) + LN_EPS);
        }
#pragma unroll
        for (int s2 = 0; s2 < 2; ++s2) {
            const int c0 = 512 * s2 + 8 * lane;
            const f32x4 sca = psc[2 * s2] + 1.0f, scb = psc[2 * s2 + 1] + 1.0f, sha = psh[2 * s2], shb = psh[2 * s2 + 1];
#pragma unroll
            for (int r = 0; r < 4; ++r) { v[r][2 * s2] = v[r][2 * s2] * rstd[r] * sca + sha; v[r][2 * s2 + 1] = v[r][2 * s2 + 1] * rstd[r] * scb + shb; }
        }
#pragma unroll
        for (int r = 0; r < 4; ++r)
#pragma unroll
            for (int q = 0; q < 4; ++q) asm volatile("" : "+v"(v[r][q]) :: "memory");
        if (grp + NGW < M / 4) rp1_load(grp + NGW);
#pragma unroll
        for (int s2 = 0; s2 < 2; ++s2)
#pragma unroll
            for (int r = 0; r < 4; ++r) *(u32x4*)(U2 + (size_t)(row0 + r) * D + 512 * s2 + 8 * lane) = pack8(v[r][2 * s2], v[r][2 * s2 + 1]);
        float p[64];
#pragma unroll
        for (int e = 0; e < 16; ++e) {
            f32x4 pa[4];
#pragma unroll
            for (int r = 0; r < 4; ++r) pa[r] = (f32x4){0.f, 0.f, 0.f, 0.f};
#pragma unroll
            for (int q = 0; q < 4; ++q) {
                const f32x4 w4 = *(const LAS f32x4*)(wrT + e * WRP + 512 * (q >> 1) + 8 * lane + 4 * (q & 1));
#pragma unroll
                for (int r = 0; r < 4; ++r) pa[r] = __builtin_elementwise_fma(v[r][q], w4, pa[r]);
            }
#pragma unroll
            for (int r = 0; r < 4; ++r) p[r * 16 + e] = hsum4(pa[r]);
            asm volatile("" ::: "memory");
        }
#pragma unroll
        for (int i = 0; i < 32; ++i) { const auto sw = __builtin_amdgcn_permlane32_swap(__float_as_uint(p[i]), __float_as_uint(p[i + 32]), false, false); p[i] = __uint_as_float(sw[0]) + __uint_as_float(sw[1]); }
#define BFLY_(N, MK) { const bool hi_ = (lane & MK) != 0; _Pragma("unroll") for (int i = 0; i < N / 2; ++i) { const float send = hi_ ? p[i] : p[i + N / 2]; const float keep = hi_ ? p[i + N / 2] : p[i]; p[i] = keep + shx(send, MK, lane); } }
        BFLY_(32, 16) BFLY_(16, 8) BFLY_(8, 4) BFLY_(4, 2) BFLY_(2, 1)
#undef BFLY_
        const float lg = p[0];
        const float mx = row16_max(lg);
        const float ex = __expf(lg - mx);
        const float mine = ex * __builtin_amdgcn_rcpf(row16_sum(ex));
        const int r = lane >> 4, e = lane & 15, row = row0 + r;
        AFF[(size_t)row0 * 16 + lane] = mine;
        if (lat) AFFT[((size_t)(row >> 13) * 16 + e) * SEQ + (row & (SEQ - 1))] = mine;
        else { const int rc = row - NLAT; AFFT[(size_t)NB * 16 * SEQ + ((size_t)(rc >> 8) * 16 + e) * CTXL + (rc & (CTXL - 1))] = mine; }
    }
}
__device__ __forceinline__ void topk_phase(const Frame& F, int l) {
    LAS unsigned* vals = (LAS unsigned*)F.lds;
    LAS unsigned* hist = (LAS unsigned*)(F.lds + 32768);
    LAS unsigned* wtot = (LAS unsigned*)(F.lds + 32768 + 1024);
    LAS unsigned* ctl = (LAS unsigned*)(F.lds + 32768 + 1024 + 64);
    const float* AFFT = (const float*)(F.ws + WS_AFFT);
    int* SEL = (int*)(F.ws + WS_SEL); int* INV = (int*)(F.ws + WS_INV);
    const int total = 128 + (l == 0 ? 128 : 0);
    for (int u = F.vcu; u < total; u += F.G) {
        const bool lat = u < 128; const int q = lat ? u : u - 128, b = q >> 4, e = q & 15;
        const int n = lat ? SEQ : CTXL, cap = lat ? CAP : CAPC;
        const float* src = lat ? AFFT + (size_t)q * SEQ : AFFT + (size_t)NB * 16 * SEQ + (size_t)q * CTXL;
        if (lat) {
            u32x4 t4[4];
#pragma unroll
            for (int k = 0; k < 4; ++k) t4[k] = *(const u32x4*)(src + 4 * F.tid + 2048 * k);
#pragma unroll
            for (int k = 0; k < 4; ++k) *(LAS u32x4*)(vals + 4 * F.tid + 2048 * k) = t4[k];
        } else for (int i = F.tid; i < n; i += 512) vals[i] = __float_as_uint(src[i]);
        if (F.tid == 0) { ctl[0] = 0u; ctl[1] = (unsigned)cap; }
        __syncthreads();
        unsigned mask = 0u;
        for (int pass = 0; pass < 4; ++pass) {
            const int shift = 24 - 8 * pass;
            if (F.tid < 256) hist[F.tid] = 0u;
            __syncthreads();
            const unsigned prefix = ctl[0];
            for (int i = F.tid; i < n; i += 512) { const unsigned v = vals[i]; if ((v & mask) == prefix) __hip_atomic_fetch_add(&hist[(v >> shift) & 255u], 1u, __ATOMIC_RELAXED, __HIP_MEMORY_SCOPE_WORKGROUP); }
            __syncthreads();
            if (F.wave == 0) {
                const unsigned kk = ctl[1];
                const u32x4 h4 = *(const LAS u32x4*)(hist + 4 * F.lane);
                const unsigned sl = (h4.x + h4.y) + (h4.z + h4.w);
                unsigned inc = sl;
#pragma unroll
                for (int o = 1; o < 64; o <<= 1) { const unsigned x = shup_u(inc, o, F.lane); if (F.lane >= o) inc += x; }
                const unsigned tot = (unsigned)__builtin_amdgcn_readlane((int)inc, 63);
                const bool reach = tot - (inc - sl) >= kk;
                const unsigned long long bm = __ballot(reach);
                const int ls = bm ? 63 - __builtin_clzll(bm) : 0;
                unsigned cum = tot - (unsigned)__builtin_amdgcn_readlane((int)inc, ls);
                const unsigned c3 = (unsigned)__builtin_amdgcn_readlane((int)h4.w, ls), c2 = (unsigned)__builtin_amdgcn_readlane((int)h4.z, ls), c1 = (unsigned)__builtin_amdgcn_readlane((int)h4.y, ls);
                int bin = 4 * ls + 3;
                if (cum + c3 < kk) { cum += c3; bin = 4 * ls + 2; if (cum + c2 < kk) { cum += c2; bin = 4 * ls + 1; if (cum + c1 < kk) { cum += c1; bin = 4 * ls; } } }
                if (F.lane == 0) { ctl[0] = prefix | ((unsigned)bin << shift); ctl[1] = kk - cum; }
            }
            mask |= 255u << shift;
            __syncthreads();
        }
        const unsigned T = ctl[0], keq = ctl[1];
        const int per = n >= 512 ? n / 512 : 1; const int base = F.tid * per; const bool active = base < n;
        unsigned ngt = 0u, neq = 0u;
        if (active) for (int i = 0; i < per; ++i) { const unsigned v = vals[base + i]; ngt += v > T; neq += v == T; }
        unsigned pk = ngt | (neq << 16), inc = pk;
#pragma unroll
        for (int o = 1; o < 64; o <<= 1) { const unsigned x = shup_u(inc, o, F.lane); if (F.lane >= o) inc += x; }
        if (F.lane == 63) wtot[F.wave] = inc;
        __syncthreads();
        unsigned wpre = 0u;
        for (int w = 0; w < F.wave; ++w) wpre += wtot[w];
        const unsigned excl = wpre + inc - pk;
        unsigned cgt = excl & 0xffffu, ceq = excl >> 16;
        if (active) for (int i = 0; i < per; ++i) {
            const int t = base + i; const unsigned v = vals[t];
            bool take = false; unsigned slot = 0u;
            if (v > T) { take = true; slot = cgt + (ceq < keq ? ceq : keq); ++cgt; }
            else if (v == T) { if (ceq < keq) { take = true; slot = cgt + ceq; } ++ceq; }
            const int row = lat ? b * SEQ + t : NLAT + b * CTXL + t;
            INV[(size_t)row * 16 + e] = take ? (int)slot : -1;
            if (take) { const int xr = lat ? (b * NE + e) * CAP + (int)slot : NB * NE * CAP + (e * NB + b) * CAPC + (int)slot; SEL[xr] = row; }
        }
        __syncthreads();
    }
}
__device__ __forceinline__ void gather_phase(const Frame& F, int l) {
    const int* SEL = (const int*)(F.ws + WS_SEL);
    const bf16_t* U2 = (const bf16_t*)(F.ws + WS_U); bf16_t* XS = (bf16_t*)(F.ws + WS_Z);
    const int total = NB * NE * CAP + (l == 0 ? NB * NE * CAPC : 0);
    const int gw = F.vcu * 8 + F.wave, NGW = F.G * 8;
    for (int r = gw; r < total; r += NGW) {
        const int src = SEL[r];
        const u32x4 a0 = *(const u32x4*)(U2 + (size_t)src * D + 8 * F.lane), a1 = *(const u32x4*)(U2 + (size_t)src * D + 512 + 8 * F.lane);
        *(u32x4*)(XS + (size_t)r * D + 8 * F.lane) = a0; *(u32x4*)(XS + (size_t)r * D + 512 + 8 * F.lane) = a1;
    }
}
__device__ __forceinline__ void row_pass2(const Frame& F, const Args& a, int l, int M) {
    const float* MOD = (const float*)(F.ws + WS_MOD);
    const bf16_t* YE = (const bf16_t*)(F.ws + WS_Z);
    bf16_t* U = (bf16_t*)(F.ws + WS_U);
    float* XC = (float*)(F.ws + WS_XC);
    const float* AFF = (const float*)(F.ws + WS_AFF); const int* INV = (const int*)(F.ws + WS_INV);
    const float* lng = a.ln_g + (size_t)(l * 2 + 1) * D; const float* lnb = a.ln_b + (size_t)(l * 2 + 1) * D;
    const int gw = F.vcu * 8 + F.wave, NGW = F.G * 8, lane = F.lane;
    u32x4 xr[4][4]; int inv_n = -1; float af_n = 0.f;
    const bf16_t* X1 = (const bf16_t*)(F.ws + WS_O);
    auto rp2_load = [&](int grp) {
        const int row0 = grp * 4; const bool lat = row0 < NLAT;
        inv_n = INV[(size_t)row0 * 16 + lane]; af_n = AFF[(size_t)row0 * 16 + lane];
        if (lat) {
#pragma unroll
            for (int s2 = 0; s2 < 2; ++s2)
#pragma unroll
                for (int r = 0; r < 4; ++r) xr[r][2 * s2] = *(const u32x4*)(X1 + (size_t)(row0 + r) * D + 512 * s2 + 8 * lane);
        } else {
            const float* xin = XC + (size_t)(row0 - NLAT) * D;
#pragma unroll
            for (int q = 0; q < 4; ++q)
#pragma unroll
                for (int r = 0; r < 4; ++r) xr[r][q] = *(const u32x4*)(xin + (size_t)r * D + 512 * (q >> 1) + 8 * lane + 4 * (q & 1));
        }
    };
    if (gw < M / 4) rp2_load(gw);
    for (int grp = gw; grp < M / 4; grp += NGW) {
        const int row0 = grp * 4; const bool lat = row0 < NLAT;
        float* xio = lat ? a.out + (size_t)row0 * D : XC + (size_t)(row0 - NLAT) * D;
        const bool obf = lat && l == 0;
        const int g9 = mod_group(row0);
        const float* md = MOD + (size_t)(l * 9 + g9) * 6144;
        const int inv = inv_n; const float af = af_n;
        const unsigned long long selm = __ballot(inv >= 0);
        unsigned sel_lo = (unsigned)selm, sel_hi = (unsigned)(selm >> 32); asm volatile("" : "+s"(sel_lo), "+s"(sel_hi));
        const int b = lat ? (row0 >> 13) : ((row0 - NLAT) >> 8);
        f32x4 v[4][4];
        unsigned mk[4];
#pragma unroll
        for (int r = 0; r < 4; ++r) {
#pragma unroll
            for (int q = 0; q < 4; ++q) v[r][q] = (f32x4){0.f, 0.f, 0.f, 0.f};
            mk[r] = ((r < 2 ? sel_lo : sel_hi) >> (16 * (r & 1))) & 0xffffu;
        }
        while ((mk[0] | mk[1]) | (mk[2] | mk[3])) {
            u32x4 y0[4], y1[4]; float w[4];
#pragma unroll
            for (int r = 0; r < 4; ++r) {
                w[r] = 0.f;
                if (mk[r]) {
                    const int e = __builtin_ctz(mk[r]); mk[r] &= mk[r] - 1u;
                    const int slot = __builtin_amdgcn_readlane(inv, 16 * r + e); w[r] = rdlane(af, 16 * r + e);
                    const size_t yr = lat ? (size_t)(b * NE + e) * CAP + slot : (size_t)NB * NE * CAP + (size_t)(e * NB + b) * CAPC + slot;
                    y0[r] = *(const u32x4*)(YE + yr * D + 8 * lane); y1[r] = *(const u32x4*)(YE + yr * D + 512 + 8 * lane);
                } else { y0[r] = (u32x4){0u, 0u, 0u, 0u}; y1[r] = y0[r]; }
            }
#pragma unroll
            for (int r = 0; r < 4; ++r) {
                f32x4 ya, yb; unpack8(y0[r], ya, yb); v[r][0] += ya * w[r]; v[r][1] += yb * w[r]; unpack8(y1[r], ya, yb); v[r][2] += ya * w[r]; v[r][3] += yb * w[r];
            }
        }
        f32x4 pg2[4];
#pragma unroll
        for (int q = 0; q < 4; ++q) pg2[q] = *(const f32x4*)(md + 5120 + 512 * (q >> 1) + 8 * lane + 4 * (q & 1));
        __builtin_amdgcn_sched_barrier(0);
#pragma unroll
        for (int q = 0; q < 4; ++q) {
            const int c0 = 512 * (q >> 1) + 8 * lane + 4 * (q & 1);
            const f32x4 g2 = pg2[q];
#pragma unroll
            for (int r = 0; r < 4; ++r) {
                f32x4 xv;
                if (lat) { f32x4 xa, xb; unpack8(xr[r][q & 2], xa, xb); xv = (q & 1) ? xb : xa; } else xv = __builtin_bit_cast(f32x4, xr[r][q]);
                v[r][q] = xv * ALPHA + g2 * v[r][q];
            }
        }
        f32x4 pg[4], pb[4];
#pragma unroll
        for (int q = 0; q < 4; ++q) { const int c0 = 512 * (q >> 1) + 8 * lane + 4 * (q & 1); pg[q] = *(const f32x4*)(lng + c0); pb[q] = *(const f32x4*)(lnb + c0); }
        float rstd[4];
#pragma unroll
        for (int r = 0; r < 4; ++r) {
            const float mean = wsum((hsum4(v[r][0]) + hsum4(v[r][1])) + (hsum4(v[r][2]) + hsum4(v[r][3]))) * (1.f / D);
#pragma unroll
            for (int q = 0; q < 4; ++q) v[r][q] = v[r][q] - mean;
            rstd[r] = __builtin_amdgcn_rsqf(wsum((hsq4(v[r][0]) + hsq4(v[r][1])) + (hsq4(v[r][2]) + hsq4(v[r][3]))) * (1.f / D) + LN_EPS);
        }
#pragma unroll
        for (int q = 0; q < 4; ++q) {
            const int c0 = 512 * (q >> 1) + 8 * lane + 4 * (q & 1);
            const f32x4 g = pg[q], bb = pb[q];
#pragma unroll
            for (int r = 0; r < 4; ++r) v[r][q] = v[r][q] * rstd[r] * g + bb;
        }
        if (grp + NGW < M / 4) rp2_load(grp + NGW);
        if (!obf) {
#pragma unroll
            for (int q = 0; q < 4; ++q)
#pragma unroll
                for (int r = 0; r < 4; ++r) *(f32x4*)(xio + (size_t)r * D + 512 * (q >> 1) + 8 * lane + 4 * (q & 1)) = v[r][q];
        }
        if (obf) {
            bf16_t* X2 = (bf16_t*)a.out;
#pragma unroll
            for (int s2 = 0; s2 < 2; ++s2)
#pragma unroll
                for (int r = 0; r < 4; ++r) *(u32x4*)(X2 + (size_t)(row0 + r) * D + 512 * s2 + 8 * lane) = pack8(v[r][2 * s2], v[r][2 * s2 + 1]);
        }
        if (l == 0) {
            const float* md1 = MOD + (size_t)(1 * 9 + g9) * 6144;
#pragma unroll
            for (int r = 0; r < 4; ++r) {
                const float mean = wsum((hsum4(v[r][0]) + hsum4(v[r][1])) + (hsum4(v[r][2]) + hsum4(v[r][3]))) * (1.f / D);
#pragma unroll
                for (int q = 0; q < 4; ++q) v[r][q] = v[r][q] - mean;
                rstd[r] = __builtin_amdgcn_rsqf(wsum((hsq4(v[r][0]) + hsq4(v[r][1])) + (hsq4(v[r][2]) + hsq4(v[r][3]))) * (1.f / D) + LN_EPS);
            }
#pragma unroll
            for (int s2 = 0; s2 < 2; ++s2) {
                const int c0 = 512 * s2 + 8 * lane;
                const f32x4 sca = *(const f32x4*)(md1 + 1024 + c0) + 1.0f, scb = *(const f32x4*)(md1 + 1024 + c0 + 4) + 1.0f, sha = *(const f32x4*)(md1 + c0), shb = *(const f32x4*)(md1 + c0 + 4);
#pragma unroll
                for (int r = 0; r < 4; ++r) *(u32x4*)(U + (size_t)(row0 + r) * D + c0) = pack8(v[r][2 * s2] * rstd[r] * sca + sha, v[r][2 * s2 + 1] * rstd[r] * scb + shb);
            }
        }
    }
}

constexpr int NPH_LAYER = 13, NPHASES = 2 + 2 * NPH_LAYER;
__global__ void __launch_bounds__(512, 2) fwd_kernel(Args args) {
    extern __shared__ __attribute__((aligned(16))) unsigned char lds_raw[];
    Frame F0;
    F0.lds = (LAS unsigned char*)lds_raw;
    F0.tid = threadIdx.x; F0.lane = F0.tid & 63; F0.wave = __builtin_amdgcn_readfirstlane(F0.tid >> 6);
    F0.G = gridDim.x; { const int bx = blockIdx.x; F0.vcu = (F0.G % 8 == 0) ? (bx % 8) * (F0.G / 8) + bx / 8 : bx; }
    F0.ws = args.ws;
    volatile LAS unsigned* MISC = (volatile LAS unsigned*)(F0.lds + MISC_OFF);
    if (F0.tid < 64) MISC[F0.tid] = 0u;
    __syncthreads();
    unsigned* ctl = (unsigned*)(F0.ws + WS_CTL);
    XcdBarrier bar; bar.bar = ctl + CW_BAR; bar.x = 0; bar.st = nullptr;
    const int lo = args.ph_lo, hi = args.ph_hi;
    if (hi - lo > 1) bar = xcd_barrier_post(ctl + CW_BAR, MISC + 8);
#ifndef PH_MASK
#define PH_MASK 0xffff
#endif
#define PHON(j) (((PH_MASK) >> (j)) & 1)
#ifndef PH_REP
#define PH_REP 0
#endif
#define REPS(j) for (int rep_ = 0; rep_ <= (((PH_REP) >> (j)) & 1); ++rep_)
#define IN(k) (lo <= (k) && (k) < hi)
#define SEAM(k) do { if (IN(k) && IN((k) + 1)) xcd_barrier(bar); } while (0)
    if (PHON(13) && IN(0)) { const Frame F = phase_frame(F0); mod_items(F, args); small_tables(F, args); convert_weights(F, args, 0, 0, CVS_P0, F.bx, F.G); }
    SEAM(0);
    if (PHON(14) && IN(1)) { const Frame F = phase_frame(F0); ln_mod_rows(F, args); }
    SEAM(1);
    for (int l = 0; l < 2; ++l) {
        const int pb = 2 + NPH_LAYER * l;
        const int M = l == 0 ? MROWS : NLAT;
        REPS(0) if (PHON(0) && IN(pb + 0)) { const Frame F = phase_frame(F0); bf16_t* Wb = weights_of(F, args, l);
            DenseSched<1> S{(const char*)(F.ws + WS_U), (const char*)(Wb + W_IN / 2), MROWS / 256, N1 / 256, F.G, F.bx, 0, 0};
            EpiIn1 E{(bf16_t*)(F.ws + WS_Z), (const float*)(F.ws + WS_ROPE), (const float*)(F.ws + WS_LB) + l * 1024, (float*)(F.ws + WS_VECS), (bf16_t*)(F.ws + WS_AH)};
            pg8::gemm_phase(F.lds, F.tid, D, D, D, S, E);
            { const Frame F2 = phase_frame(F0);
              if (l == 0) convert_in_tail(F2, args, (MROWS / 256) * (N1 / 256), 0, CVS_P0, CVS_A); else convert_in_tail(F2, args, (MROWS / 256) * (N1 / 256), 1, CV_GU_END, CV_ITEMS); }
        }
        SEAM(pb + 0);
        REPS(2) if (PHON(2) && IN(pb + 1)) { const Frame F = phase_frame(F0); bf16_t* Wb = weights_of(F, args, l); hgrn_phase(F); }
        if (IN(pb + 1) && IN(pb + 2)) __syncthreads();
        REPS(1) if (PHON(1) && IN(pb + 2)) { const Frame F = phase_frame(F0); bf16_t* Wb = weights_of(F, args, l); attn_phase(F, args, l); }
        SEAM(pb + 2);
        REPS(3) if (PHON(3) && IN(pb + 3)) { const Frame F = phase_frame(F0); bf16_t* Wb = weights_of(F, args, l);
            DenseSched<1> S{(const char*)(F.ws + WS_U), (const char*)(Wb + W_IN / 2 + (size_t)N1 * D), M / 256, N2 / 256, F.G, F.bx, 0, 0};
            EpiIn2 E{(bf16_t*)(F.ws + WS_Z), F.ws + WS_ZG};
            pg8::gemm_phase(F.lds, F.tid, D, D, D, S, E);
            { const Frame F2 = phase_frame(F0);
              if (l == 0) convert_in_tail(F2, args, (M / 256) * (N2 / 256), 0, CVS_A, CVS_B); }
        }
        SEAM(pb + 3);
        REPS(4) if (PHON(4) && IN(pb + 4)) { const Frame F = phase_frame(F0); bf16_t* Wb = weights_of(F, args, l); readout_phase(F, args, l, M); }
        SEAM(pb + 4);
        REPS(5) if (PHON(5) && IN(pb + 5)) { const Frame F = phase_frame(F0); bf16_t* Wb = weights_of(F, args, l);
            DenseSched<1> S{(const char*)(F.ws + WS_AH), (const char*)(Wb + W_BR / 2), M / 256, D / 256, F.G, F.bx, 0, 0};
            EpiBranch E{F.ws + WS_ZG, (bf16_t*)(F.ws + WS_O)};
            pg8::gemm_phase(F.lds, F.tid, D, D, D, S, E);
            { const Frame F2 = phase_frame(F0);
              if (l == 0) convert_in_tail(F2, args, (M / 256) * (D / 256), 0, CVS_B, CV_ITEMS); }
        }
        SEAM(pb + 5);
        REPS(6) if (PHON(6) && IN(pb + 6)) { const Frame F = phase_frame(F0); bf16_t* Wb = weights_of(F, args, l);
            DenseSched<1> S{(const char*)(F.ws + WS_O), (const char*)(Wb + W_OUT / 2), M / 256, D / 256, F.G, F.bx, 0, 0};
            EpiPlain E{(bf16_t*)(F.ws + WS_AH)};
            pg8::gemm_phase(F.lds, F.tid, D, D, D, S, E);
            { const Frame F2 = phase_frame(F0);
              if (l == 0) convert_in_tail(F2, args, (M / 256) * (D / 256), 1, 0, CVS_C); }
        }
        SEAM(pb + 6);
        REPS(7) if (PHON(7) && IN(pb + 7)) { const Frame F = phase_frame(F0); bf16_t* Wb = weights_of(F, args, l); row_pass1(F, args, l, M); }
        SEAM(pb + 7);
        REPS(8) if (PHON(8) && IN(pb + 8)) { const Frame F = phase_frame(F0); bf16_t* Wb = weights_of(F, args, l); topk_phase(F, l); }
        SEAM(pb + 8);
        REPS(10) if (PHON(10) && IN(pb + 10)) { const Frame F = phase_frame(F0); bf16_t* Wb = weights_of(F, args, l);
            MoeSched1 S{(const char*)(F.ws + WS_U), (const char*)(Wb + W_GU / 2), (const int*)(F.ws + WS_SEL), 4096 + (l == 0 ? 128 : 0), F.G, F.bx};
            EpiSwiglu E{(bf16_t*)(F.ws + WS_HB)};
            pg8::gemm_phase<true>(F.lds, F.tid, D, D, D, S, E);
            { const Frame F2 = phase_frame(F0);
              if (l == 0) convert_in_tail(F2, args, 4096 + 128, 1, CVS_C, CVS_D); }
        }
        SEAM(pb + 10);
        REPS(11) if (PHON(11) && IN(pb + 11)) { const Frame F = phase_frame(F0); bf16_t* Wb = weights_of(F, args, l);
            MoeSched2 S{(const char*)(F.ws + WS_HB), (const char*)(Wb + W_DN / 2), 2048 + (l == 0 ? 64 : 0), F.G, F.bx};
            EpiPlain E{(bf16_t*)(F.ws + WS_Z)};
            pg8::gemm_phase(F.lds, F.tid, D, D, D, S, E);
            { const Frame F2 = phase_frame(F0);
              if (l == 0) convert_in_tail(F2, args, 2048 + 64, 1, CVS_D, CV_GU_END); }
        }
        SEAM(pb + 11);
        REPS(12) if (PHON(12) && IN(pb + 12)) { const Frame F = phase_frame(F0); bf16_t* Wb = weights_of(F, args, l); row_pass2(F, args, l, M); }
        if (l == 0) SEAM(pb + 12);
    }
#undef IN
#undef SEAM
}

extern "C" void kernel_launch(void* const* d_in, const int* in_sizes, int n_in, void* d_out, int out_size, void* d_ws, size_t ws_size, hipStream_t stream) {
    static int grid = 0;
    if (grid == 0) {
        if (n_in != 20 || out_size != NLAT * D || ws_size < WS_END) { fprintf(stderr, "kernel_launch: unexpected shapes (n_in %d out %d ws %zu)\n", n_in, out_size, ws_size); grid = -1; return; }
        int dev = 0, cus = 0, per_cu = 0;
        if (hipGetDevice(&dev) != hipSuccess || hipDeviceGetAttribute(&cus, hipDeviceAttributeMultiprocessorCount, dev) != hipSuccess) { grid = -1; return; }
        if (hipFuncSetAttribute((const void*)fwd_kernel, hipFuncAttributeMaxDynamicSharedMemorySize, LDS_BYTES) != hipSuccess) { fprintf(stderr, "kernel_launch: hipFuncSetAttribute failed\n"); grid = -1; return; }
        if (hipOccupancyMaxActiveBlocksPerMultiprocessor(&per_cu, (const void*)fwd_kernel, 512, LDS_BYTES) != hipSuccess || per_cu < 1) fprintf(stderr, "kernel_launch: occupancy query reports %d\n", per_cu);
        (void)hipGetLastError();
        grid = cus;
    }
    if (grid < 0) return;
    (void)hipMemsetAsync((char*)d_ws + WS_CTL, 0, CTL_ZERO_BYTES, stream);
    Args a{};
    a.x = (const float*)d_in[0]; a.c = (const float*)d_in[1]; a.ctx = (const float*)d_in[2]; a.c_ctx = (const float*)d_in[3]; a.w_mod = (const float*)d_in[4]; a.b_mod = (const float*)d_in[5];
    a.w_in = (const float*)d_in[6]; a.attn_sink = (const float*)d_in[7]; a.lb_fw = (const float*)d_in[8]; a.lb_bw = (const float*)d_in[9]; a.norm_g = (const float*)d_in[10];
    a.w_bra = (const float*)d_in[11]; a.w_brh = (const float*)d_in[12]; a.w_out = (const float*)d_in[13]; a.w_router = (const float*)d_in[14]; a.w_gate = (const float*)d_in[15];
    a.w_up = (const float*)d_in[16]; a.w_down = (const float*)d_in[17]; a.ln_g = (const float*)d_in[18]; a.ln_b = (const float*)d_in[19];
    a.out = (float*)d_out; a.ws = (unsigned char*)d_ws;
#if MK_MULTI
    for (int p = 0; p < NPHASES; ++p) { a.ph_lo = p; a.ph_hi = p + 1; hipLaunchKernelGGL(fwd_kernel, dim3(grid), dim3(512), LDS_BYTES, stream, a); }
#else
    a.ph_lo = 0; a.ph_hi = NPHASES;
    hipLaunchKernelGGL(fwd_kernel, dim3(grid), dim3(512), LDS_BYTES, stream, a);
#endif
}
```
